# Optimizing an MI355X kernel written in HIP

```python
import jax, jax.numpy as jnp
from jax import lax
import numpy as np

D_MODEL = 2048
BATCH = 8
SEQ = 2048
DEPTH = 1

EPS = 1e-6
DA_HEADS = 8
DA_QK_DIM = 64
DA_V_DIM = 2 * DA_QK_DIM
ROPE_DIM = DA_QK_DIM // 4
ROPE_THETA = 500000.0
Q_BLOCK = 128
HG_HEADS = 8
HG_K_DIM = 128
HG_V_DIM = 128
HG_CHUNK = 64
DA_QK_W = DA_HEADS * 2 * DA_QK_DIM
DA_V_W = DA_HEADS * DA_V_DIM
HG_K_W = HG_HEADS * HG_K_DIM
HG_V_W = HG_HEADS * HG_V_DIM
SPLIT_SIZES = (DA_QK_W, DA_QK_W, DA_V_W, HG_K_W, HG_K_W, HG_K_W, HG_V_W, HG_V_W, D_MODEL, D_MODEL)
IN_W = sum(SPLIT_SIZES)
SPLIT_IDX = tuple(int(i) for i in np.cumsum(SPLIT_SIZES)[:-1])
PEER_HEADS = 8
PEER_N_KEYS = 128
PEER_N_EXPERTS = PEER_N_KEYS * PEER_N_KEYS
PEER_KEY_DIM = 256
PEER_HALF = PEER_KEY_DIM // 2
PEER_TOPK = 16
PEER_TOKEN_BLOCK = 128

kernel_name = "cond_hybrid_diffattn_hgrn2_peer_encoder"


def _rmsnorm(x, g):
    xf = x.astype(jnp.float32)
    y = xf * lax.rsqrt(jnp.mean(xf * xf, axis=-1, keepdims=True) + EPS)
    return (y * g.astype(jnp.float32)).astype(x.dtype)


def _modulate(x, g, shift, scale):
    return _rmsnorm(x, g) * (1.0 + scale[:, None, :]) + shift[:, None, :]


def _rope_tables(positions):
    inv = ROPE_THETA ** (-jnp.arange(0, ROPE_DIM, 2, dtype=jnp.float32) / ROPE_DIM)
    ang = positions.astype(jnp.float32)[..., None] * inv
    return jnp.cos(ang), jnp.sin(ang)


def _partial_rope(t, cos, sin):
    half = ROPE_DIM // 2
    c = cos[:, :, None, None, :].astype(t.dtype)
    s = sin[:, :, None, None, :].astype(t.dtype)
    x1, x2, rest = t[..., :half], t[..., half:ROPE_DIM], t[..., ROPE_DIM:]
    return jnp.concatenate([x1 * c - x2 * s, x2 * c + x1 * s, rest], axis=-1)


def _diff_attention(q, k, v, lam, lambda_init, subln_g):
    B, S, H, _, dk = q.shape
    nblk = S // Q_BLOCK
    q = q * (dk ** -0.5)
    qb = q.reshape(B, nblk, Q_BLOCK, H, 2, dk).transpose(1, 0, 2, 3, 4, 5)

    def block(qblk):
        s = jnp.einsum('bqhmd,bkhmd->bhmqk', qblk, k).astype(jnp.float32)
        p = jax.nn.softmax(s, axis=-1)
        p = p[:, :, 0] - lam * p[:, :, 1]
        return jnp.einsum('bhqk,bkhd->bqhd', p.astype(v.dtype), v)

    o = lax.map(block, qb)
    o = o.transpose(1, 0, 2, 3, 4).reshape(B, S, H, v.shape[-1])
    o = _rmsnorm(o, subln_g) * (1.0 - lambda_init)
    return o.reshape(B, S, H * v.shape[-1])


def _gla_chunkwise(q, k, v, log_f):
    B, S, H, dk = q.shape
    dv = v.shape[-1]
    L = HG_CHUNK
    C = S // L
    to_c = lambda t: t.reshape(B, C, L, H, t.shape[-1]).transpose(0, 3, 1, 2, 4)
    q, k, v, log_f = to_c(q), to_c(k), to_c(v), to_c(log_f)
    b = jnp.cumsum(log_f, axis=3)
    b_last = b[:, :, :, -1:, :]
    r = b[:, :, :, L // 2 - 1:L // 2, :]
    qi = q * jnp.exp(b - r)
    ki = k * jnp.exp(r - b)
    A = jnp.einsum('bhctd,bhcsd->bhcts', qi, ki)
    mask = jnp.tril(jnp.ones((L, L), dtype=bool))
    A = jnp.where(mask, A, 0.0)
    o_intra = jnp.einsum('bhcts,bhcsv->bhctv', A, v)
    U = jnp.einsum('bhcsd,bhcsv->bhcdv', k * jnp.exp(b_last - b), v)
    a = jnp.exp(b_last[:, :, :, 0, :])

    def step(state, inp):
        a_c, U_c = inp
        return a_c[..., None] * state + U_c, state

    s0 = jnp.zeros((B, H, dk, dv), jnp.float32)
    _, s_prev = lax.scan(step, s0, (jnp.moveaxis(a, 2, 0), jnp.moveaxis(U, 2, 0)))
    s_prev = jnp.moveaxis(s_prev, 0, 2)
    o_inter = jnp.einsum('bhctd,bhcdv->bhctv', q * jnp.exp(b), s_prev)
    o = o_intra + o_inter
    return o.transpose(0, 2, 3, 1, 4).reshape(B, S, H, dv)


def _layer_lower_bound(tbl, l):
    sm = jax.nn.softmax(tbl.astype(jnp.float32), axis=0)
    cum = jnp.cumsum(sm, axis=0)
    return (cum[l + 1] - cum[0]).reshape(HG_HEADS, HG_K_DIM)


def _hgrn2_gates(f_raw, lb):
    f = lb + (1.0 - lb) * jax.nn.sigmoid(f_raw)
    return 1.0 - f, jnp.log(f)


def _hgrn2(q_raw, ff_raw, fb_raw, i_raw, g_raw, lb_f, lb_b, norm_g):
    B, S, _ = q_raw.shape
    hk = lambda t: t.astype(jnp.float32).reshape(B, S, HG_HEADS, -1)
    q = jax.nn.silu(hk(q_raw))
    v = hk(i_raw)
    k_f, logf_f = _hgrn2_gates(hk(ff_raw), lb_f)
    k_b, logf_b = _hgrn2_gates(hk(fb_raw), lb_b)
    o_f = _gla_chunkwise(q, k_f, v, logf_f)
    flip = lambda t: jnp.flip(t, axis=1)
    o_b = flip(_gla_chunkwise(flip(q), flip(k_b), flip(v), flip(logf_b)))
    o = _rmsnorm(o_f + o_b, norm_g) * jax.nn.silu(hk(g_raw))
    return o.reshape(B, S, HG_V_W).astype(q_raw.dtype)


def _peer(h, wq, keys1, keys2, u, v):
    B, S, D = h.shape
    T = B * S
    t = h.reshape(T, D)
    qp = (t @ wq).reshape(T, PEER_HEADS, 2, PEER_HALF)
    s1 = jnp.einsum('thk,hnk->thn', qp[:, :, 0], keys1).astype(jnp.float32)
    s2 = jnp.einsum('thk,hnk->thn', qp[:, :, 1], keys2).astype(jnp.float32)
    v1, i1 = lax.top_k(s1, PEER_TOPK)
    v2, i2 = lax.top_k(s2, PEER_TOPK)
    cand = (v1[..., :, None] + v2[..., None, :]).reshape(T, PEER_HEADS, PEER_TOPK * PEER_TOPK)
    sc, ci = lax.top_k(cand, PEER_TOPK)
    e = (jnp.take_along_axis(i1, ci // PEER_TOPK, axis=-1) * PEER_N_KEYS
         + jnp.take_along_axis(i2, ci % PEER_TOPK, axis=-1))
    g = jax.nn.softmax(sc, axis=-1)
    nb = T // PEER_TOKEN_BLOCK
    kk = PEER_HEADS * PEER_TOPK
    xb = t.reshape(nb, PEER_TOKEN_BLOCK, D)
    eb = e.reshape(nb, PEER_TOKEN_BLOCK, kk)
    gb = g.reshape(nb, PEER_TOKEN_BLOCK, kk).astype(h.dtype)

    def blk(args):
        xt, et, gt = args
        us = jnp.take(u, et, axis=0)
        a = jax.nn.gelu(jnp.einsum('td,tkd->tk', xt, us), approximate=False) * gt
        vs = jnp.take(v, et, axis=0)
        return jnp.einsum('tk,tkd->td', a, vs)

    return lax.map(blk, (xb, eb, gb)).reshape(B, S, D)


def setup_inputs(seed: int = 0) -> dict:
    key = jax.random.key(seed)
    ks = jax.random.split(key, 26)
    f32 = jnp.float32
    nrm = lambda k, shape, s: jax.random.normal(k, shape, f32) * s
    gain = lambda k, shape: 1.0 + 0.02 * jax.random.normal(k, shape, f32)
    L, D = DEPTH, D_MODEL
    return {
        "x": nrm(ks[0], (BATCH, SEQ, D), 1.0),
        "c": nrm(ks[1], (BATCH, D), 1.0),
        "positions": jnp.broadcast_to(jnp.arange(SEQ, dtype=jnp.int32), (BATCH, SEQ)),
        "w_ada": nrm(ks[2], (L, D, 6 * D), 0.5 * D ** -0.5),
        "b_ada": nrm(ks[3], (L, 6 * D), 0.01),
        "norm1_g": gain(ks[4], (L, D)),
        "w_in": nrm(ks[5], (L, D, IN_W), D ** -0.5),
        "diff_lq1": nrm(ks[6], (L, DA_QK_DIM), 0.1),
        "diff_lk1": nrm(ks[7], (L, DA_QK_DIM), 0.1),
        "diff_lq2": nrm(ks[8], (L, DA_QK_DIM), 0.1),
        "diff_lk2": nrm(ks[9], (L, DA_QK_DIM), 0.1),
        "diff_subln_g": gain(ks[10], (L, DA_V_DIM)),
        "hgrn_lb_fwd": nrm(ks[11], (L + 1, HG_K_W), 0.1),
        "hgrn_lb_bwd": nrm(ks[12], (L + 1, HG_K_W), 0.1),
        "hgrn_norm_g": gain(ks[13], (L, HG_V_DIM)),
        "w_branch_attn": nrm(ks[14], (L, DA_V_W, D), DA_V_W ** -0.5),
        "w_branch_hgrn": nrm(ks[15], (L, HG_V_W, D), HG_V_W ** -0.5),
        "w_out": nrm(ks[16], (L, D, D), D ** -0.5),
        "norm2_g": gain(ks[17], (L, D)),
        "peer_wq": nrm(ks[18], (L, D, PEER_HEADS * PEER_KEY_DIM), D ** -0.5),
        "peer_keys1": nrm(ks[19], (L, PEER_HEADS, PEER_N_KEYS, PEER_HALF), PEER_HALF ** -0.5),
        "peer_keys2": nrm(ks[20], (L, PEER_HEADS, PEER_N_KEYS, PEER_HALF), PEER_HALF ** -0.5),
        "peer_u": nrm(ks[21], (L, PEER_N_EXPERTS, D), D ** -0.5),
        "peer_v": nrm(ks[22], (L, PEER_N_EXPERTS, D), PEER_HEADS ** -0.5),
        "final_norm_g": gain(ks[23], (D,)),
    }


def reference(x, c, positions, w_ada, b_ada, norm1_g, w_in, diff_lq1, diff_lk1, diff_lq2, diff_lk2,
              diff_subln_g, hgrn_lb_fwd, hgrn_lb_bwd, hgrn_norm_g, w_branch_attn, w_branch_hgrn,
              w_out, norm2_g, peer_wq, peer_keys1, peer_keys2, peer_u, peer_v, final_norm_g):
    B, S, D = x.shape
    cos, sin = _rope_tables(positions)
    for l in range(DEPTH):
        ada = jax.nn.silu(c) @ w_ada[l] + b_ada[l]
        shift1, scale1, gate1, shift2, scale2, gate2 = jnp.split(ada, 6, axis=-1)
        h = _modulate(x, norm1_g[l], shift1, scale1)
        parts = jnp.split(h @ w_in[l], SPLIT_IDX, axis=-1)
        da_q, da_k, da_v, hg_q, hg_ff, hg_fb, hg_i, hg_g, g_a, g_b = parts
        qa = _partial_rope(da_q.reshape(B, S, DA_HEADS, 2, DA_QK_DIM), cos, sin)
        ka = _partial_rope(da_k.reshape(B, S, DA_HEADS, 2, DA_QK_DIM), cos, sin)
        va = da_v.reshape(B, S, DA_HEADS, DA_V_DIM)
        lambda_init = 0.8 - 0.6 * float(np.exp(-0.3 * l))
        lam = (jnp.exp(jnp.sum(diff_lq1[l].astype(jnp.float32) * diff_lk1[l].astype(jnp.float32)))
               - jnp.exp(jnp.sum(diff_lq2[l].astype(jnp.float32) * diff_lk2[l].astype(jnp.float32)))
               + lambda_init)
        o_a = _diff_attention(qa, ka, va, lam, lambda_init, diff_subln_g[l])
        o_b = _hgrn2(hg_q, hg_ff, hg_fb, hg_i, hg_g,
                     _layer_lower_bound(hgrn_lb_fwd, l), _layer_lower_bound(hgrn_lb_bwd, l),
                     hgrn_norm_g[l])
        y = (jax.nn.sigmoid(g_a) * (o_a @ w_branch_attn[l])
             + jax.nn.sigmoid(g_b) * (o_b @ w_branch_hgrn[l]))
        x = x + gate1[:, None, :] * (y @ w_out[l])
        h2 = _modulate(x, norm2_g[l], shift2, scale2)
        x = x + gate2[:, None, :] * _peer(h2, peer_wq[l], peer_keys1[l], peer_keys2[l], peer_u[l], peer_v[l])
    return _rmsnorm(x, final_norm_g)
```

```cpp
#define MK_N_LAUNCHES 11
#include <hip/hip_runtime.h>
#include <cstdio>
#include <cstdint>
namespace pg8 {
#define PG8_LAS __attribute__((address_space(3)))
typedef unsigned short bf16_t;
typedef short bf16x8 __attribute__((ext_vector_type(8)));
typedef float f32x4 __attribute__((ext_vector_type(4)));
typedef unsigned u32x4 __attribute__((ext_vector_type(4)));
constexpr int BM = 256, BK = 64, HALF = 128, HTB = HALF * BK * 2  , STAGE_BYTES = 8 * HTB, NXCD = 8, WGM = 8;

__host__ __device__ __forceinline__ int lds_byte(int r, int c) { const int st = (r >> 4) * 2 + (c >> 5), rr = r & 15, cc = c & 31, ob = rr * 64 + cc * 2; return st * 1024 + (ob ^ (((ob >> 9) & 1) << 5)); }
__host__ __device__ __forceinline__ void stage_rc(int b, int& R, int& C) { const int st = b / 1024, sb = b % 1024, swz = sb ^ (((sb >> 9) & 1) << 5); R = (st >> 1) * 16 + swz / 64; C = (st & 1) * 32 + (swz % 64) / 2; }
__host__ __device__ __forceinline__ int perm32(int rho) { const int n = rho >> 4, i = rho & 15; return 8 * (i >> 2) + 4 * n + (i & 3); }

struct Unit { int pm, pn; };
struct Gemm { const bf16_t* A; const bf16_t* Bt; int M, N, K; };

struct StaticOrder {
    int nM, nN, nwg, G, c;
    __host__ __device__ void init(int M, int N, int G_, int c_) { nM = M / BM; nN = N / BM; nwg = nM * nN; G = G_; c = c_; }
    __host__ __device__ bool next(int i, Unit& u) const {
        const long L = (long)i * G + c; if (L >= nwg) return false;
        int wgid = (int)L; { const int q = nwg / NXCD, r = nwg % NXCD, xcd = wgid % NXCD, off = wgid / NXCD; wgid = (xcd < r ? xcd * (q + 1) : r * (q + 1) + (xcd - r) * q) + off; }
        const int nig = WGM * nN, gid = wgid / nig, fm = gid * WGM, gsz = (nM - fm) < WGM ? (nM - fm) : WGM;
        u.pm = fm + ((wgid % nig) % gsz); u.pn = (wgid % nig) / gsz; return true;
    }
    __device__ __forceinline__ void a_ready(const Unit&) const {}
    __device__ __forceinline__ void done(const Unit&) const {}
};

__device__ __forceinline__ unsigned cvt_pk_bf16(float lo, float hi) { unsigned r; asm volatile("v_cvt_pk_bf16_f32 %0, %1, %2" : "=v"(r) : "v"(lo), "v"(hi)); return r; }
typedef float f32x2 __attribute__((ext_vector_type(2)));
__device__ __forceinline__ f32x2 gelu_pk(f32x2 v) {
    const f32x2 av = __builtin_elementwise_abs(v), d = av * 0.2316418882f + 1.0f;
    f32x2 t; t.x = __builtin_amdgcn_rcpf(d.x); t.y = __builtin_amdgcn_rcpf(d.y);
    f32x2 q = t * 0.5307027145f + (-0.7265760135f); q = q * t + 0.7107068705f; q = q * t + (-0.142248368f); q = q * t + 0.127414796f; q = q * t;
    const f32x2 s = (v * v) * (-0.72134752044f);
    f32x2 e; e.x = __builtin_amdgcn_exp2f(s.x); e.y = __builtin_amdgcn_exp2f(s.y);
    const f32x2 m = v * (q * e), r = v - m;
    f32x2 o; o.x = v.x < 0.f ? m.x : r.x; o.y = v.y < 0.f ? m.y : r.y; return o;
}


__device__ __forceinline__ float fsigmoid(float x) { return __builtin_amdgcn_rcpf(1.0f + __expf(-x)); }
__device__ __forceinline__ float bflo(unsigned u) { return __builtin_bit_cast(float, u << 16); }
__device__ __forceinline__ float bfhi(unsigned u) { return __builtin_bit_cast(float, u & 0xffff0000u); }
constexpr float QSCALE = 0.18033688011112042f;

struct EpiPlain {
    static constexpr bool PERM = true, AFTER_DRAIN = false;
    bf16_t* O; int ldc;
    __device__ __forceinline__ void operator()(const f32x4 (&acc)[2][2][4][2], const Unit& u, int wr, int wc, int fr, int fq) const {
        const int row0 = u.pm * BM + wr * 64 + fr, col0 = u.pn * BM + wc * 32 + 8 * fq;
#pragma unroll
        for (int ai = 0; ai < 2; ++ai)
#pragma unroll
            for (int m = 0; m < 4; ++m) { bf16_t* rowp = O + (size_t)(row0 + ai * HALF + m * 16) * ldc + col0;
#pragma unroll
                for (int bj = 0; bj < 2; ++bj) { const f32x4 v0 = acc[ai][bj][m][0], v1 = acc[ai][bj][m][1];
                    u32x4 w; w.x = cvt_pk_bf16(v0[0], v0[1]); w.y = cvt_pk_bf16(v0[2], v0[3]); w.z = cvt_pk_bf16(v1[0], v1[1]); w.w = cvt_pk_bf16(v1[2], v1[3]);
                    *(u32x4*)(rowp + bj * HALF) = w; } }
    }
};

constexpr size_t G1_MiB = 1u << 20, G1_O0 = 140 * G1_MiB, G1_O1 = 172 * G1_MiB, G1_O2 = 204 * G1_MiB, G1_O3 = 236 * G1_MiB, G1_O4 = 332 * G1_MiB, G1_O5 = 364 * G1_MiB, G1_O6 = 268 * G1_MiB, G1_O7 = 300 * G1_MiB, G1_O8 = 396 * G1_MiB, G1_O9 = 460 * G1_MiB;
struct EpiG1 {
    static constexpr bool PERM = true, AFTER_DRAIN = false;
    unsigned char* ws; const float* rope;
    __device__ __forceinline__ void operator()(const f32x4 (&acc)[2][2][4][2], const Unit& u, int wr, int wc, int fr, int fq) const {
        const int pn = u.pn; int part, colt, ldc;
        if (pn < 32) { part = pn >> 2; colt = (pn & 3) * 256; ldc = 1024; } else { part = 8 + ((pn - 32) >> 3); colt = ((pn - 32) & 7) * 256; ldc = 2048; }
        const size_t off = part == 0 ? G1_O0 : part == 1 ? G1_O1 : part == 2 ? G1_O2 : part == 3 ? G1_O3 : part == 4 ? G1_O4 : part == 5 ? G1_O5 : part == 6 ? G1_O6 : part == 7 ? G1_O7 : part == 8 ? G1_O8 : G1_O9;
        bf16_t* base = (bf16_t*)(ws + off);
        const int row0 = u.pm * BM + wr * 64 + fr, col0 = colt + wc * 32 + 8 * fq;
        const int mode = (part <= 1) ? 1 : ((part == 3 || part == 7) ? 2 : (part >= 8 ? 3 : 0));
        const bool do_rope = (mode == 1) && ((wc & 1) == 0);
        const float qs = (part == 0) ? QSCALE : 1.0f;
#pragma unroll
        for (int ai = 0; ai < 2; ++ai)
#pragma unroll
            for (int m = 0; m < 4; ++m) {
                const int row = row0 + ai * HALF + m * 16;
                bf16_t* rowp = base + (size_t)row * ldc + col0;
                f32x4 c4[2], s4[2];
                if (do_rope) { c4[0] = *(const f32x4*)(rope + (size_t)row * 16); c4[1] = *(const f32x4*)(rope + (size_t)row * 16 + 4);
                               s4[0] = *(const f32x4*)(rope + (size_t)row * 16 + 8); s4[1] = *(const f32x4*)(rope + (size_t)row * 16 + 12); }
#pragma unroll
                for (int bj = 0; bj < 2; ++bj) {
                    f32x4 v[2] = {acc[ai][bj][m][0], acc[ai][bj][m][1]};
                    if (mode == 1) {
                        if (do_rope) {
#pragma unroll
                            for (int n = 0; n < 2; ++n)
#pragma unroll
                                for (int i = 0; i < 4; ++i) { const float val = v[n][i]; const float p = __shfl_xor(val, 16);
                                    const float c = c4[n][i], s = s4[n][i];
                                    v[n][i] = (fq == 0) ? (val * c - p * s) : ((fq == 1) ? (val * c + p * s) : val); }
                        }
                        v[0] = v[0] * qs; v[1] = v[1] * qs;
                    } else if (mode == 2) {
#pragma unroll
                        for (int n = 0; n < 2; ++n)
#pragma unroll
                            for (int i = 0; i < 4; ++i) v[n][i] = v[n][i] * fsigmoid(v[n][i]);
                    } else if (mode == 3) {
#pragma unroll
                        for (int n = 0; n < 2; ++n)
#pragma unroll
                            for (int i = 0; i < 4; ++i) v[n][i] = fsigmoid(v[n][i]);
                    }
                    u32x4 w; w.x = cvt_pk_bf16(v[0][0], v[0][1]); w.y = cvt_pk_bf16(v[0][2], v[0][3]); w.z = cvt_pk_bf16(v[1][0], v[1][1]); w.w = cvt_pk_bf16(v[1][2], v[1][3]);
                    *(u32x4*)(rowp + bj * HALF) = w;
                }
            }
    }
};

template <bool ADD> struct EpiGate {
    static constexpr bool PERM = true, AFTER_DRAIN = false;
    bf16_t* Y; const bf16_t* G; int ldc;
    __device__ __forceinline__ void operator()(const f32x4 (&acc)[2][2][4][2], const Unit& u, int wr, int wc, int fr, int fq) const {
        const int row0 = u.pm * BM + wr * 64 + fr, col0 = u.pn * BM + wc * 32 + 8 * fq;
#pragma unroll
        for (int ai = 0; ai < 2; ++ai)
#pragma unroll
            for (int m = 0; m < 4; ++m) { const size_t ro = (size_t)(row0 + ai * HALF + m * 16) * ldc + col0;
#pragma unroll
                for (int bj = 0; bj < 2; ++bj) { const f32x4 v0 = acc[ai][bj][m][0], v1 = acc[ai][bj][m][1];
                    const u32x4 g = *(const u32x4*)(G + ro + bj * HALF);
                    float r[8] = {v0[0] * bflo(g.x), v0[1] * bfhi(g.x), v0[2] * bflo(g.y), v0[3] * bfhi(g.y), v1[0] * bflo(g.z), v1[1] * bfhi(g.z), v1[2] * bflo(g.w), v1[3] * bfhi(g.w)};
                    if (ADD) { const u32x4 y = *(const u32x4*)(Y + ro + bj * HALF);
                        r[0] += bflo(y.x); r[1] += bfhi(y.x); r[2] += bflo(y.y); r[3] += bfhi(y.y); r[4] += bflo(y.z); r[5] += bfhi(y.z); r[6] += bflo(y.w); r[7] += bfhi(y.w); }
                    u32x4 w; w.x = cvt_pk_bf16(r[0], r[1]); w.y = cvt_pk_bf16(r[2], r[3]); w.z = cvt_pk_bf16(r[4], r[5]); w.w = cvt_pk_bf16(r[6], r[7]);
                    *(u32x4*)(Y + ro + bj * HALF) = w; } }
    }
};

struct EpiResGate {
    static constexpr bool PERM = false, AFTER_DRAIN = false;
    const float* base; float* out; const float* gate; int ldc; int gate_ld; int rows_per_batch;
    __device__ __forceinline__ void operator()(const f32x4 (&acc)[2][2][4][2], const Unit& u, int wr, int wc, int fr, int fq) const {
        const int row0 = u.pm * BM + wr * 64 + fr, col0 = u.pn * BM + wc * 32 + 4 * fq;
        const float* gp = gate + (size_t)((u.pm * BM) / rows_per_batch) * gate_ld + col0;
        f32x4 gv[2][2];
#pragma unroll
        for (int bj = 0; bj < 2; ++bj)
#pragma unroll
            for (int n = 0; n < 2; ++n) gv[bj][n] = *(const f32x4*)(gp + bj * HALF + n * 16);
#pragma unroll
        for (int ai = 0; ai < 2; ++ai)
#pragma unroll
            for (int m = 0; m < 4; ++m) { const size_t ro = (size_t)(row0 + ai * HALF + m * 16) * ldc + col0;
#pragma unroll
                for (int bj = 0; bj < 2; ++bj)
#pragma unroll
                    for (int n = 0; n < 2; ++n) { const f32x4 xb = *(const f32x4*)(base + ro + bj * HALF + n * 16);
                        *(f32x4*)(out + ro + bj * HALF + n * 16) = xb + gv[bj][n] * acc[ai][bj][m][n]; } }
    }
};
template <class Epi, class Sched, bool ALIGN_EPI = false, bool SP2 = false>
__device__ __forceinline__ void gemm_phase(PG8_LAS unsigned char* lds, const Gemm g, const Sched& S, const Epi& E) {
    const int tid = threadIdx.x, wid = __builtin_amdgcn_readfirstlane(tid >> 6), lane = tid & 63, wr = wid >> 2, wc = wid & 3, fr = lane & 15, fq = lane >> 4;
    const int K = g.K, nt = K / BK;
    unsigned voffA[2], voffB[2];
#pragma unroll
    for (int i = 0; i < 2; ++i) { int R, C; stage_rc(tid * 16 + i * 8192, R, C); const int Rb = Epi::PERM ? ((R & ~31) + perm32(R & 31)) : R;
        voffA[i] = (unsigned)(R * K + C) * 2u; voffB[i] = (unsigned)(Rb * K + C) * 2u; }
    const size_t kstep = (size_t)(BK * 2);
    const size_t hstep = (size_t)HALF * K * 2;
    const size_t tstep = 2 * hstep;
    const unsigned ldsw = (unsigned)wid * 1024u;
    const int aoff = lds_byte(wr * 64 + fr, fq * 8), boff = lds_byte(wc * 32 + fr, fq * 8);
#define PG8_SA(b, h) (((b) * 2 + (h)) * HTB)
#define PG8_SB(b, h) ((4 + (b) * 2 + (h)) * HTB)
#define PG8_STAGE(bufoff, gbase, voff) do { _Pragma("unroll") for (int _i = 0; _i < 2; ++_i) \
        __builtin_amdgcn_global_load_lds((const unsigned*)((const char*)(gbase) + (voff)[_i]), (PG8_LAS unsigned*)(lds + (bufoff) + ldsw + _i * 8192), 16, 0, 0); } while (0)
#define PG8_LDA(dst, b, h) do { _Pragma("unroll") for (int m = 0; m < 4; ++m) _Pragma("unroll") for (int k = 0; k < 2; ++k) dst[m][k] = *(const PG8_LAS bf16x8*)(lds + PG8_SA(b, h) + aoff + m * 2048 + k * 1024); } while (0)
#define PG8_LDB(dst, b, h) do { _Pragma("unroll") for (int n = 0; n < 2; ++n) _Pragma("unroll") for (int k = 0; k < 2; ++k) dst[n][k] = *(const PG8_LAS bf16x8*)(lds + PG8_SB(b, h) + boff + n * 2048 + k * 1024); } while (0)
#define PG8_MMA(ai, bj, At, Bt) do { __builtin_amdgcn_s_setprio(1); _Pragma("unroll") for (int m = 0; m < 4; ++m) _Pragma("unroll") for (int n = 0; n < 2; ++n) _Pragma("unroll") for (int k = 0; k < 2; ++k) \
        acc[ai][bj][m][n] = __builtin_amdgcn_mfma_f32_16x16x32_bf16(Bt[n][k], At[m][k], acc[ai][bj][m][n], 0, 0, 0); __builtin_amdgcn_s_setprio(0); } while (0)
#define PG8_WAIT_V(n) asm volatile("s_waitcnt vmcnt(" #n ")" ::: "memory")
#define PG8_WAIT_L(n) asm volatile("s_waitcnt lgkmcnt(" #n ")" ::: "memory")
#define PG8_BAR __builtin_amdgcn_s_barrier()
#define PG8_SCHED __builtin_amdgcn_sched_barrier(0)
    Unit cur, nxt; int ui = 0;
    if (!S.next(0, cur)) return;
    f32x4 acc[2][2][4][2];
#pragma unroll
    for (int a = 0; a < 2; ++a)
#pragma unroll
        for (int b = 0; b < 2; ++b)
#pragma unroll
            for (int m = 0; m < 4; ++m)
#pragma unroll
                for (int n = 0; n < 2; ++n) acc[a][b][m][n] = (f32x4){0.f, 0.f, 0.f, 0.f};
    bf16x8 At[4][2], B0[2][2], B1[2][2];
    const char* cA = (const char*)g.A + (size_t)cur.pm * tstep; const char* cB = (const char*)g.Bt + (size_t)cur.pn * tstep;
    S.a_ready(cur);
    if constexpr (SP2) {
        PG8_STAGE(PG8_SB(0, 0), cB, voffB); PG8_STAGE(PG8_SB(0, 1), cB + hstep, voffB); PG8_STAGE(PG8_SA(0, 0), cA, voffA); PG8_STAGE(PG8_SA(0, 1), cA + hstep, voffA);
        if (wr == 1) PG8_BAR;
        PG8_WAIT_V(2); PG8_BAR;
        PG8_STAGE(PG8_SB(1, 0), cB + kstep, voffB); PG8_STAGE(PG8_SA(1, 0), cA + kstep, voffA); PG8_STAGE(PG8_SB(1, 1), cB + hstep + kstep, voffB);
        PG8_WAIT_V(6); PG8_BAR;
    } else {
        PG8_STAGE(PG8_SB(0, 0), cB, voffB); PG8_STAGE(PG8_SA(0, 0), cA, voffA); PG8_STAGE(PG8_SB(0, 1), cB + hstep, voffB); PG8_STAGE(PG8_SA(0, 1), cA + hstep, voffA);
        if (wr == 1) PG8_BAR;
        PG8_WAIT_V(4); PG8_BAR;
        PG8_STAGE(PG8_SB(1, 0), cB + kstep, voffB); PG8_STAGE(PG8_SA(1, 0), cA + kstep, voffA); PG8_STAGE(PG8_SB(1, 1), cB + hstep + kstep, voffB);
        PG8_WAIT_V(6); PG8_BAR;
    }
    for (;;) {
        const bool has_next = S.next(ui + 1, nxt);
        const char* nA = has_next ? (const char*)g.A + (size_t)nxt.pm * tstep : cA; const char* nB = has_next ? (const char*)g.Bt + (size_t)nxt.pn * tstep : cB;
        for (int t = 0; t < nt; t += 2) {
            const bool last = (t == nt - 2);
            const char* a1 = cA + (size_t)(t + 1) * kstep;
            const char* a2 = last ? nA : cA + (size_t)(t + 2) * kstep; const char* b2 = last ? nB : cB + (size_t)(t + 2) * kstep;
            const char* a3 = a2 + kstep; const char* b3 = b2 + kstep;
            if (last && has_next) S.a_ready(nxt);
            if constexpr (SP2) {
            PG8_LDB(B0, 0, 0); PG8_LDB(B1, 0, 1); PG8_SCHED; PG8_LDA(At, 0, 0); PG8_STAGE(PG8_SA(1, 1), a1 + hstep, voffA);
            PG8_WAIT_V(8); PG8_WAIT_L(0); PG8_BAR; PG8_MMA(0, 0, At, B0); PG8_MMA(0, 1, At, B1); PG8_BAR; PG8_SCHED;
            PG8_LDA(At, 0, 1); PG8_STAGE(PG8_SB(0, 0), b2, voffB); PG8_STAGE(PG8_SB(0, 1), b2 + hstep, voffB); PG8_STAGE(PG8_SA(0, 0), a2, voffA);
            PG8_WAIT_V(8); PG8_WAIT_L(0); PG8_BAR; PG8_MMA(1, 0, At, B0); PG8_MMA(1, 1, At, B1); PG8_BAR; PG8_SCHED;
            PG8_LDB(B0, 1, 0); PG8_LDB(B1, 1, 1); PG8_SCHED; PG8_LDA(At, 1, 0); PG8_STAGE(PG8_SA(0, 1), a2 + hstep, voffA);
            PG8_WAIT_V(8); PG8_WAIT_L(0); PG8_BAR; PG8_MMA(0, 0, At, B0); PG8_MMA(0, 1, At, B1); PG8_BAR; PG8_SCHED;
            PG8_LDA(At, 1, 1); PG8_STAGE(PG8_SB(1, 0), b3, voffB); PG8_STAGE(PG8_SB(1, 1), b3 + hstep, voffB); PG8_STAGE(PG8_SA(1, 0), a3, voffA);
            PG8_WAIT_V(8); PG8_WAIT_L(0); PG8_BAR; PG8_MMA(1, 0, At, B0); PG8_MMA(1, 1, At, B1); PG8_BAR; PG8_SCHED;
            } else {
            PG8_LDB(B0, 0, 0); PG8_SCHED; PG8_LDA(At, 0, 0); PG8_STAGE(PG8_SA(1, 1), a1 + hstep, voffA);
            PG8_WAIT_L(8); PG8_BAR; PG8_WAIT_L(0); PG8_MMA(0, 0, At, B0); PG8_BAR; PG8_SCHED;
            PG8_LDB(B1, 0, 1); PG8_STAGE(PG8_SB(0, 0), b2, voffB);
            PG8_BAR; PG8_WAIT_L(0); PG8_MMA(0, 1, At, B1); PG8_BAR;
            PG8_LDA(At, 0, 1); PG8_STAGE(PG8_SA(0, 0), a2, voffA);
            PG8_BAR; PG8_WAIT_L(0); PG8_MMA(1, 0, At, B0); PG8_BAR; PG8_SCHED;
            PG8_STAGE(PG8_SB(0, 1), b2 + hstep, voffB);
            PG8_WAIT_V(6); PG8_BAR; PG8_MMA(1, 1, At, B1); PG8_BAR;
            PG8_LDB(B0, 1, 0); PG8_SCHED; PG8_LDA(At, 1, 0); PG8_STAGE(PG8_SA(0, 1), a2 + hstep, voffA);
            PG8_WAIT_L(8); PG8_BAR; PG8_WAIT_L(0); PG8_MMA(0, 0, At, B0); PG8_BAR; PG8_SCHED;
            PG8_LDB(B1, 1, 1); PG8_STAGE(PG8_SB(1, 0), b3, voffB);
            PG8_BAR; PG8_WAIT_L(0); PG8_MMA(0, 1, At, B1); PG8_BAR;
            PG8_LDA(At, 1, 1); PG8_STAGE(PG8_SA(1, 0), a3, voffA);
            PG8_BAR; PG8_WAIT_L(0); PG8_MMA(1, 0, At, B0); PG8_BAR; PG8_SCHED;
            PG8_STAGE(PG8_SB(1, 1), b3 + hstep, voffB);
            PG8_WAIT_V(6); PG8_BAR; PG8_MMA(1, 1, At, B1); PG8_BAR;
            }
        }
        if constexpr (ALIGN_EPI) { if (wr == 0) PG8_BAR; }
        if constexpr (!Epi::AFTER_DRAIN) { E(acc, cur, wr, wc, fr, fq); S.done(cur); }
        if (!has_next) break;
#pragma unroll
        for (int a = 0; a < 2; ++a)
#pragma unroll
            for (int b = 0; b < 2; ++b)
#pragma unroll
                for (int m = 0; m < 4; ++m)
#pragma unroll
                    for (int n = 0; n < 2; ++n) acc[a][b][m][n] = (f32x4){0.f, 0.f, 0.f, 0.f};
        cur = nxt; cA = nA; cB = nB; ++ui;
        if constexpr (ALIGN_EPI) { if (wr == 1) PG8_BAR; }
    }
    PG8_WAIT_V(0);
    if constexpr (!ALIGN_EPI) { if (wr == 0) PG8_BAR; }
    PG8_BAR;
    if constexpr (Epi::AFTER_DRAIN) { E.fused(acc, cur, wr, wc, fr, fq, lds, wid, lane); S.done(cur); }
#undef PG8_SA
#undef PG8_SB
#undef PG8_STAGE
#undef PG8_LDA
#undef PG8_LDB
#undef PG8_MMA
#undef PG8_WAIT_V
#undef PG8_WAIT_L
#undef PG8_BAR
#undef PG8_SCHED
}
}

constexpr int NWAVES = 8;
#ifndef MK_N_LAUNCHES
#define MK_N_LAUNCHES 1
#endif
constexpr int N_PHASES = 11;
constexpr int N_LAUNCHES = MK_N_LAUNCHES;

constexpr int BATCH = 8, SEQ = 2048, DM = 2048, T = BATCH * SEQ;
constexpr int IN_W = 12288, ADA_W = 6 * DM;
constexpr float EPS = 1e-6f;
constexpr float LAMBDA_INIT = 0.2f;
constexpr float THRL = 11.541560327111707f;

constexpr size_t MiB = 1u << 20;
constexpr size_t WS_CTL = 0, CTL_ZERO_BYTES = 64 * 1024;
constexpr size_t WS_ADA = 256 * 1024;
constexpr size_t WS_ROPE = 1 * MiB;
constexpr size_t WS_WIN = 4 * MiB;
constexpr size_t WS_OA = WS_WIN;
constexpr size_t WS_WA = 52 * MiB, WS_WB = 56 * MiB, WS_WOUT = 60 * MiB, WS_WQ = 68 * MiB;
constexpr size_t WS_H = 76 * MiB;
constexpr size_t WS_OF = WS_H, WS_H2 = WS_H;
constexpr size_t WS_DAQ = 140 * MiB, WS_DAK = 172 * MiB, WS_DAV = 204 * MiB;
constexpr size_t WS_Y = WS_DAQ;
constexpr size_t WS_OB = WS_DAV;
constexpr size_t WS_HGQ = 236 * MiB, WS_HGI = 268 * MiB, WS_HGG = 300 * MiB, WS_HFF = 332 * MiB, WS_HFB = 364 * MiB;
constexpr size_t WS_U8 = 236 * MiB, WS_V8 = 300 * MiB;
constexpr size_t WS_GA = 396 * MiB, WS_GB = 460 * MiB;
constexpr size_t WS_QP = WS_GA;
constexpr size_t WS_EIDX = WS_GB, WS_EG = WS_GB + 8 * MiB;
constexpr size_t WS_OBW = 524 * MiB;
constexpr size_t WS_STASH = 588 * MiB;
constexpr size_t WS_END = 620 * MiB;

constexpr int CW_TMO = 0, CW_CODE = 1, CW_CHK = 2;
constexpr int CW_BAR = 1024;

constexpr int RING_OFF = 0, RING_BYTES = 131072;
constexpr int LDSCTL_OFF = RING_BYTES, MISC_OFF = LDSCTL_OFF + 320;
constexpr int LDS_BYTES = 147456;
static_assert(pg8::G1_O0 == WS_DAQ && pg8::G1_O1 == WS_DAK && pg8::G1_O2 == WS_DAV && pg8::G1_O3 == WS_HGQ && pg8::G1_O4 == WS_HFF && pg8::G1_O5 == WS_HFB && pg8::G1_O6 == WS_HGI && pg8::G1_O7 == WS_HGG && pg8::G1_O8 == WS_GA && pg8::G1_O9 == WS_GB, "G1 part offsets");
#define GAS __attribute__((address_space(1)))
#define LAS __attribute__((address_space(3)))
typedef unsigned short bf16;
typedef unsigned v4u __attribute__((ext_vector_type(4)));
typedef float f32x4 __attribute__((ext_vector_type(4)));
typedef short bf16x8 __attribute__((ext_vector_type(8)));
typedef GAS unsigned gu32;
typedef GAS unsigned long long gu64;
#define RLX_AGENT __ATOMIC_RELAXED, __HIP_MEMORY_SCOPE_AGENT
#define LDS_WAIT() asm volatile("s_waitcnt lgkmcnt(0)" ::: "memory")
#define VM_WAIT() asm volatile("s_waitcnt vmcnt(0)" ::: "memory")
__device__ __forceinline__ unsigned long long rt() { return __builtin_amdgcn_s_memrealtime(); }
__device__ __forceinline__ unsigned f2bf(float f) { unsigned u = __builtin_bit_cast(unsigned, f); return (u + 0x7fffu + ((u >> 16) & 1u)) >> 16; }
__device__ __forceinline__ unsigned pk2(float lo, float hi) { return f2bf(lo) | (f2bf(hi) << 16); }

#define XB_TMO      128
#define XB_XCNT(j)  (256  + 64 * (j))
#define XB_XSUB(j)  (1280 + 64 * (j))
#define XB_XGEN(j)  (2304 + 64 * (j))
#define XB_TOP      3328
#define XB_TOPGEN   3392
#define XCD_BAR_WORDS 3456
#define XB_SPIN_CAP (1u << 18)

__device__ __forceinline__ unsigned xb_ld(unsigned* p)              { return __hip_atomic_load(p, __ATOMIC_RELAXED, __HIP_MEMORY_SCOPE_AGENT); }
__device__ __forceinline__ unsigned xb_add(unsigned* p, unsigned v) { return __hip_atomic_fetch_add(p, v, __ATOMIC_RELAXED, __HIP_MEMORY_SCOPE_AGENT); }
__device__ __forceinline__ unsigned xb_xcc_id() { return (unsigned)__builtin_amdgcn_s_getreg((3 << 11) | 20) & 0xFu; }
#define XB_SPIN(cond, bar) do { unsigned _sp = 0; while (cond) { __builtin_amdgcn_s_sleep(1); \
    if ((++_sp & 255u) == 0u) { if (xb_ld(&(bar)[XB_TMO])) break; if (_sp > XB_SPIN_CAP) { atomicAdd(&(bar)[XB_TMO], 1u); break; } } } } while (0)

struct XcdBarrier {
    unsigned* bar; unsigned x;
    volatile LAS unsigned* st;
};

__device__ __forceinline__ XcdBarrier xcd_barrier_post(unsigned* bar, volatile LAS unsigned* st) {
    XcdBarrier b; b.bar = bar; b.x = xb_xcc_id(); b.st = st;
    if (threadIdx.x == 0) (void)xb_add(&bar[XB_XCNT(b.x)], 1u);
    return b;
}
__device__ __forceinline__ void xcd_barrier_complete(unsigned* bar, unsigned x, unsigned& nloc, unsigned& nx) {
    const unsigned G = gridDim.x * gridDim.y * gridDim.z;
    unsigned sum, cnt, mine, sp = 0u;
    for (;;) {
        sum = 0u; cnt = 0u; mine = 0u;
#pragma unroll
        for (unsigned j = 0; j < 16; ++j) { const unsigned c = xb_ld(&bar[XB_XCNT(j)]); sum += c; cnt += (c > 0u) ? 1u : 0u; mine = (j == x) ? c : mine; }
        if (sum == G) break;
        __builtin_amdgcn_s_sleep(1);
        if ((++sp & 255u) == 0u) { if (xb_ld(&bar[XB_TMO])) break; if (sp > XB_SPIN_CAP) { atomicAdd(&bar[XB_TMO], 1u); break; } }
    }
    nloc = mine > 0u ? mine : 1u; nx = cnt > 0u ? cnt : 1u;
}

__device__ __forceinline__ void xcd_barrier(const XcdBarrier& b) {
    asm volatile("s_waitcnt vmcnt(0)" ::: "memory");
    __syncthreads();
    if (threadIdx.x == 0) {
        unsigned* bar = b.bar;
        __builtin_amdgcn_s_waitcnt(0);
        unsigned nloc = b.st[0], nx = b.st[1];
        if (nloc == 0u) { xcd_barrier_complete(bar, b.x, nloc, nx); b.st[0] = nloc; b.st[1] = nx; }
        const unsigned old = xb_add(&bar[XB_XSUB(b.x)], 1u);
        const unsigned gen = old / nloc;
        if (old + 1u == (gen + 1u) * nloc) {
            __builtin_amdgcn_fence(__ATOMIC_RELEASE, "agent");
            asm volatile("s_waitcnt vmcnt(0)" ::: "memory");
            const unsigned og = xb_add(&bar[XB_TOP], 1u);
            const unsigned tg = og / nx;
            if (og + 1u == (tg + 1u) * nx) xb_add(&bar[XB_TOPGEN], 1u);
            else XB_SPIN(xb_ld(&bar[XB_TOPGEN]) == tg, bar);
            __builtin_amdgcn_fence(__ATOMIC_ACQUIRE, "agent");
            xb_add(&bar[XB_XGEN(b.x)], 1u);
            asm volatile("s_waitcnt vmcnt(0)" ::: "memory");
        } else {
            XB_SPIN(xb_ld(&bar[XB_XGEN(b.x)]) == gen, bar);
            __builtin_amdgcn_fence(__ATOMIC_ACQUIRE, "agent");
            asm volatile("s_waitcnt vmcnt(0)" ::: "memory");
        }
    }
    __syncthreads();
}

typedef float f32x16 __attribute__((ext_vector_type(16)));
typedef short s16x4 __attribute__((ext_vector_type(4)));
typedef __bf16 bf16x2v __attribute__((ext_vector_type(2)));
typedef float f32x2v __attribute__((ext_vector_type(2)));

struct Frame {
    LAS unsigned char* lds;
    unsigned char* ldsg;
    volatile LAS unsigned* MISC;
    gu32* ctl;
    int tid, lane, wave;
    int vcu, G;
    unsigned char* ws;
    float* out;
};
#define IN_F(k) ((const float*)args.in[k])

__device__ __forceinline__ float wave_sum(float v) {
#pragma unroll
    for (int o = 1; o < 64; o <<= 1) v += __shfl_xor(v, o);
    return v;
}
__device__ __forceinline__ float fsig(float x) { return __builtin_amdgcn_rcpf(1.0f + __expf(-x)); }
__device__ __forceinline__ float bf_lo(unsigned u) { return __builtin_bit_cast(float, u << 16); }
__device__ __forceinline__ float bf_hi(unsigned u) { return __builtin_bit_cast(float, u & 0xffff0000u); }
__device__ __forceinline__ unsigned cvtpk(float lo, float hi) { f32x2v v = {lo, hi}; bf16x2v b = __builtin_convertvector(v, bf16x2v); return __builtin_bit_cast(unsigned, b); }
__device__ __forceinline__ float dot2bf(unsigned a, unsigned b, float acc) { return __builtin_amdgcn_fdot2_f32_bf16(__builtin_bit_cast(bf16x2v, a), __builtin_bit_cast(bf16x2v, b), acc, false); }

__device__ __forceinline__ void p0_transpose_item(const float* W, int K, int N, bf16* WT, LAS float* scr, int item, int lane) {
    const int nblk = N / 32, kb = item / nblk, nb = item % nblk, k0 = 64 * kb, n0 = 32 * nb;
#pragma unroll 8
    for (int i = 0; i < 32; ++i) { const int kk = 2 * i + (lane >> 5); scr[kk * 33 + (lane & 31)] = W[(size_t)(k0 + kk) * N + n0 + (lane & 31)]; }
    LDS_WAIT(); asm volatile("" ::: "memory");
    const int c = lane & 7;
#pragma unroll
    for (int j = 0; j < 4; ++j) { const int n = (lane >> 3) + 8 * j; const LAS float* s = scr + (8 * c) * 33 + n;
        v4u o; o.x = pk2(s[0 * 33], s[1 * 33]); o.y = pk2(s[2 * 33], s[3 * 33]); o.z = pk2(s[4 * 33], s[5 * 33]); o.w = pk2(s[6 * 33], s[7 * 33]);
        *(GAS v4u*)(WT + (size_t)(n0 + n) * K + k0 + 8 * c) = o; }
    LDS_WAIT(); asm volatile("" ::: "memory");
}
__device__ __forceinline__ void p0_ada_item(Frame& F, const float* c, const float* W, const float* bias, float* ada, int item) {
    const int n0 = item * 64, lane = F.lane, w = F.wave;
    float acc[8];
#pragma unroll
    for (int b = 0; b < 8; ++b) acc[b] = 0.f;
    for (int kb = 0; kb < 4; ++kb) {
        const int k0 = 256 * w + 64 * kb;
        float sc[8];
#pragma unroll
        for (int b = 0; b < 8; ++b) { const float cv = c[b * DM + k0 + lane]; sc[b] = cv * fsig(cv); }
#pragma unroll
        for (int g = 0; g < 4; ++g) {
            float wv[16];
#pragma unroll
            for (int i = 0; i < 16; ++i) wv[i] = W[(size_t)(k0 + g * 16 + i) * ADA_W + n0 + lane];
#pragma unroll
            for (int i = 0; i < 16; ++i)
#pragma unroll
                for (int b = 0; b < 8; ++b) { const float s = __builtin_bit_cast(float, __builtin_amdgcn_readlane(__builtin_bit_cast(int, sc[b]), g * 16 + i)); acc[b] += s * wv[i]; }
        }
    }
    LAS float* red = (LAS float*)(F.lds + RING_OFF);
#pragma unroll
    for (int b = 0; b < 8; ++b) red[(w * 8 + b) * 64 + lane] = acc[b];
    __syncthreads();
    { const int b = F.tid >> 6, col = F.tid & 63; float s = 0.f;
#pragma unroll
      for (int ww = 0; ww < 8; ++ww) s += red[(ww * 8 + b) * 64 + col];
      ada[b * ADA_W + n0 + col] = s + bias[n0 + col]; }
    __syncthreads();
}
__device__ __forceinline__ void p0_prologue(Frame& F, const float* c, const int* positions, const float* w_ada, const float* b_ada,
                                            const float* w_in, const float* w_ba, const float* w_bh, const float* w_out, const float* w_q) {
    float* ada = (float*)(F.ws + WS_ADA);
    for (int it = F.vcu; it < ADA_W / 64; it += F.G) p0_ada_item(F, c, w_ada, b_ada, ada, it);
    { const double inv[8] = {1.0, 0.19392274474868576, 0.03760603093086393, 0.007292664737217109, 0.001414213562373095, 0.0002742481756762073, 5.318295896944988e-05, 1.031338537721246e-05};
      float* rope = (float*)(F.ws + WS_ROPE);
      for (int idx = F.vcu * 512 + F.tid; idx < T * 8; idx += F.G * 512) { const int t = idx >> 3, j = idx & 7;
          double iv = inv[0];
#pragma unroll
          for (int q = 1; q < 8; ++q) iv = (j == q) ? inv[q] : iv;
          const double rev = (double)positions[t] * iv * 0.15915494309189535;
          const float fr = (float)(rev - __builtin_rint(rev));
          rope[(size_t)t * 16 + j] = __builtin_amdgcn_cosf(fr); rope[(size_t)t * 16 + 8 + j] = __builtin_amdgcn_sinf(fr); } }
    LAS float* scr = (LAS float*)(F.lds + RING_OFF + 16384 + F.wave * 12288);
    const int gw = F.vcu * NWAVES + F.wave, NGW = F.G * NWAVES;
    constexpr int I_IN = (DM / 64) * (IN_W / 32), I_B = (1024 / 64) * (DM / 32), I_O = (DM / 64) * (DM / 32);
    constexpr int NITEMS = I_IN + 2 * I_B + 2 * I_O;
    for (int it = gw; it < NITEMS; it += NGW) {
        int r = it;
        if (r < I_IN) { p0_transpose_item(w_in, DM, IN_W, (bf16*)(F.ws + WS_WIN), scr, r, F.lane); continue; } r -= I_IN;
        if (r < I_B) { p0_transpose_item(w_ba, 1024, DM, (bf16*)(F.ws + WS_WA), scr, r, F.lane); continue; } r -= I_B;
        if (r < I_B) { p0_transpose_item(w_bh, 1024, DM, (bf16*)(F.ws + WS_WB), scr, r, F.lane); continue; } r -= I_B;
        if (r < I_O) { p0_transpose_item(w_out, DM, DM, (bf16*)(F.ws + WS_WOUT), scr, r, F.lane); continue; } r -= I_O;
        p0_transpose_item(w_q, DM, DM, (bf16*)(F.ws + WS_WQ), scr, r, F.lane);
    }
}

__device__ __forceinline__ void mod_rows(Frame& F, const float* X, const float* g, const float* shift, const float* scale, bf16* O) {
    const int gw = F.vcu * NWAVES + F.wave, NGW = F.G * NWAVES, lane = F.lane;
    for (int m = gw; m < T; m += NGW) {
        const int b = m / SEQ;
        const GAS f32x4* xr = (const GAS f32x4*)(X + (size_t)m * DM) + lane;
        f32x4 v[8]; float s = 0.f;
#pragma unroll
        for (int j = 0; j < 8; ++j) { v[j] = xr[64 * j]; s += (v[j].x * v[j].x + v[j].y * v[j].y) + (v[j].z * v[j].z + v[j].w * v[j].w); }
        const float rstd = __builtin_amdgcn_rsqf(wave_sum(s) * (1.0f / DM) + EPS);
        GAS unsigned long long* o8 = (GAS unsigned long long*)(O + (size_t)m * DM) + lane;
#pragma unroll
        for (int j = 0; j < 8; ++j) { const int col = (64 * j + lane) * 4;
            const f32x4 gg = *(const f32x4*)(g + col), sc = *(const f32x4*)(scale + (size_t)b * ADA_W + col), sh = *(const f32x4*)(shift + (size_t)b * ADA_W + col);
            const f32x4 h = v[j] * rstd * gg * (sc + 1.0f) + sh;
            o8[64 * j] = (unsigned long long)cvtpk(h.x, h.y) | ((unsigned long long)cvtpk(h.z, h.w) << 32); }
    }
}

namespace hg {
constexpr int LQ = 272, LV = 144;
constexpr int O_QI = 0, O_KI = 17408, O_QB = 34816, O_KDT = 52224, O_VT = 70656, O_AM = 79872, O_ST = 89088, O_PART = 106496, O_A = 110592, O_END = 111104;
typedef short bf16x8 __attribute__((ext_vector_type(8)));
typedef float f32x4 __attribute__((ext_vector_type(4)));
__device__ __forceinline__ bf16x8 ldfrag(const LAS unsigned char* p) { return *(const LAS bf16x8*)p; }
}
__device__ __forceinline__ void hgrn_item(Frame& F, int item, const float* lb_fwd, const float* lb_bwd) {
    using namespace hg;
    const int b = item >> 5, h = (item >> 2) & 7, dir = (item >> 1) & 1, vh = item & 1;
    LAS unsigned char* L = F.lds + RING_OFF;
    const int tid = F.tid, lane = F.lane, w = F.wave;
    const int d0 = 2 * lane;
    float lb[2];
    { const float* tbl = dir ? lb_bwd : lb_fwd;
#pragma unroll
      for (int i = 0; i < 2; ++i) { const float t0 = tbl[h * 128 + d0 + i], t1 = tbl[1024 + h * 128 + d0 + i]; lb[i] = 1.0f / (1.0f + __expf(t0 - t1)); } }
    f32x4 st[4];
#pragma unroll
    for (int i = 0; i < 4; ++i) st[i] = (f32x4){0.f, 0.f, 0.f, 0.f};
    for (int i = tid; i < 17408 / 4; i += 512) ((LAS unsigned*)(L + O_ST))[i] = 0u;
    const size_t rowbase = (size_t)b * SEQ;
    const bf16* Qg = (const bf16*)(F.ws + WS_HGQ) + rowbase * 1024 + h * 128 + d0;
    const bf16* Fg = (const bf16*)(F.ws + (dir ? WS_HFB : WS_HFF)) + rowbase * 1024 + h * 128 + d0;
    const int vp = tid & 31, pg = (tid >> 5) & 7;
    const bf16* Vg = (const bf16*)(F.ws + WS_HGI) + rowbase * 1024 + h * 128 + vh * 64 + 2 * vp;
    float* Og = (float*)(F.ws + (dir ? WS_OBW : WS_OF)) + rowbase * 1024 + h * 128 + vh * 64;
    unsigned qraw[8], fraw[8], vraw[8];
#define HG_LOAD(ch) do { const size_t t0_ = (size_t)(ch) * 64; \
        _Pragma("unroll") for (int p = 0; p < 8; ++p) { qraw[p] = *(const unsigned*)(Qg + (t0_ + 8 * w + p) * 1024); fraw[p] = *(const unsigned*)(Fg + (t0_ + 8 * w + p) * 1024); } \
        if (tid < 256) { _Pragma("unroll") for (int p = 0; p < 8; ++p) vraw[p] = *(const unsigned*)(Vg + (t0_ + 8 * pg + p) * 1024); } } while (0)
    HG_LOAD(dir ? 31 : 0);
    __syncthreads();
    const int tb = w >> 1, hf = w & 1, l15 = lane & 15, l4 = lane >> 4;
    for (int c = 0; c < 32; ++c) {
        const int ch = dir ? 31 - c : c;
        float lf[8][2], kk[8][2], qq[8][2];
#pragma unroll
        for (int p = 0; p < 8; ++p) {
#pragma unroll
            for (int i = 0; i < 2; ++i) { const float x = i ? bf_hi(fraw[p]) : bf_lo(fraw[p]); const float sg = fsig(x); const float f = lb[i] + (1.0f - lb[i]) * sg;
                lf[p][i] = __logf(f); kk[p][i] = 1.0f - f; qq[p][i] = i ? bf_hi(qraw[p]) : bf_lo(qraw[p]); } }
        float bl[8][2], tot[2];
#pragma unroll
        for (int i = 0; i < 2; ++i) { float run = 0.f;
            if (!dir) {
#pragma unroll
                for (int p = 0; p < 8; ++p) { run += lf[p][i]; bl[p][i] = run; }
            } else {
#pragma unroll
                for (int p = 7; p >= 0; --p) { run += lf[p][i]; bl[p][i] = run; }
            }
            tot[i] = run; }
        { LAS float* part = (LAS float*)(L + O_PART); *(LAS f32x2v*)(part + w * 128 + d0) = (f32x2v){tot[0], tot[1]}; }
        __syncthreads();
        float offs[2] = {0.f, 0.f}, rr[2] = {0.f, 0.f}, bt[2] = {0.f, 0.f};
        { const LAS float* part = (const LAS float*)(L + O_PART);
#pragma unroll
          for (int w2 = 0; w2 < 8; ++w2) { const f32x2v pv = *(const LAS f32x2v*)(part + w2 * 128 + d0);
              const bool before = dir ? (w2 > w) : (w2 < w); const bool inr = dir ? (w2 >= 4) : (w2 < 4);
#pragma unroll
              for (int i = 0; i < 2; ++i) { bt[i] += pv[i]; offs[i] += before ? pv[i] : 0.f; rr[i] += inr ? pv[i] : 0.f; } } }
        float er[2], el[2];
#pragma unroll
        for (int i = 0; i < 2; ++i) { er[i] = __expf(rr[i]); el[i] = __expf(bt[i] - rr[i]); }
        if (w == 0) { LAS float* aa = (LAS float*)(L + O_A); *(LAS f32x2v*)(aa + d0) = (f32x2v){__expf(bt[0]), __expf(bt[1])}; }
        unsigned kdp[2][4];
#pragma unroll
        for (int p = 0; p < 8; ++p) {
            float qi[2], ki[2], qb[2], kd[2];
#pragma unroll
            for (int i = 0; i < 2; ++i) { const float bb = bl[p][i] + offs[i]; const float e1 = __expf(bb - rr[i]), e2 = __expf(rr[i] - bb);
                qi[i] = qq[p][i] * e1; ki[i] = kk[p][i] * e2; qb[i] = qi[i] * er[i]; kd[i] = ki[i] * el[i]; }
            const int pos = 8 * w + p;
            *(LAS unsigned*)(L + O_QI + pos * LQ + d0 * 2) = cvtpk(qi[0], qi[1]);
            *(LAS unsigned*)(L + O_KI + pos * LQ + d0 * 2) = cvtpk(ki[0], ki[1]);
            *(LAS unsigned*)(L + O_QB + pos * LQ + d0 * 2) = cvtpk(qb[0], qb[1]);
            if (p & 1) { kdp[0][p >> 1] = (kdp[0][p >> 1] & 0xffffu) | (cvtpk(0.f, kd[0]) & 0xffff0000u); kdp[1][p >> 1] = (kdp[1][p >> 1] & 0xffffu) | (cvtpk(0.f, kd[1]) & 0xffff0000u); }
            else { kdp[0][p >> 1] = cvtpk(kd[0], 0.f) & 0xffffu; kdp[1][p >> 1] = cvtpk(kd[1], 0.f) & 0xffffu; }
        }
#pragma unroll
        for (int i = 0; i < 2; ++i) *(LAS v4u*)(L + O_KDT + (d0 + i) * LV + (8 * w) * 2) = (v4u){kdp[i][0], kdp[i][1], kdp[i][2], kdp[i][3]};
        if (tid < 256) {
            unsigned v0[4], v1[4];
#pragma unroll
            for (int p = 0; p < 8; p += 2) { v0[p >> 1] = (vraw[p] & 0xffffu) | (vraw[p + 1] << 16); v1[p >> 1] = (vraw[p] >> 16) | (vraw[p + 1] & 0xffff0000u); }
            *(LAS v4u*)(L + O_VT + (2 * vp) * LV + (8 * pg) * 2) = (v4u){v0[0], v0[1], v0[2], v0[3]};
            *(LAS v4u*)(L + O_VT + (2 * vp + 1) * LV + (8 * pg) * 2) = (v4u){v1[0], v1[1], v1[2], v1[3]};
        }
        if (c + 1 < 32) HG_LOAD(dir ? 30 - c : c + 1);
        __syncthreads();
        f32x4 ao[2], au[4];
#pragma unroll
        for (int sbi = 0; sbi < 2; ++sbi) {
            const int sb = 2 * hf + sbi; f32x4 a = (f32x4){0.f, 0.f, 0.f, 0.f};
#pragma unroll
            for (int ks = 0; ks < 4; ++ks) a = __builtin_amdgcn_mfma_f32_16x16x32_bf16(ldfrag(L + O_KI + (16 * sb + l15) * LQ + ks * 64 + l4 * 16), ldfrag(L + O_QI + (16 * tb + l15) * LQ + ks * 64 + l4 * 16), a, 0, 0, 0);
            const int tt = 16 * tb + l15, s0 = 16 * sb + 4 * l4;
            float m[4];
#pragma unroll
            for (int r = 0; r < 4; ++r) { const int ss = s0 + r; const bool keep = dir ? (ss >= tt) : (ss <= tt); m[r] = keep ? a[r] : 0.f; }
            *(LAS unsigned long long*)(L + O_AM + tt * LV + s0 * 2) = (unsigned long long)cvtpk(m[0], m[1]) | ((unsigned long long)cvtpk(m[2], m[3]) << 32);
        }
#pragma unroll
        for (int vbi = 0; vbi < 2; ++vbi) {
            const int vb = 2 * hf + vbi; f32x4 a = (f32x4){0.f, 0.f, 0.f, 0.f};
#pragma unroll
            for (int ks = 0; ks < 4; ++ks) a = __builtin_amdgcn_mfma_f32_16x16x32_bf16(ldfrag(L + O_ST + (16 * vb + l15) * LQ + ks * 64 + l4 * 16), ldfrag(L + O_QB + (16 * tb + l15) * LQ + ks * 64 + l4 * 16), a, 0, 0, 0);
            ao[vbi] = a;
        }
#pragma unroll
        for (int vb = 0; vb < 4; ++vb) {
            f32x4 a = (f32x4){0.f, 0.f, 0.f, 0.f};
#pragma unroll
            for (int ks = 0; ks < 2; ++ks) a = __builtin_amdgcn_mfma_f32_16x16x32_bf16(ldfrag(L + O_KDT + (16 * w + l15) * LV + ks * 64 + l4 * 16), ldfrag(L + O_VT + (16 * vb + l15) * LV + ks * 64 + l4 * 16), a, 0, 0, 0);
            au[vb] = a;
        }
        __syncthreads();
#pragma unroll
        for (int vbi = 0; vbi < 2; ++vbi) {
            const int vb = 2 * hf + vbi; f32x4 a = ao[vbi];
#pragma unroll
            for (int ks = 0; ks < 2; ++ks) a = __builtin_amdgcn_mfma_f32_16x16x32_bf16(ldfrag(L + O_VT + (16 * vb + l15) * LV + ks * 64 + l4 * 16), ldfrag(L + O_AM + (16 * tb + l15) * LV + ks * 64 + l4 * 16), a, 0, 0, 0);
            *(f32x4*)(Og + ((size_t)ch * 64 + 16 * tb + l15) * 1024 + 16 * vb + 4 * l4) = a;
        }
        { const f32x4 av = *(const LAS f32x4*)(L + O_A + (16 * w + 4 * l4) * 4);
#pragma unroll
          for (int vb = 0; vb < 4; ++vb) { st[vb] = av * st[vb] + au[vb];
              *(LAS unsigned long long*)(L + O_ST + (16 * vb + l15) * LQ + (16 * w + 4 * l4) * 2) = (unsigned long long)cvtpk(st[vb][0], st[vb][1]) | ((unsigned long long)cvtpk(st[vb][2], st[vb][3]) << 32); } }
    }
    __syncthreads();
#undef HG_LOAD
}

namespace at {
typedef short bf16x8 __attribute__((ext_vector_type(8)));
constexpr int SHM_V = 16384, SHM_K = 8192, O_V = 0, O_K = 32768, O_WS = 49152, LDK = 1024;
#define AT_SBAR() __builtin_amdgcn_sched_barrier(0)
#define KSWZ64(row, ch) ((row) * 128 + ((((ch) ^ (((row) >> 1) & 7))) << 4))
__device__ __forceinline__ int crow(int r, int hi) { return (r & 3) + 8 * (r >> 2) + 4 * hi; }
__device__ __forceinline__ void partialSM(f32x16& p0, f32x16& p1, float& m_reg, float& mn, float& alpha) {
  float pmax = p0[0];
#pragma unroll
  for (int r = 1; r < 16; ++r) pmax = fmaxf(pmax, p0[r]);
#pragma unroll
  for (int r = 0; r < 16; ++r) pmax = fmaxf(pmax, p1[r]);
  { auto rr = __builtin_amdgcn_permlane32_swap(__float_as_uint(pmax), __float_as_uint(pmax), false, false);
    pmax = fmaxf(__uint_as_float(rr[0]), __uint_as_float(rr[1])); }
  if (__builtin_expect(__all(pmax - m_reg <= THRL), 1)) { mn = m_reg; alpha = 1.f; }
  else { mn = fmaxf(m_reg, pmax); alpha = __builtin_amdgcn_exp2f(m_reg - mn); m_reg = mn; }
#pragma unroll
  for (int r = 0; r < 16; ++r) p0[r] = p0[r] - mn;
#pragma unroll
  for (int r = 0; r < 16; ++r) p1[r] = p1[r] - mn;
#pragma unroll
  for (int r = 0; r < 16; ++r) p0[r] = __builtin_amdgcn_exp2f(p0[r]);
}
__device__ __forceinline__ void finishSM(f32x16& p0, f32x16& p1, float alpha, float& l_reg, bf16x8& pa0, bf16x8& pa1, bf16x8& pa2, bf16x8& pa3) {
#pragma unroll
  for (int r = 0; r < 16; ++r) p1[r] = __builtin_amdgcn_exp2f(p1[r]);
  float ps = 0;
#pragma unroll
  for (int r = 0; r < 16; ++r) ps += p0[r];
#pragma unroll
  for (int r = 0; r < 16; ++r) ps += p1[r];
  { auto rr = __builtin_amdgcn_permlane32_swap(__float_as_uint(ps), __float_as_uint(ps), false, false);
    ps = __uint_as_float(rr[0]) + __uint_as_float(rr[1]); }
  l_reg = l_reg * alpha + ps;
#define AT_PK4(P, BASE, OUT) do { unsigned a0 = cvtpk(P[BASE + 0], P[BASE + 1]), a1 = cvtpk(P[BASE + 2], P[BASE + 3]);   \
    unsigned b0 = cvtpk(P[BASE + 4], P[BASE + 5]), b1 = cvtpk(P[BASE + 6], P[BASE + 7]);                              \
    auto r0 = __builtin_amdgcn_permlane32_swap(a0, b0, false, false); auto r1 = __builtin_amdgcn_permlane32_swap(a1, b1, false, false); \
    v4u w_ = {r0[0], r1[0], r0[1], r1[1]}; OUT = __builtin_bit_cast(bf16x8, w_); } while (0)
  AT_PK4(p0, 0, pa0); AT_PK4(p0, 8, pa1); AT_PK4(p1, 0, pa2); AT_PK4(p1, 8, pa3);
#undef AT_PK4
}
__device__ __forceinline__ void qkt(f32x16& p0, f32x16& p1, const char* Ks, const bf16x8* qr, int r32, int hi) {
  p0 = f32x16{}; p1 = f32x16{};
#pragma unroll
  for (int d0 = 0; d0 < 4; ++d0) { const int ch = d0 * 2 + hi;
    bf16x8 b0 = *reinterpret_cast<const bf16x8*>(Ks + KSWZ64(r32, ch));
    bf16x8 b1 = *reinterpret_cast<const bf16x8*>(Ks + 4096 + KSWZ64(r32, ch));
    p0 = __builtin_amdgcn_mfma_f32_32x32x16_bf16(b0, qr[d0], p0, 0, 0, 0);
    p1 = __builtin_amdgcn_mfma_f32_32x32x16_bf16(b1, qr[d0], p1, 0, 0, 0); }
}
__device__ __forceinline__ int v_st(int k, int c) { const int kk = (k & ~0xC) | ((k & 4) << 1) | ((k & 8) >> 1); return ((kk >> 3) * 4 + (c >> 5)) * 512 + ((kk & 7) * 32 + (c & 31)) * 2; }
__device__ __forceinline__ int v_rd_base(int lane) { return ((lane & 3) << 3) | (((lane >> 2) & 3) << 6) | (((lane >> 4) & 1) << 5) | (((lane >> 5) & 1) << 8); }
constexpr int v_rd_off(int d0, int ks, int half) { return d0 * 512 + ks * 4096 + half * 2048; }
template <int OFF> __device__ __forceinline__ s16x4 tr_read(int vb) {
  s16x4 r; asm volatile("ds_read_b64_tr_b16 %0, %1 offset:%2" : "=&v"(r) : "v"(vb), "i"(OFF) : "memory"); return r;
}
template <int D0> __device__ __forceinline__ void pv_one(f32x16& od, int vb, bf16x8 pa0, bf16x8 pa1, bf16x8 pa2, bf16x8 pa3) {
  const s16x4 l0 = tr_read<v_rd_off(D0, 0, 0)>(vb), h0 = tr_read<v_rd_off(D0, 0, 1)>(vb), l1 = tr_read<v_rd_off(D0, 1, 0)>(vb), h1 = tr_read<v_rd_off(D0, 1, 1)>(vb);
  const s16x4 l2 = tr_read<v_rd_off(D0, 2, 0)>(vb), h2 = tr_read<v_rd_off(D0, 2, 1)>(vb), l3 = tr_read<v_rd_off(D0, 3, 0)>(vb), h3 = tr_read<v_rd_off(D0, 3, 1)>(vb);
  asm volatile("s_waitcnt lgkmcnt(0)" ::: "memory"); AT_SBAR();
#define AT_PK(L, H) (bf16x8){L[0], L[1], L[2], L[3], H[0], H[1], H[2], H[3]}
  od = __builtin_amdgcn_mfma_f32_32x32x16_bf16(pa0, AT_PK(l0, h0), od, 0, 0, 0);
  od = __builtin_amdgcn_mfma_f32_32x32x16_bf16(pa1, AT_PK(l1, h1), od, 0, 0, 0);
  od = __builtin_amdgcn_mfma_f32_32x32x16_bf16(pa2, AT_PK(l2, h2), od, 0, 0, 0);
  od = __builtin_amdgcn_mfma_f32_32x32x16_bf16(pa3, AT_PK(l3, h3), od, 0, 0, 0);
#undef AT_PK
}
__device__ __forceinline__ void pv_d0(f32x16* o, int vb, bf16x8 pa0, bf16x8 pa1, bf16x8 pa2, bf16x8 pa3) {
  pv_one<0>(o[0], vb, pa0, pa1, pa2, pa3); pv_one<1>(o[1], vb, pa0, pa1, pa2, pa3); pv_one<2>(o[2], vb, pa0, pa1, pa2, pa3); pv_one<3>(o[3], vb, pa0, pa1, pa2, pa3);
}
__device__ __forceinline__ void attn_pass(const bf16* __restrict__ Qw, const bf16* __restrict__ Kh, const bf16* __restrict__ Vh, int seq, char* lds, f32x16 (&o)[4]) {
  int tid_ = threadIdx.x; asm volatile("" : "+v"(tid_));
  const int tid = tid_, wid = tid >> 6, lane = tid & 63, r32 = lane & 31, hi = lane >> 5;
  char* V_lds = lds + O_V; char* K_lds = lds + O_K;
  float* ws = (float*)(lds + O_WS) + wid * 64; float* li_l = ws; float* al_l = ws + 32;
  float m_reg = -1e30f, l_reg = 0; bf16x8 qr[4];
#pragma unroll
  for (int d = 0; d < 4; ++d) o[d] = f32x16{};
  const bf16* Ql = Qw + (long)r32 * LDK + hi * 8;
#pragma unroll
  for (int d0 = 0; d0 < 4; ++d0) qr[d0] = *reinterpret_cast<const bf16x8*>(Ql + d0 * 16);
  const int sr = tid >> 4, sc = (tid & 15) * 8, vst0 = v_st(sr, sc), vst1 = v_st(32 + sr, sc);
  const int kr = tid >> 3, kc = tid & 7, kst = KSWZ64(kr, kc);
  const int vb0 = (int)(uintptr_t)V_lds + v_rd_base(lane);
  struct { bf16x8 vs0, vs1, ks0; } sr_[2];
#define AT_SLOAD(i, k0) do { sr_[i].vs0 = *reinterpret_cast<const bf16x8*>(&Vh[(long)((k0) + sr) * LDK + sc]); sr_[i].vs1 = *reinterpret_cast<const bf16x8*>(&Vh[(long)((k0) + 32 + sr) * LDK + sc]); \
    sr_[i].ks0 = *reinterpret_cast<const bf16x8*>(&Kh[(long)((k0) + kr) * LDK + kc * 8]); } while (0)
#define AT_SWRITE(b, i) do { *(bf16x8*)(V_lds + (b) * SHM_V + vst0) = sr_[i].vs0; *(bf16x8*)(V_lds + (b) * SHM_V + vst1) = sr_[i].vs1; \
    *(bf16x8*)(K_lds + (b) * SHM_K + kst) = sr_[i].ks0; } while (0)
#define AT_SWAIT() asm volatile("s_waitcnt vmcnt(3)" ::: "memory")
#define AT_RESC(a) do { if (__any((a) < 1.f)) { if (hi == 0) al_l[r32] = (a); asm volatile("s_waitcnt lgkmcnt(0)" ::: "memory"); \
    _Pragma("unroll") for (int d = 0; d < 4; ++d) _Pragma("unroll") for (int r = 0; r < 16; ++r) o[d][r] *= al_l[crow(r, hi)]; } } while (0)
  f32x16 pA0, pA1, pB0, pB1; float mnA, mnB, alA, alB; bf16x8 pa0, pa1, pa2, pa3; const int NT = seq / 64;
  constexpr int SE = 0, SO = 1;
  AT_SLOAD(SE, 0); asm volatile("s_waitcnt vmcnt(0)" ::: "memory"); AT_SWRITE(0, SE); __syncthreads();
  qkt(pA0, pA1, K_lds, qr, r32, hi); partialSM(pA0, pA1, m_reg, mnA, alA);
  AT_SLOAD(SO, 64); if (2 < NT) AT_SLOAD(SE, 128);
  AT_SWAIT(); AT_SWRITE(1, SO); __syncthreads();
  for (int j = 1; j + 1 < NT; j += 2) {
    AT_SBAR(); qkt(pB0, pB1, K_lds + SHM_K, qr, r32, hi);
    finishSM(pA0, pA1, alA, l_reg, pa0, pa1, pa2, pa3); AT_SBAR();
    AT_SLOAD(SO, (j + 2) * 64); AT_SBAR();
    pv_d0(o, vb0, pa0, pa1, pa2, pa3); partialSM(pB0, pB1, m_reg, mnB, alB);
    __syncthreads(); AT_SWAIT(); AT_SWRITE(0, SE);
    AT_RESC(alB); __syncthreads();
    AT_SBAR(); qkt(pA0, pA1, K_lds, qr, r32, hi);
    finishSM(pB0, pB1, alB, l_reg, pa0, pa1, pa2, pa3); AT_SBAR();
    if (j + 3 < NT) AT_SLOAD(SE, (j + 3) * 64); AT_SBAR();
    pv_d0(o, vb0 + SHM_V, pa0, pa1, pa2, pa3); partialSM(pA0, pA1, m_reg, mnA, alA);
    __syncthreads(); AT_SWAIT(); AT_SWRITE(1, SO);
    AT_RESC(alA); __syncthreads();
  }
  AT_SBAR(); qkt(pB0, pB1, K_lds + SHM_K, qr, r32, hi);
  finishSM(pA0, pA1, alA, l_reg, pa0, pa1, pa2, pa3); AT_SBAR();
  pv_d0(o, vb0, pa0, pa1, pa2, pa3); partialSM(pB0, pB1, m_reg, mnB, alB);
  __syncthreads(); AT_RESC(alB);
  finishSM(pB0, pB1, alB, l_reg, pa0, pa1, pa2, pa3); AT_SBAR();
  pv_d0(o, vb0 + SHM_V, pa0, pa1, pa2, pa3);
  if (hi == 0) li_l[r32] = l_reg; asm volatile("s_waitcnt lgkmcnt(0)" ::: "memory");
#pragma unroll
  for (int r = 0; r < 16; ++r) { const float rl = __builtin_amdgcn_rcpf(li_l[crow(r, hi)]);
#pragma unroll
    for (int d = 0; d < 4; ++d) o[d][r] *= rl; }
  __syncthreads();
#undef AT_SLOAD
#undef AT_SWRITE
#undef AT_SWAIT
#undef AT_RESC
}
}

__device__ __forceinline__ void attn_unit(Frame& F, int unit, float lam, const float* subln_g) {
    const int b = unit >> 6, h = (unit >> 3) & 7, qb = unit & 7;
    int tid_ = threadIdx.x; asm volatile("" : "+v"(tid_));
    const int tid = tid_, wid = tid >> 6, lane = tid & 63, r32 = lane & 31, hi = lane >> 5;
    const size_t rowbase = (size_t)b * SEQ;
    const bf16* Qb = (const bf16*)(F.ws + WS_DAQ) + (rowbase + qb * 256 + wid * 32) * 1024 + h * 128;
    const bf16* Kb = (const bf16*)(F.ws + WS_DAK) + rowbase * 1024 + h * 128;
    const bf16* Vb = (const bf16*)(F.ws + WS_DAV) + rowbase * 1024 + h * 128;
    GAS f32x4* stash = (GAS f32x4*)(F.ws + WS_STASH) + (size_t)blockIdx.x * 16 * 512 + tid;
    asm volatile("" : "+v"(stash));
    char* lds = (char*)F.ldsg + RING_OFF;
    f32x16 o[4];
    at::attn_pass(Qb, Kb, Vb, SEQ, lds, o);
#pragma unroll
    for (int d = 0; d < 4; ++d)
#pragma unroll
        for (int g = 0; g < 4; ++g) stash[(d * 4 + g) * 512] = (f32x4){o[d][4 * g], o[d][4 * g + 1], o[d][4 * g + 2], o[d][4 * g + 3]};
    at::attn_pass(Qb + 64, Kb + 64, Vb, SEQ, lds, o);
    float gsc[4];
#pragma unroll
    for (int d = 0; d < 4; ++d) gsc[d] = subln_g[d * 32 + r32] * (1.0f - LAMBDA_INIT);
    bf16* Ob = (bf16*)(F.ws + WS_OA) + (rowbase + qb * 256 + wid * 32) * 1024 + h * 128;
#pragma unroll
    for (int g = 0; g < 4; ++g) {
        f32x4 s0[4];
#pragma unroll
        for (int d = 0; d < 4; ++d) s0[d] = stash[(d * 4 + g) * 512];
#pragma unroll
        for (int q = 0; q < 4; ++q) { const int r = 4 * g + q;
            float v[4], ss = 0.f;
#pragma unroll
            for (int d = 0; d < 4; ++d) { v[d] = s0[d][q] - lam * o[d][r]; ss += v[d] * v[d]; }
#pragma unroll
            for (int x = 1; x < 32; x <<= 1) ss += __shfl_xor(ss, x);
            const float rstd = __builtin_amdgcn_rsqf(ss * (1.0f / 128.0f) + EPS);
            const int orow = at::crow(r, hi);
#pragma unroll
            for (int d = 0; d < 4; ++d) Ob[(size_t)orow * 1024 + d * 32 + r32] = (bf16)(cvtpk(v[d] * rstd * gsc[d], 0.f) & 0xffffu);
        }
    }
}

__device__ __forceinline__ void hgrn_combine(Frame& F, const float* norm_g) {
    const int gw = F.vcu * NWAVES + F.wave, NGW = F.G * NWAVES, lane = F.lane;
    const float* OFp = (const float*)(F.ws + WS_OF); const float* OBp = (const float*)(F.ws + WS_OBW);
    const bf16* GG = (const bf16*)(F.ws + WS_HGG); bf16* OB = (bf16*)(F.ws + WS_OB);
    f32x4 ng[4];
#pragma unroll
    for (int j = 0; j < 4; ++j) ng[j] = *(const f32x4*)(norm_g + (16 * lane + 4 * j) % 128);
    for (int m = gw; m < T; m += NGW) {
        const size_t off = (size_t)m * 1024 + 16 * lane;
        f32x4 v[4]; float ss = 0.f;
#pragma unroll
        for (int j = 0; j < 4; ++j) { v[j] = *(const f32x4*)(OFp + off + 4 * j) + *(const f32x4*)(OBp + off + 4 * j); ss += (v[j].x * v[j].x + v[j].y * v[j].y) + (v[j].z * v[j].z + v[j].w * v[j].w); }
        ss += __shfl_xor(ss, 1); ss += __shfl_xor(ss, 2); ss += __shfl_xor(ss, 4);
        const float rstd = __builtin_amdgcn_rsqf(ss * (1.0f / 128.0f) + EPS);
        const v4u g0 = *(const v4u*)(GG + off), g1 = *(const v4u*)(GG + off + 8);
        const unsigned gg[8] = {g0.x, g0.y, g0.z, g0.w, g1.x, g1.y, g1.z, g1.w};
        unsigned o[8];
#pragma unroll
        for (int j = 0; j < 4; ++j) { const f32x4 t = v[j] * rstd * ng[j];
            o[2 * j] = cvtpk(t.x * bf_lo(gg[2 * j]), t.y * bf_hi(gg[2 * j])); o[2 * j + 1] = cvtpk(t.z * bf_lo(gg[2 * j + 1]), t.w * bf_hi(gg[2 * j + 1])); }
        *(v4u*)(OB + off) = (v4u){o[0], o[1], o[2], o[3]}; *(v4u*)(OB + off + 8) = (v4u){o[4], o[5], o[6], o[7]};
    }
}
__device__ __forceinline__ void cvt_table(Frame& F, const float* src, bf16* dst, size_t n) {
    const size_t n8 = n / 8, stride = (size_t)F.G * 512;
    for (size_t i = (size_t)F.vcu * 512 + F.tid; i < n8; i += stride) {
        const f32x4 a = *(const f32x4*)(src + i * 8), b = *(const f32x4*)(src + i * 8 + 4);
        *(v4u*)(dst + i * 8) = (v4u){cvtpk(a.x, a.y), cvtpk(a.z, a.w), cvtpk(b.x, b.y), cvtpk(b.z, b.w)};
    }
}

namespace pr {
typedef short bf16x8 __attribute__((ext_vector_type(8)));
constexpr int LK = 272;
#define PR_CE(a, b) do { const unsigned hi_ = (a) > (b) ? (a) : (b); const unsigned lo_ = (a) > (b) ? (b) : (a); (a) = hi_; (b) = lo_; } while (0)
__device__ __forceinline__ void sort16(unsigned (&v)[16]) {
#pragma unroll
    for (int k = 2; k <= 16; k <<= 1)
#pragma unroll
        for (int j = k >> 1; j > 0; j >>= 1)
#pragma unroll
            for (int i = 0; i < 16; ++i) { const int l = i ^ j; if (l > i) { if ((i & k) == 0) PR_CE(v[i], v[l]); else PR_CE(v[l], v[i]); } }
}
__device__ __forceinline__ void merge16(unsigned (&a)[16], const unsigned (&b)[16]) {
#pragma unroll
    for (int i = 0; i < 16; ++i) a[i] = a[i] > b[15 - i] ? a[i] : b[15 - i];
#pragma unroll
    for (int j = 8; j > 0; j >>= 1)
#pragma unroll
        for (int i = 0; i < 16; ++i) { const int l = i ^ j; if (l > i) PR_CE(a[i], a[l]); }
}
__device__ __forceinline__ unsigned ord(float f) { const unsigned u = __float_as_uint(f); return u ^ ((unsigned)((int)u >> 31) | 0x80000000u); }
__device__ __forceinline__ float unord(unsigned u) { return __uint_as_float((u & 0x80000000u) ? (u ^ 0x80000000u) : ~u); }
}
__device__ __forceinline__ void peer_route_unit(Frame& F, int unit, const float* keys1, const float* keys2) {
    using namespace pr;
    const int hp = unit >> 6, tt = unit & 63;
    LAS unsigned char* L = F.lds + RING_OFF;
    const int tid = F.tid, lane = F.lane, w = F.wave, r32 = lane & 31, hi = lane >> 5;
    for (int i = tid; i < 2 * 128 * 16; i += 512) { const int half = i >> 11, rem = i & 2047, kr = rem >> 4, kc = rem & 15;
        const float* src = (half ? keys2 : keys1) + ((size_t)hp * 128 + kr) * 128 + kc * 8;
        const f32x4 a = *(const f32x4*)src, b = *(const f32x4*)(src + 4);
        *(LAS v4u*)(L + half * (128 * LK) + kr * LK + kc * 16) = (v4u){cvtpk(a.x, a.y), cvtpk(a.z, a.w), cvtpk(b.x, b.y), cvtpk(b.z, b.w)}; }
    __syncthreads();
    const int tok = tt * 256 + w * 32 + r32;
    const bf16* qrow = (const bf16*)(F.ws + WS_QP) + (size_t)tok * DM + hp * 256 + hi * 8;
    unsigned top[2][16];
#pragma unroll
    for (int half = 0; half < 2; ++half) {
        bf16x8 qf[8];
#pragma unroll
        for (int ks = 0; ks < 8; ++ks) qf[ks] = *(const bf16x8*)(qrow + half * 128 + ks * 16);
        unsigned res[16];
#pragma unroll
        for (int kb = 0; kb < 4; ++kb) {
            f32x16 acc = f32x16{};
#pragma unroll
            for (int ks = 0; ks < 8; ++ks) acc = __builtin_amdgcn_mfma_f32_32x32x16_bf16(*(const LAS bf16x8*)(L + half * (128 * LK) + (32 * kb + r32) * LK + ks * 32 + hi * 16), qf[ks], acc, 0, 0, 0);
            unsigned kv[16];
#pragma unroll
            for (int r = 0; r < 16; ++r) { const int idx = 32 * kb + (r & 3) + 8 * (r >> 2) + 4 * hi; kv[r] = (ord(acc[r]) & 0xFFFFFF80u) | (unsigned)(127 - idx); }
            sort16(kv);
            if (kb == 0) {
#pragma unroll
                for (int r = 0; r < 16; ++r) res[r] = kv[r];
            } else merge16(res, kv);
        }
        unsigned oth[16];
#pragma unroll
        for (int r = 0; r < 16; ++r) { auto rr = __builtin_amdgcn_permlane32_swap(res[r], res[r], false, false); oth[r] = hi ? rr[0] : rr[1]; }
        merge16(res, oth);
#pragma unroll
        for (int r = 0; r < 16; ++r) top[half][r] = res[r];
    }
    float f1[16], f2[16]; unsigned ip1[4] = {0u, 0u, 0u, 0u}, ip2[4] = {0u, 0u, 0u, 0u};
#pragma unroll
    for (int r = 0; r < 16; ++r) { f1[r] = unord((top[0][r] & 0xFFFFFF80u) | 0x40u); f2[r] = unord((top[1][r] & 0xFFFFFF80u) | 0x40u);
        ip1[r >> 2] |= (127u - (top[0][r] & 127u)) << (8 * (r & 3)); ip2[r >> 2] |= (127u - (top[1][r] & 127u)) << (8 * (r & 3)); }
    unsigned cand[64];
    { int n = 0;
#pragma unroll
      for (int i = 0; i < 16; ++i)
#pragma unroll
          for (int j = 0; j < 16; ++j) if ((i + 1) * (j + 1) <= 16) { cand[n] = (ord(f1[i] + f2[j]) & 0xFFFFFF00u) | (unsigned)(255 - (i * 16 + j)); ++n; }
#pragma unroll
      for (int q = 50; q < 64; ++q) cand[q] = 0u; }
    unsigned res[16];
#pragma unroll
    for (int g = 0; g < 4; ++g) { unsigned kv[16];
#pragma unroll
        for (int r = 0; r < 16; ++r) kv[r] = cand[g * 16 + r];
        sort16(kv);
        if (g == 0) {
#pragma unroll
            for (int r = 0; r < 16; ++r) res[r] = kv[r];
        } else merge16(res, kv); }
    float sc[16]; int ex[16];
#pragma unroll
    for (int r = 0; r < 16; ++r) { sc[r] = unord((res[r] & 0xFFFFFF00u) | 0x80u); const unsigned ci = 255u - (res[r] & 255u), i = ci >> 4, j = ci & 15u;
        unsigned wi = ip1[0]; wi = (i >> 2) == 1 ? ip1[1] : wi; wi = (i >> 2) == 2 ? ip1[2] : wi; wi = (i >> 2) == 3 ? ip1[3] : wi;
        unsigned wj = ip2[0]; wj = (j >> 2) == 1 ? ip2[1] : wj; wj = (j >> 2) == 2 ? ip2[2] : wj; wj = (j >> 2) == 3 ? ip2[3] : wj;
        ex[r] = (int)(((wi >> (8 * (i & 3))) & 255u) * 128u + ((wj >> (8 * (j & 3))) & 255u)); }
    const float mx = sc[0];
    float ev[16], sum = 0.f;
#pragma unroll
    for (int r = 0; r < 16; ++r) { ev[r] = __expf(sc[r] - mx); sum += ev[r]; }
    const float inv = 1.0f / sum;
    int eo[8]; float go[8];
#pragma unroll
    for (int q = 0; q < 8; ++q) { eo[q] = hi ? ex[8 + q] : ex[q]; go[q] = (hi ? ev[8 + q] : ev[q]) * inv; }
    int* EI = (int*)(F.ws + WS_EIDX) + (size_t)tok * 128 + hp * 16 + 8 * hi;
    float* EGp = (float*)(F.ws + WS_EG) + (size_t)tok * 128 + hp * 16 + 8 * hi;
    typedef int i32x4 __attribute__((ext_vector_type(4)));
    *(i32x4*)EI = (i32x4){eo[0], eo[1], eo[2], eo[3]}; *(i32x4*)(EI + 4) = (i32x4){eo[4], eo[5], eo[6], eo[7]};
    *(f32x4*)EGp = (f32x4){go[0], go[1], go[2], go[3]}; *(f32x4*)(EGp + 4) = (f32x4){go[4], go[5], go[6], go[7]};
    __syncthreads();
}

__device__ __forceinline__ void peer_main(Frame& F, const float* ada, const float* final_g) {
    const int gw = F.vcu * NWAVES + F.wave, NGW = F.G * NWAVES, lane = F.lane;
    const bf16* H2 = (const bf16*)(F.ws + WS_H2); const bf16* U8 = (const bf16*)(F.ws + WS_U8); const bf16* V8 = (const bf16*)(F.ws + WS_V8);
    const int* EI = (const int*)(F.ws + WS_EIDX); const float* EGp = (const float*)(F.ws + WS_EG);
    for (int t = gw; t < T; t += NGW) {
        v4u hq[4];
#pragma unroll
        for (int j = 0; j < 4; ++j) hq[j] = *(const v4u*)(H2 + (size_t)t * DM + (j * 64 + lane) * 8);
        int ev[2]; float gv[2], av[2];
        ev[0] = EI[(size_t)t * 128 + lane]; ev[1] = EI[(size_t)t * 128 + 64 + lane];
        gv[0] = EGp[(size_t)t * 128 + lane]; gv[1] = EGp[(size_t)t * 128 + 64 + lane];
#pragma unroll
        for (int bt = 0; bt < 2; ++bt) {
            float part[64];
#pragma unroll
            for (int k = 0; k < 64; ++k) {
                const int e = __builtin_amdgcn_readlane(ev[bt], k);
                const bf16* up = U8 + (size_t)e * DM;
                float p0 = 0.f, p1 = 0.f;
#pragma unroll
                for (int j = 0; j < 4; ++j) { const v4u uu = *(const v4u*)(up + (j * 64 + lane) * 8);
                    p0 = dot2bf(uu.x, hq[j].x, p0); p1 = dot2bf(uu.y, hq[j].y, p1); p0 = dot2bf(uu.z, hq[j].z, p0); p1 = dot2bf(uu.w, hq[j].w, p1); }
                part[k] = p0 + p1;
            }
#define PM_STAGE(N, OFF) _Pragma("unroll") for (int i = 0; i < (N); ++i) { const bool up_ = (lane & (OFF)) != 0; const float send = up_ ? part[i] : part[i + (N)]; const float keep = up_ ? part[i + (N)] : part[i]; part[i] = keep + __shfl_xor(send, (OFF)); }
            PM_STAGE(32, 32) PM_STAGE(16, 16) PM_STAGE(8, 8) PM_STAGE(4, 4) PM_STAGE(2, 2) PM_STAGE(1, 1)
#undef PM_STAGE
            const float x = part[0];
            const pg8::f32x2 g2 = pg8::gelu_pk((pg8::f32x2){x, x});
            av[bt] = g2.x * gv[bt];
        }
        float acc[32];
#pragma unroll
        for (int i = 0; i < 32; ++i) acc[i] = 0.f;
#pragma unroll
        for (int bt = 0; bt < 2; ++bt) {
#pragma unroll 8
            for (int k = 0; k < 64; ++k) {
                const int e = __builtin_amdgcn_readlane(ev[bt], k);
                const float a = __builtin_bit_cast(float, __builtin_amdgcn_readlane(__builtin_bit_cast(int, av[bt]), k));
                const bf16* vp = V8 + (size_t)e * DM;
#pragma unroll
                for (int j = 0; j < 4; ++j) { const v4u vv = *(const v4u*)(vp + (j * 64 + lane) * 8);
                    acc[j * 8 + 0] += a * bf_lo(vv.x); acc[j * 8 + 1] += a * bf_hi(vv.x); acc[j * 8 + 2] += a * bf_lo(vv.y); acc[j * 8 + 3] += a * bf_hi(vv.y);
                    acc[j * 8 + 4] += a * bf_lo(vv.z); acc[j * 8 + 5] += a * bf_hi(vv.z); acc[j * 8 + 6] += a * bf_lo(vv.w); acc[j * 8 + 7] += a * bf_hi(vv.w); }
            }
        }
        const int b = t / SEQ; float* xo = F.out + (size_t)t * DM; float ss = 0.f;
#pragma unroll
        for (int j = 0; j < 4; ++j)
#pragma unroll
            for (int q = 0; q < 2; ++q) { const int col = (j * 64 + lane) * 8 + 4 * q;
                const f32x4 x1 = *(const f32x4*)(xo + col), g2 = *(const f32x4*)(ada + (size_t)b * ADA_W + 5 * DM + col);
                const f32x4 pe = {acc[j * 8 + 4 * q], acc[j * 8 + 4 * q + 1], acc[j * 8 + 4 * q + 2], acc[j * 8 + 4 * q + 3]};
                const f32x4 x2 = x1 + g2 * pe;
                acc[j * 8 + 4 * q] = x2.x; acc[j * 8 + 4 * q + 1] = x2.y; acc[j * 8 + 4 * q + 2] = x2.z; acc[j * 8 + 4 * q + 3] = x2.w;
                ss += (x2.x * x2.x + x2.y * x2.y) + (x2.z * x2.z + x2.w * x2.w); }
        const float rstd = __builtin_amdgcn_rsqf(wave_sum(ss) * (1.0f / DM) + EPS);
#pragma unroll
        for (int j = 0; j < 4; ++j)
#pragma unroll
            for (int q = 0; q < 2; ++q) { const int col = (j * 64 + lane) * 8 + 4 * q; const f32x4 fg = *(const f32x4*)(final_g + col);
                *(f32x4*)(xo + col) = (f32x4){acc[j * 8 + 4 * q] * rstd * fg.x, acc[j * 8 + 4 * q + 1] * rstd * fg.y, acc[j * 8 + 4 * q + 2] * rstd * fg.z, acc[j * 8 + 4 * q + 3] * rstd * fg.w}; }
    }
}

struct Args { const void* in[25]; float* out; unsigned char* ws; int ph_lo, ph_hi; };
__global__ void __launch_bounds__(NWAVES * 64, 2) mk_fwd(Args args) {
    extern __shared__ __attribute__((aligned(16))) unsigned char lds[];
    Frame F;
    F.lds = (LAS unsigned char*)lds; F.ldsg = lds;
    F.MISC = (volatile LAS unsigned*)(F.lds + MISC_OFF);
    F.tid = threadIdx.x; F.lane = F.tid & 63; F.wave = __builtin_amdgcn_readfirstlane(F.tid >> 6);
    F.G = gridDim.x; { const int bx = blockIdx.x; F.vcu = (F.G % 8 == 0) ? (bx % 8) * (F.G / 8) + bx / 8 : bx; }
    F.ws = args.ws; F.out = args.out; F.ctl = (gu32*)(args.ws + WS_CTL);
    for (int u = F.tid; u < (LDS_BYTES - LDSCTL_OFF) / 4; u += NWAVES * 64) ((LAS unsigned*)(F.lds + LDSCTL_OFF))[u] = 0u;
    __syncthreads();
    XcdBarrier bar; bar.bar = (unsigned*)(F.ctl + CW_BAR); bar.x = 0; bar.st = nullptr;
    if (N_LAUNCHES == 1) bar = xcd_barrier_post((unsigned*)(F.ctl + CW_BAR), F.MISC + 8);
#define GRID_BAR() do { if (N_LAUNCHES == 1) xcd_barrier(bar); } while (0)
    const int lo = args.ph_lo, hi = args.ph_hi;
#ifndef PH_MASK
#define PH_MASK 0xFFFF
#endif
#define IN(k) ((((PH_MASK) >> (k)) & 1) && lo <= (k) && (k) < hi)
#define BOTH(k) (IN(k) && IN((k) + 1))
    const float* x = IN_F(0); const float* ada = (const float*)(F.ws + WS_ADA);

    if (IN(0)) { p0_prologue(F, IN_F(1), (const int*)args.in[2], IN_F(3), IN_F(4), IN_F(6), IN_F(15), IN_F(16), IN_F(17), IN_F(19)); if (BOTH(0)) GRID_BAR(); }
    if (IN(1)) { mod_rows(F, x, IN_F(5), ada + 0 * DM, ada + 1 * DM, (bf16*)(F.ws + WS_H)); if (BOTH(1)) GRID_BAR(); }
    if (IN(2)) {
        pg8::Gemm g{(const bf16*)(F.ws + WS_H), (const bf16*)(F.ws + WS_WIN), T, IN_W, DM}; pg8::StaticOrder S; S.init(T, IN_W, F.G, (int)blockIdx.x);
        pg8::EpiG1 E; E.ws = F.ws; E.rope = (const float*)(F.ws + WS_ROPE);
        pg8::gemm_phase<pg8::EpiG1, pg8::StaticOrder, true, true>(F.lds + RING_OFF, g, S, E);
        if (BOTH(2)) GRID_BAR();
    }
    if (IN(3)) {
        if ((PH_MASK >> 11) & 1) for (int it = F.vcu; it < 256; it += F.G) hgrn_item(F, it, IN_F(12), IN_F(13));
        float lam;
        { float s1 = 0.f, s2 = 0.f; const float* q1 = IN_F(7); const float* k1 = IN_F(8); const float* q2 = IN_F(9); const float* k2 = IN_F(10);
          for (int i = 0; i < 64; ++i) { s1 += q1[i] * k1[i]; s2 += q2[i] * k2[i]; }
          lam = __expf(s1) - __expf(s2) + LAMBDA_INIT; }
        if ((PH_MASK >> 12) & 1) for (int u = F.vcu; u < 512; u += F.G) attn_unit(F, u, lam, IN_F(11));
        if (BOTH(3)) GRID_BAR();
    }
    if (IN(4)) { hgrn_combine(F, IN_F(14)); if (BOTH(4)) GRID_BAR(); }
    if (IN(5)) {
        { pg8::Gemm g{(const bf16*)(F.ws + WS_OA), (const bf16*)(F.ws + WS_WA), T, DM, 1024}; pg8::StaticOrder S; S.init(T, DM, F.G, (int)blockIdx.x);
          pg8::EpiGate<false> E{(bf16*)(F.ws + WS_Y), (const bf16*)(F.ws + WS_GA), DM};
          pg8::gemm_phase<pg8::EpiGate<false>, pg8::StaticOrder, true, true>(F.lds + RING_OFF, g, S, E); }
        { pg8::Gemm g{(const bf16*)(F.ws + WS_OB), (const bf16*)(F.ws + WS_WB), T, DM, 1024}; pg8::StaticOrder S; S.init(T, DM, F.G, (int)blockIdx.x);
          pg8::EpiGate<true> E{(bf16*)(F.ws + WS_Y), (const bf16*)(F.ws + WS_GB), DM};
          pg8::gemm_phase<pg8::EpiGate<true>, pg8::StaticOrder, true, true>(F.lds + RING_OFF, g, S, E); }
        if (BOTH(5)) GRID_BAR();
    }
    if (IN(6)) {
        pg8::Gemm g{(const bf16*)(F.ws + WS_Y), (const bf16*)(F.ws + WS_WOUT), T, DM, DM}; pg8::StaticOrder S; S.init(T, DM, F.G, (int)blockIdx.x);
        pg8::EpiResGate E{x, F.out, ada + 2 * DM, DM, ADA_W, SEQ};
        pg8::gemm_phase<pg8::EpiResGate, pg8::StaticOrder, true, true>(F.lds + RING_OFF, g, S, E);
        if (BOTH(6)) GRID_BAR();
    }
    if (IN(7)) {
        mod_rows(F, F.out, IN_F(18), ada + 3 * DM, ada + 4 * DM, (bf16*)(F.ws + WS_H2));
        cvt_table(F, IN_F(22), (bf16*)(F.ws + WS_U8), (size_t)16384 * DM); cvt_table(F, IN_F(23), (bf16*)(F.ws + WS_V8), (size_t)16384 * DM);
        if (BOTH(7)) GRID_BAR();
    }
    if (IN(8)) {
        pg8::Gemm g{(const bf16*)(F.ws + WS_H2), (const bf16*)(F.ws + WS_WQ), T, DM, DM}; pg8::StaticOrder S; S.init(T, DM, F.G, (int)blockIdx.x);
        pg8::EpiPlain E{(bf16*)(F.ws + WS_QP), DM};
        pg8::gemm_phase<pg8::EpiPlain, pg8::StaticOrder, true, true>(F.lds + RING_OFF, g, S, E);
        if (BOTH(8)) GRID_BAR();
    }
    if (IN(9)) { for (int u = F.vcu; u < 512; u += F.G) peer_route_unit(F, u, IN_F(20), IN_F(21)); if (BOTH(9)) GRID_BAR(); }
    if (IN(10)) { peer_main(F, ada, IN_F(24)); }
#undef IN
#undef BOTH
#undef GRID_BAR
}

extern "C" void kernel_launch(void* const* d_in, const int* in_sizes, int n_in, void* d_out, int out_size, void* d_ws, size_t ws_size, hipStream_t stream) {
    static int grid = 0;
    if (grid == 0) {
        if (n_in != 25 || in_sizes[0] != T * DM || out_size != T * DM || ws_size < WS_END) {
            fprintf(stderr, "kernel_launch: shape/workspace mismatch: n_in %d in0 %d out %d ws %zu (need >= %zu)\n", n_in, n_in > 0 ? in_sizes[0] : -1, out_size, ws_size, (size_t)WS_END); grid = -1; return; }
        int dev = 0, cus = 0, per_cu = 0;
        if (hipGetDevice(&dev) != hipSuccess || hipDeviceGetAttribute(&cus, hipDeviceAttributeMultiprocessorCount, dev) != hipSuccess) { fprintf(stderr, "kernel_launch: device query failed\n"); grid = -1; return; }
        if (hipFuncSetAttribute((const void*)mk_fwd, hipFuncAttributeMaxDynamicSharedMemorySize, LDS_BYTES) != hipSuccess) { fprintf(stderr, "kernel_launch: hipFuncSetAttribute failed\n"); grid = -1; return; }
        if (hipOccupancyMaxActiveBlocksPerMultiprocessor(&per_cu, (const void*)mk_fwd, NWAVES * 64, LDS_BYTES) != hipSuccess || per_cu < 1) {
            fprintf(stderr, "kernel_launch: occupancy query reports %d workgroups per CU\n", per_cu); (void)hipGetLastError(); per_cu = 1; }
        grid = cus;
        if (grid > 256) grid = 256;
    }
    if (grid < 0) return;
    if (hipMemsetAsync((char*)d_ws + WS_CTL, 0, CTL_ZERO_BYTES, stream) != hipSuccess) { fprintf(stderr, "kernel_launch: memset failed\n"); return; }
    Args a{};
    for (int i = 0; i < 25; ++i) a.in[i] = d_in[i];
    a.out = (float*)d_out; a.ws = (unsigned char*)d_ws;
    for (int li = 0; li < N_LAUNCHES; ++li) {
        a.ph_lo = (N_LAUNCHES == 1) ? 0 : li; a.ph_hi = (N_LAUNCHES == 1) ? N_PHASES : li + 1;
        hipLaunchKernelGGL(mk_fwd, dim3(grid), dim3(NWAVES * 64), LDS_BYTES, stream, a);
        const hipError_t le = hipPeekAtLastError();
        if (le != hipSuccess) { fprintf(stderr, "kernel_launch: launch %d failed: %s\n", li, hipGetErrorName(le)); break; }
    }
}
```

```cpp
#include <hip/hip_runtime.h>
#include <cstdio>
#include <cstdint>
namespace pg8 {
#define PG8_LAS __attribute__((address_space(3)))
typedef unsigned short bf16_t;
typedef short bf16x8 __attribute__((ext_vector_type(8)));
typedef float f32x4 __attribute__((ext_vector_type(4)));
typedef unsigned u32x4 __attribute__((ext_vector_type(4)));
constexpr int BM = 256, BK = 64, HALF = 128, HTB = HALF * BK * 2  , STAGE_BYTES = 8 * HTB, NXCD = 8, WGM = 8;

__host__ __device__ __forceinline__ int lds_byte(int r, int c) { const int st = (r >> 4) * 2 + (c >> 5), rr = r & 15, cc = c & 31, ob = rr * 64 + cc * 2; return st * 1024 + (ob ^ (((ob >> 9) & 1) << 5)); }
__host__ __device__ __forceinline__ void stage_rc(int b, int& R, int& C) { const int st = b / 1024, sb = b % 1024, swz = sb ^ (((sb >> 9) & 1) << 5); R = (st >> 1) * 16 + swz / 64; C = (st & 1) * 32 + (swz % 64) / 2; }
__host__ __device__ __forceinline__ int perm32(int rho) { const int n = rho >> 4, i = rho & 15; return 8 * (i >> 2) + 4 * n + (i & 3); }

struct Unit { int pm, pn; };
struct Gemm { const bf16_t* A; const bf16_t* Bt; int M, N, K; };

struct StaticOrder {
    int nM, nN, nwg, G, c;
    __host__ __device__ void init(int M, int N, int G_, int c_) { nM = M / BM; nN = N / BM; nwg = nM * nN; G = G_; c = c_; }
    __host__ __device__ bool next(int i, Unit& u) const {
        const long L = (long)i * G + c; if (L >= nwg) return false;
        int wgid = (int)L; { const int q = nwg / NXCD, r = nwg % NXCD, xcd = wgid % NXCD, off = wgid / NXCD; wgid = (xcd < r ? xcd * (q + 1) : r * (q + 1) + (xcd - r) * q) + off; }
        const int nig = WGM * nN, gid = wgid / nig, fm = gid * WGM, gsz = (nM - fm) < WGM ? (nM - fm) : WGM;
        u.pm = fm + ((wgid % nig) % gsz); u.pn = (wgid % nig) / gsz; return true;
    }
    __device__ __forceinline__ void a_ready(const Unit&) const {}
    __device__ __forceinline__ void done(const Unit&) const {}
};

__device__ __forceinline__ unsigned cvt_pk_bf16(float lo, float hi) { unsigned r; asm volatile("v_cvt_pk_bf16_f32 %0, %1, %2" : "=v"(r) : "v"(lo), "v"(hi)); return r; }
typedef float f32x2 __attribute__((ext_vector_type(2)));
__device__ __forceinline__ f32x2 gelu_pk(f32x2 v) {
    const f32x2 av = __builtin_elementwise_abs(v), d = av * 0.2316418882f + 1.0f;
    f32x2 t; t.x = __builtin_amdgcn_rcpf(d.x); t.y = __builtin_amdgcn_rcpf(d.y);
    f32x2 q = t * 0.5307027145f + (-0.7265760135f); q = q * t + 0.7107068705f; q = q * t + (-0.142248368f); q = q * t + 0.127414796f; q = q * t;
    const f32x2 s = (v * v) * (-0.72134752044f);
    f32x2 e; e.x = __builtin_amdgcn_exp2f(s.x); e.y = __builtin_amdgcn_exp2f(s.y);
    const f32x2 m = v * (q * e), r = v - m;
    f32x2 o; o.x = v.x < 0.f ? m.x : r.x; o.y = v.y < 0.f ? m.y : r.y; return o;
}


__device__ __forceinline__ float fsigmoid(float x) { return __builtin_amdgcn_rcpf(1.0f + __expf(-x)); }
__device__ __forceinline__ float bflo(unsigned u) { return __builtin_bit_cast(float, u << 16); }
__device__ __forceinline__ float bfhi(unsigned u) { return __builtin_bit_cast(float, u & 0xffff0000u); }
#ifndef FP4_CLIP
#define FP4_CLIP 1.0f
#endif
#ifndef TJOB_NT
#define TJOB_NT 0
#endif
#ifndef G1_NT
#define G1_NT 0
#endif
#ifndef PEER_U4
#define PEER_U4 1
#endif
#ifndef PEER_V4
#define PEER_V4 1
#endif
#ifndef F6_ORDER
#define F6_ORDER 0
#endif
#ifndef PEER_UI4
#define PEER_UI4 1
#endif
#ifndef UI4_STEP
#define UI4_STEP 0.35f
#endif
constexpr int PEER_ROWB_U = PEER_U4 ? 1024 : 1536, PEER_ROWB_V = PEER_V4 ? 1024 : 1536;
constexpr float QSCALE = 0.18033688011112042f;

struct EpiPlain {
    static constexpr bool PERM = true, AFTER_DRAIN = false;
    bf16_t* O; int ldc;
    __device__ __forceinline__ void operator()(const f32x4 (&acc)[2][2][4][2], const Unit& u, int wr, int wc, int fr, int fq) const {
        const int row0 = u.pm * BM + wr * 64 + fr, col0 = u.pn * BM + wc * 32 + 8 * fq;
#pragma unroll
        for (int ai = 0; ai < 2; ++ai)
#pragma unroll
            for (int m = 0; m < 4; ++m) { bf16_t* rowp = O + (size_t)(row0 + ai * HALF + m * 16) * ldc + col0;
#pragma unroll
                for (int bj = 0; bj < 2; ++bj) { const f32x4 v0 = acc[ai][bj][m][0], v1 = acc[ai][bj][m][1];
                    u32x4 w; w.x = cvt_pk_bf16(v0[0], v0[1]); w.y = cvt_pk_bf16(v0[2], v0[3]); w.z = cvt_pk_bf16(v1[0], v1[1]); w.w = cvt_pk_bf16(v1[2], v1[3]);
                    *(u32x4*)(rowp + bj * HALF) = w; } }
    }
};

constexpr size_t G1_MiB = 1u << 20, G1_O0 = 140 * G1_MiB, G1_O1 = 172 * G1_MiB, G1_O2 = 204 * G1_MiB, G1_O3 = 236 * G1_MiB, G1_O4 = 332 * G1_MiB, G1_O5 = 364 * G1_MiB, G1_O6 = 268 * G1_MiB, G1_O7 = 300 * G1_MiB, G1_O8 = 396 * G1_MiB, G1_O9 = 460 * G1_MiB;
struct EpiPlainS {
    static constexpr bool PERM = true, AFTER_DRAIN = false;
    bf16_t* O; int ldc; const float* sa; const float* sb;
    __device__ __forceinline__ void operator()(const f32x4 (&acc)[2][2][4][2], const Unit& u, int wr, int wc, int fr, int fq) const {
        const int row0 = u.pm * BM + wr * 64 + fr, col0 = u.pn * BM + wc * 32 + 8 * fq;
        float rsc[8]; f32x4 csc[2][2];
#pragma unroll
        for (int ai = 0; ai < 2; ++ai)
#pragma unroll
            for (int m = 0; m < 4; ++m) rsc[ai * 4 + m] = sa[row0 + ai * HALF + m * 16];
#pragma unroll
        for (int bj = 0; bj < 2; ++bj) { csc[bj][0] = *(const f32x4*)(sb + col0 + bj * HALF); csc[bj][1] = *(const f32x4*)(sb + col0 + bj * HALF + 4); }
#pragma unroll
        for (int ai = 0; ai < 2; ++ai)
#pragma unroll
            for (int m = 0; m < 4; ++m) { bf16_t* rowp = O + (size_t)(row0 + ai * HALF + m * 16) * ldc + col0;
#pragma unroll
                for (int bj = 0; bj < 2; ++bj) { const f32x4 v0 = acc[ai][bj][m][0] * csc[bj][0] * rsc[ai * 4 + m], v1 = acc[ai][bj][m][1] * csc[bj][1] * rsc[ai * 4 + m];
                    u32x4 w; w.x = cvt_pk_bf16(v0[0], v0[1]); w.y = cvt_pk_bf16(v0[2], v0[3]); w.z = cvt_pk_bf16(v1[0], v1[1]); w.w = cvt_pk_bf16(v1[2], v1[3]);
                    *(u32x4*)(rowp + bj * HALF) = w; } }
    }
};

template <int VAR  > struct EpiG1T {
    static constexpr bool PERM = true, AFTER_DRAIN = false;
    unsigned char* ws; const int* positions; const float* sa; const float* sb;
    const float* tsrc_u; const float* tsrc_v; unsigned char* tdst_u; unsigned char* tdst_v; float* tsc_u; float* tsc_v; mutable int cnt;
    __device__ __forceinline__ void operator()(const f32x4 (&acc)[2][2][4][2], const Unit& u, int wr, int wc, int fr, int fq) const {
        const bool tjob = (VAR == 0) && (cnt < 8);
        const int tlane = fq * 16 + fr, trow0 = cnt * 4096 + 2 * ((int)blockIdx.x * 8 + wr * 4 + wc);
        f32x4 tv[8];
#define G1_TLOAD(j_) do { const int r_ = trow0 + (j_); const float* rp_ = (r_ < 16384 ? tsrc_u + (size_t)r_ * 2048 : tsrc_v + (size_t)(r_ - 16384) * 2048); \
            int tl_ = tlane; asm volatile("" : "+v"(tl_));     \
            _Pragma("unroll") for (int q = 0; q < 8; ++q) tv[q] = *(const f32x4*)(rp_ + q * 256 + 4 * tl_); } while (0)
#define G1_TPROC(j_) do { const int r = trow0 + (j_); float am = 0.f; const bool isu = r < 16384; const bool f4 = isu ? (PEER_U4 != 0) : (PEER_V4 != 0); \
            _Pragma("unroll") for (int q = 0; q < 8; ++q) am = fmaxf(am, fmaxf(fmaxf(__builtin_fabsf(tv[q][0]), __builtin_fabsf(tv[q][1])), fmaxf(__builtin_fabsf(tv[q][2]), __builtin_fabsf(tv[q][3])))); \
            _Pragma("unroll") for (int o = 1; o < 64; o <<= 1) am = fmaxf(am, __shfl_xor(am, o)); \
            float sc = am > 0.f ? am * (f4 ? (FP4_CLIP / 6.0f) : (1.0f / 7.5f)) : 1.0f; \
            if (isu && (PEER_UI4 != 0)) { float ss = 0.f; \
                _Pragma("unroll") for (int q = 0; q < 8; ++q) ss += (tv[q][0] * tv[q][0] + tv[q][1] * tv[q][1]) + (tv[q][2] * tv[q][2] + tv[q][3] * tv[q][3]); \
                _Pragma("unroll") for (int o = 1; o < 64; o <<= 1) ss += __shfl_xor(ss, o); \
                sc = am > 0.f ? fminf(am * (1.0f / 7.0f), UI4_STEP * __builtin_sqrtf(ss * (1.0f / 2048.0f))) : 1.0f; } \
            const float inv = 1.0f / sc; \
            unsigned char* op = isu ? tdst_u + (size_t)r * PEER_ROWB_U : tdst_v + (size_t)(r - 16384) * PEER_ROWB_V; \
            int tlane_s = tlane; asm volatile("" : "+v"(tlane_s));     \
            if (isu && (PEER_UI4 != 0)) { unsigned w4[4];        \
                _Pragma("unroll") for (int d = 0; d < 4; ++d) { unsigned w = 0u; \
                    _Pragma("unroll") for (int c = 0; c < 4; ++c) { \
                        const unsigned n0 = __builtin_bit_cast(unsigned, __builtin_amdgcn_fmed3f(tv[2 * d][c] * inv, -7.0f, 7.0f) + 12582912.0f) & 15u; \
                        const unsigned n1 = __builtin_bit_cast(unsigned, __builtin_amdgcn_fmed3f(tv[2 * d + 1][c] * inv, -7.0f, 7.0f) + 12582912.0f) & 15u; \
                        w |= (n0 << (8 * c)) | (n1 << (8 * c + 4)); } \
                    w4[d] = w; } \
                *(u32x4*)(op + tlane_s * 16) = (u32x4){w4[0], w4[1], w4[2], w4[3]}; \
            } else if (f4) { unsigned w4[4]; \
                _Pragma("unroll") for (int d = 0; d < 4; ++d) { unsigned w = 0u; \
                    w = __builtin_amdgcn_cvt_scalef32_pk_fp4_f32(w, tv[2 * d][0] * inv, tv[2 * d][1] * inv, 1.0f, 0); w = __builtin_amdgcn_cvt_scalef32_pk_fp4_f32(w, tv[2 * d][2] * inv, tv[2 * d][3] * inv, 1.0f, 1); \
                    w = __builtin_amdgcn_cvt_scalef32_pk_fp4_f32(w, tv[2 * d + 1][0] * inv, tv[2 * d + 1][1] * inv, 1.0f, 2); w = __builtin_amdgcn_cvt_scalef32_pk_fp4_f32(w, tv[2 * d + 1][2] * inv, tv[2 * d + 1][3] * inv, 1.0f, 3); \
                    w4[d] = w; } \
                *(u32x4*)(op + tlane_s * 16) = (u32x4){w4[0], w4[1], w4[2], w4[3]}; \
            } else { typedef __bf16 bf16x32 __attribute__((ext_vector_type(32))); typedef int i32x6 __attribute__((ext_vector_type(6))); typedef unsigned u32x2 __attribute__((ext_vector_type(2))); bf16x32 b; \
                typedef float f32x16 __attribute__((ext_vector_type(16))); f32x16 x16, y16; i32x6 w6; \
                if (F6_ORDER == 2) { _Pragma("unroll") for (int q = 0; q < 8; ++q) { b[4 * q] = (__bf16)(tv[q][0] * inv); b[4 * q + 1] = (__bf16)(tv[q][1] * inv); b[4 * q + 2] = (__bf16)(tv[q][2] * inv); b[4 * q + 3] = (__bf16)(tv[q][3] * inv); } \
                    w6 = __builtin_amdgcn_cvt_scalef32_pk32_fp6_bf16(b, 1.0f); } else { \
                _Pragma("unroll") for (int q = 0; q < 4; ++q) { _Pragma("unroll") for (int c = 0; c < 4; ++c) { \
                    if (F6_ORDER == 0) { x16[4 * q + c] = tv[q][c] * inv; y16[4 * q + c] = tv[q + 4][c] * inv; } \
                    else { const int i0 = 4 * q + c, i1 = 16 + 4 * q + c;     \
                        if (i0 & 1) y16[i0 >> 1] = tv[q][c] * inv; else x16[i0 >> 1] = tv[q][c] * inv; \
                        if (i1 & 1) y16[i1 >> 1] = tv[q + 4][c] * inv; else x16[i1 >> 1] = tv[q + 4][c] * inv; } } } \
                w6 = __builtin_amdgcn_cvt_scalef32_2xpk16_fp6_f32(x16, y16, 1.0f); } \
                *(u32x4*)(op + tlane_s * 16) = (u32x4){(unsigned)w6[0], (unsigned)w6[1], (unsigned)w6[2], (unsigned)w6[3]}; \
                *(u32x2*)(op + 1024 + tlane_s * 8) = (u32x2){(unsigned)w6[4], (unsigned)w6[5]}; } \
            if (tlane == 0) { if (isu) tsc_u[r] = sc; else tsc_v[r - 16384] = sc; } } while (0)
        if (tjob) G1_TLOAD(0);
        const int pn = u.pn; int part, colt, ldc;
        if (pn < 32) { part = pn >> 2; colt = (pn & 3) * 256; ldc = 1024; } else { part = 8 + ((pn - 32) >> 3); colt = ((pn - 32) & 7) * 256; ldc = 2048; }
        const size_t off = part == 0 ? G1_O0 : part == 1 ? G1_O1 : part == 2 ? G1_O2 : part == 3 ? G1_O3 : part == 4 ? G1_O4 : part == 5 ? G1_O5 : part == 6 ? G1_O6 : part == 7 ? G1_O7 : part == 8 ? G1_O8 : G1_O9;
        bf16_t* base = (bf16_t*)(ws + off);
        const int row0 = u.pm * BM + wr * 64 + fr, col0 = colt + wc * 32 + 8 * fq;
        const int mode = (VAR == 1 || VAR == 3) ? 0 : ((part <= 1) ? 1 : ((part == 3 || part == 7) ? 2 : (part >= 8 ? 3 : 0)));
        const bool do_rope = (mode == 1) && ((wc & 1) == 0);
        const float qs = (part == 0) ? QSCALE : 1.0f;
        float rsc[8]; const float cs = sb[u.pn];
#pragma unroll
        for (int ai = 0; ai < 2; ++ai)
#pragma unroll
            for (int m = 0; m < 4; ++m) rsc[ai * 4 + m] = sa[row0 + ai * HALF + m * 16] * cs;
        const float fr8[8] = {0.15915494309189535f, 0.03086376340470123f, 0.005985185712713705f, 0.001160663641240061f, 0.00022507907903927653f, 4.364795279280289e-05f, 8.464330808241401e-06f, 1.6414262627950345e-06f};
#pragma unroll
        for (int ai = 0; ai < 2; ++ai) {
            if (ai == 1 && tjob) { G1_TPROC(0); G1_TLOAD(1); }
#pragma unroll
            for (int m = 0; m < 4; ++m) {
                const int row = row0 + ai * HALF + m * 16;
                bf16_t* rowp = base + (size_t)row * ldc + col0;
                const float posf = do_rope ? (float)positions[row] : 0.f;
#pragma unroll
                for (int bj = 0; bj < 2; ++bj) {
                    f32x4 v[2] = {acc[ai][bj][m][0] * rsc[ai * 4 + m], acc[ai][bj][m][1] * rsc[ai * 4 + m]};
                    if (mode == 1) {
                        if (do_rope) {
#pragma unroll
                            for (int n = 0; n < 2; ++n)
#pragma unroll
                                for (int i = 0; i < 4; ++i) { const float val = v[n][i]; const float p = __shfl_xor(val, 16);
                                    float rv = posf * fr8[4 * n + i]; rv = rv - __builtin_floorf(rv); const float c = __builtin_amdgcn_cosf(rv), s = __builtin_amdgcn_sinf(rv);
                                    v[n][i] = (fq == 0) ? (val * c - p * s) : ((fq == 1) ? (val * c + p * s) : val); }
                        }
                        v[0] = v[0] * qs; v[1] = v[1] * qs;
                    } else if (mode == 2) {
#pragma unroll
                        for (int n = 0; n < 2; ++n)
#pragma unroll
                            for (int i = 0; i < 4; ++i) v[n][i] = v[n][i] * fsigmoid(v[n][i]);
                    } else if (mode == 3) {
#pragma unroll
                        for (int n = 0; n < 2; ++n)
#pragma unroll
                            for (int i = 0; i < 4; ++i) v[n][i] = fsigmoid(v[n][i]);
                    }
                    u32x4 w; w.x = cvt_pk_bf16(v[0][0], v[0][1]); w.y = cvt_pk_bf16(v[0][2], v[0][3]); w.z = cvt_pk_bf16(v[1][0], v[1][1]); w.w = cvt_pk_bf16(v[1][2], v[1][3]);
                    if (VAR == 2) asm volatile("" :: "v"(w), "v"(rowp)); else if (VAR == 3) { const int l3 = fq * 16 + fr; *(u32x4*)(base + (size_t)(u.pm * BM + (wr * 4 + wc) * 32 + ((ai * 4 + m) * 2 + bj) * 2 + (l3 >> 5)) * ldc + colt + (l3 & 31) * 8) = w; } else *(u32x4*)(rowp + bj * HALF) = w;
                }
            }
        }
        if (tjob) G1_TPROC(1);
#ifdef PROBE_EPI_DRAIN
        asm volatile("s_waitcnt vmcnt(0)" ::: "memory");
#endif
#ifdef PROBE_TJOB2
        if (tjob) { G1_TLOAD(0); G1_TPROC(0); G1_TLOAD(1); G1_TPROC(1); }
#endif
#undef G1_TLOAD
#undef G1_TPROC
        ++cnt;
    }
};
typedef EpiG1T<0> EpiG1;
template <bool ADD> struct EpiGate {
    static constexpr bool PERM = true, AFTER_DRAIN = false;
    bf16_t* Y; const bf16_t* G; int ldc; const float* sa; const float* sb;
    __device__ __forceinline__ void operator()(const f32x4 (&acc)[2][2][4][2], const Unit& u, int wr, int wc, int fr, int fq) const {
        const int row0 = u.pm * BM + wr * 64 + fr, col0 = u.pn * BM + wc * 32 + 8 * fq;
        const float cs = sa ? sb[u.pn] : 1.0f;
#pragma unroll
        for (int ai = 0; ai < 2; ++ai) {
            u32x4 gq[4][2], yq[4][2]; float rsc[4];
#pragma unroll
            for (int m = 0; m < 4; ++m) { rsc[m] = sa ? sa[row0 + ai * HALF + m * 16] * cs : 1.0f;
#pragma unroll
                for (int bj = 0; bj < 2; ++bj) { const size_t ro = (size_t)(row0 + ai * HALF + m * 16) * ldc + col0 + bj * HALF;
                    gq[m][bj] = *(const u32x4*)(G + ro); if (ADD) yq[m][bj] = *(const u32x4*)(Y + ro); } }
#pragma unroll
            for (int m = 0; m < 4; ++m)
#pragma unroll
                for (int bj = 0; bj < 2; ++bj) { const size_t ro = (size_t)(row0 + ai * HALF + m * 16) * ldc + col0 + bj * HALF;
                    const f32x4 v0 = acc[ai][bj][m][0] * rsc[m], v1 = acc[ai][bj][m][1] * rsc[m]; const u32x4 g = gq[m][bj];
                    float r[8] = {v0[0] * bflo(g.x), v0[1] * bfhi(g.x), v0[2] * bflo(g.y), v0[3] * bfhi(g.y), v1[0] * bflo(g.z), v1[1] * bfhi(g.z), v1[2] * bflo(g.w), v1[3] * bfhi(g.w)};
                    if (ADD) { const u32x4 y = yq[m][bj];
                        r[0] += bflo(y.x); r[1] += bfhi(y.x); r[2] += bflo(y.y); r[3] += bfhi(y.y); r[4] += bflo(y.z); r[5] += bfhi(y.z); r[6] += bflo(y.w); r[7] += bfhi(y.w); }
                    u32x4 w; w.x = cvt_pk_bf16(r[0], r[1]); w.y = cvt_pk_bf16(r[2], r[3]); w.z = cvt_pk_bf16(r[4], r[5]); w.w = cvt_pk_bf16(r[6], r[7]);
                    *(u32x4*)(Y + ro) = w; }
        }
    }
};

struct EpiResGate {
    static constexpr bool PERM = false, AFTER_DRAIN = false;
    const float* base; float* out; const float* gate; int ldc; int gate_ld; int rows_per_batch; const float* sa; const float* sb;
    __device__ __forceinline__ void operator()(const f32x4 (&acc)[2][2][4][2], const Unit& u, int wr, int wc, int fr, int fq) const {
        const int row0 = u.pm * BM + wr * 64 + fr, col0 = u.pn * BM + wc * 32 + 4 * fq;
        const float* gp = gate + (size_t)((u.pm * BM) / rows_per_batch) * gate_ld + col0;
        const float cs = sa ? sb[u.pn] : 1.0f;
        f32x4 gv[2][2];
#pragma unroll
        for (int bj = 0; bj < 2; ++bj)
#pragma unroll
            for (int n = 0; n < 2; ++n) gv[bj][n] = *(const f32x4*)(gp + bj * HALF + n * 16) * cs;
#pragma unroll
        for (int ai = 0; ai < 2; ++ai)
#pragma unroll
            for (int mh = 0; mh < 2; ++mh) {
                f32x4 xb[2][2][2]; float rs[2];
#pragma unroll
                for (int ml = 0; ml < 2; ++ml) rs[ml] = sa ? sa[row0 + ai * HALF + (2 * mh + ml) * 16] : 1.0f;
#pragma unroll
                for (int ml = 0; ml < 2; ++ml)
#pragma unroll
                    for (int bj = 0; bj < 2; ++bj)
#pragma unroll
                        for (int n = 0; n < 2; ++n) xb[ml][bj][n] = *(const f32x4*)(base + (size_t)(row0 + ai * HALF + (2 * mh + ml) * 16) * ldc + col0 + bj * HALF + n * 16);
#pragma unroll
                for (int ml = 0; ml < 2; ++ml)
#pragma unroll
                    for (int bj = 0; bj < 2; ++bj)
#pragma unroll
                        for (int n = 0; n < 2; ++n) *(f32x4*)(out + (size_t)(row0 + ai * HALF + (2 * mh + ml) * 16) * ldc + col0 + bj * HALF + n * 16) = xb[ml][bj][n] + gv[bj][n] * (acc[ai][bj][2 * mh + ml][n] * rs[ml]);
            }
    }
};

struct EpiNull {
    static constexpr bool PERM = true, AFTER_DRAIN = false;
    __device__ __forceinline__ void operator()(const f32x4 (&acc)[2][2][4][2], const Unit& u, int wr, int wc, int fr, int fq) const {
#pragma unroll
        for (int ai = 0; ai < 2; ++ai)
#pragma unroll
            for (int bj = 0; bj < 2; ++bj)
#pragma unroll
                for (int m = 0; m < 4; ++m)
#pragma unroll
                    for (int n = 0; n < 2; ++n) asm volatile("" :: "v"(acc[ai][bj][m][n]));
    }
};
template <class Epi, class Sched, bool ALIGN_EPI = false, bool SP2 = false, bool I8 = false>
__device__ __forceinline__ void gemm_phase(PG8_LAS unsigned char* lds, const Gemm g, const Sched& S, const Epi& E) {
    int tid_ = threadIdx.x; asm volatile("" : "+v"(tid_));
    const int tid = tid_, wid = __builtin_amdgcn_readfirstlane(tid >> 6), lane = tid & 63, wr = wid >> 2, wc = wid & 3, fr = lane & 15, fq = lane >> 4;
    const int K = g.K, nt = K / BK;
    unsigned voffA[2], voffB[2];
#pragma unroll
    for (int i = 0; i < 2; ++i) { int R, C; stage_rc(tid * 16 + i * 8192, R, C); const int Rb = Epi::PERM ? ((R & ~31) + perm32(R & 31)) : R;
        voffA[i] = (unsigned)(R * K + C) * 2u; voffB[i] = (unsigned)(Rb * K + C) * 2u; }
    const size_t kstep = (size_t)(BK * 2);
    const size_t hstep = (size_t)HALF * K * 2;
    const size_t tstep = 2 * hstep;
    const unsigned ldsw = (unsigned)wid * 1024u;
    const int aoff = lds_byte(wr * 64 + fr, fq * 8), boff = lds_byte(wc * 32 + fr, fq * 8);
#define PG8_SA(b, h) (((b) * 2 + (h)) * HTB)
#define PG8_SB(b, h) ((4 + (b) * 2 + (h)) * HTB)
#define PG8_STAGE(bufoff, gbase, voff) do { _Pragma("unroll") for (int _i = 0; _i < 2; ++_i) \
        __builtin_amdgcn_global_load_lds((const unsigned*)((const char*)(gbase) + (voff)[_i]), (PG8_LAS unsigned*)(lds + (bufoff) + ldsw + _i * 8192), 16, 0, 0); } while (0)
#define PG8_LDA(dst, b, h) do { _Pragma("unroll") for (int m = 0; m < 4; ++m) _Pragma("unroll") for (int k = 0; k < 2; ++k) dst[m][k] = *(const PG8_LAS bf16x8*)(lds + PG8_SA(b, h) + aoff + m * 2048 + k * 1024); } while (0)
#define PG8_LDB(dst, b, h) do { _Pragma("unroll") for (int n = 0; n < 2; ++n) _Pragma("unroll") for (int k = 0; k < 2; ++k) dst[n][k] = *(const PG8_LAS bf16x8*)(lds + PG8_SB(b, h) + boff + n * 2048 + k * 1024); } while (0)
#define PG8_MMA(ai, bj, At, Bt) do { __builtin_amdgcn_s_setprio(1); _Pragma("unroll") for (int m = 0; m < 4; ++m) _Pragma("unroll") for (int n = 0; n < 2; ++n) _Pragma("unroll") for (int k = 0; k < 2; ++k) \
        { if constexpr (I8) acc[ai][bj][m][n] = __builtin_bit_cast(acc_t, __builtin_amdgcn_mfma_i32_16x16x64_i8(__builtin_bit_cast(i32x4_t, Bt[n][k]), __builtin_bit_cast(i32x4_t, At[m][k]), __builtin_bit_cast(i32x4_t, acc[ai][bj][m][n]), 0, 0, 0)); \
          else acc[ai][bj][m][n] = __builtin_bit_cast(acc_t, __builtin_amdgcn_mfma_f32_16x16x32_bf16(Bt[n][k], At[m][k], __builtin_bit_cast(f32x4, acc[ai][bj][m][n]), 0, 0, 0)); } __builtin_amdgcn_s_setprio(0); } while (0)
#define PG8_WAIT_V(n) asm volatile("s_waitcnt vmcnt(" #n ")" ::: "memory")
#define PG8_WAIT_L(n) asm volatile("s_waitcnt lgkmcnt(" #n ")" ::: "memory")
#define PG8_BAR __builtin_amdgcn_s_barrier()
#define PG8_SCHED __builtin_amdgcn_sched_barrier(0)
    Unit cur, nxt; int ui = 0;
    if (!S.next(0, cur)) return;
    typedef int i32x4_t __attribute__((ext_vector_type(4)));
    typedef f32x4 acc_t;
    acc_t acc[2][2][4][2];
#pragma unroll
    for (int a = 0; a < 2; ++a)
#pragma unroll
        for (int b = 0; b < 2; ++b)
#pragma unroll
            for (int m = 0; m < 4; ++m)
#pragma unroll
                for (int n = 0; n < 2; ++n) acc[a][b][m][n] = (f32x4){0.f, 0.f, 0.f, 0.f};
    bf16x8 At[4][2], B0[2][2], B1[2][2];
    const char* cA = (const char*)g.A + (size_t)cur.pm * tstep; const char* cB = (const char*)g.Bt + (size_t)cur.pn * tstep;
    S.a_ready(cur);
    if constexpr (SP2) {
        PG8_STAGE(PG8_SB(0, 0), cB, voffB); PG8_STAGE(PG8_SB(0, 1), cB + hstep, voffB); PG8_STAGE(PG8_SA(0, 0), cA, voffA); PG8_STAGE(PG8_SA(0, 1), cA + hstep, voffA);
        if (wr == 1) PG8_BAR;
        PG8_WAIT_V(2); PG8_BAR;
        PG8_STAGE(PG8_SB(1, 0), cB + kstep, voffB); PG8_STAGE(PG8_SA(1, 0), cA + kstep, voffA); PG8_STAGE(PG8_SB(1, 1), cB + hstep + kstep, voffB);
        PG8_WAIT_V(6); PG8_BAR;
    } else {
        PG8_STAGE(PG8_SB(0, 0), cB, voffB); PG8_STAGE(PG8_SA(0, 0), cA, voffA); PG8_STAGE(PG8_SB(0, 1), cB + hstep, voffB); PG8_STAGE(PG8_SA(0, 1), cA + hstep, voffA);
        if (wr == 1) PG8_BAR;
        PG8_WAIT_V(4); PG8_BAR;
        PG8_STAGE(PG8_SB(1, 0), cB + kstep, voffB); PG8_STAGE(PG8_SA(1, 0), cA + kstep, voffA); PG8_STAGE(PG8_SB(1, 1), cB + hstep + kstep, voffB);
        PG8_WAIT_V(6); PG8_BAR;
    }
    for (;;) {
        const bool has_next = S.next(ui + 1, nxt);
        const char* nA = has_next ? (const char*)g.A + (size_t)nxt.pm * tstep : cA; const char* nB = has_next ? (const char*)g.Bt + (size_t)nxt.pn * tstep : cB;
        for (int t = 0; t < nt; t += 2) {
            const bool last = (t == nt - 2);
            const char* a1 = cA + (size_t)(t + 1) * kstep;
            const char* a2 = last ? nA : cA + (size_t)(t + 2) * kstep; const char* b2 = last ? nB : cB + (size_t)(t + 2) * kstep;
            const char* a3 = a2 + kstep; const char* b3 = b2 + kstep;
            if (last && has_next) S.a_ready(nxt);
            if constexpr (SP2) {
            PG8_LDB(B0, 0, 0); PG8_LDB(B1, 0, 1); PG8_SCHED; PG8_LDA(At, 0, 0); PG8_STAGE(PG8_SA(1, 1), a1 + hstep, voffA);
            PG8_WAIT_V(8); PG8_WAIT_L(0); PG8_BAR; PG8_MMA(0, 0, At, B0); PG8_MMA(0, 1, At, B1); PG8_BAR; PG8_SCHED;
            PG8_LDA(At, 0, 1); PG8_STAGE(PG8_SB(0, 0), b2, voffB); PG8_STAGE(PG8_SB(0, 1), b2 + hstep, voffB); PG8_STAGE(PG8_SA(0, 0), a2, voffA);
            PG8_WAIT_V(8); PG8_WAIT_L(0); PG8_BAR; PG8_MMA(1, 0, At, B0); PG8_MMA(1, 1, At, B1); PG8_BAR; PG8_SCHED;
            PG8_LDB(B0, 1, 0); PG8_LDB(B1, 1, 1); PG8_SCHED; PG8_LDA(At, 1, 0); PG8_STAGE(PG8_SA(0, 1), a2 + hstep, voffA);
            PG8_WAIT_V(8); PG8_WAIT_L(0); PG8_BAR; PG8_MMA(0, 0, At, B0); PG8_MMA(0, 1, At, B1); PG8_BAR; PG8_SCHED;
            PG8_LDA(At, 1, 1); PG8_STAGE(PG8_SB(1, 0), b3, voffB); PG8_STAGE(PG8_SB(1, 1), b3 + hstep, voffB); PG8_STAGE(PG8_SA(1, 0), a3, voffA);
            PG8_WAIT_V(8); PG8_WAIT_L(0); PG8_BAR; PG8_MMA(1, 0, At, B0); PG8_MMA(1, 1, At, B1); PG8_BAR; PG8_SCHED;
            } else {
            PG8_LDB(B0, 0, 0); PG8_SCHED; PG8_LDA(At, 0, 0); PG8_STAGE(PG8_SA(1, 1), a1 + hstep, voffA);
            PG8_WAIT_L(8); PG8_BAR; PG8_WAIT_L(0); PG8_MMA(0, 0, At, B0); PG8_BAR; PG8_SCHED;
            PG8_LDB(B1, 0, 1); PG8_STAGE(PG8_SB(0, 0), b2, voffB);
            PG8_BAR; PG8_WAIT_L(0); PG8_MMA(0, 1, At, B1); PG8_BAR;
            PG8_LDA(At, 0, 1); PG8_STAGE(PG8_SA(0, 0), a2, voffA);
            PG8_BAR; PG8_WAIT_L(0); PG8_MMA(1, 0, At, B0); PG8_BAR; PG8_SCHED;
            PG8_STAGE(PG8_SB(0, 1), b2 + hstep, voffB);
            PG8_WAIT_V(6); PG8_BAR; PG8_MMA(1, 1, At, B1); PG8_BAR;
            PG8_LDB(B0, 1, 0); PG8_SCHED; PG8_LDA(At, 1, 0); PG8_STAGE(PG8_SA(0, 1), a2 + hstep, voffA);
            PG8_WAIT_L(8); PG8_BAR; PG8_WAIT_L(0); PG8_MMA(0, 0, At, B0); PG8_BAR; PG8_SCHED;
            PG8_LDB(B1, 1, 1); PG8_STAGE(PG8_SB(1, 0), b3, voffB);
            PG8_BAR; PG8_WAIT_L(0); PG8_MMA(0, 1, At, B1); PG8_BAR;
            PG8_LDA(At, 1, 1); PG8_STAGE(PG8_SA(1, 0), a3, voffA);
            PG8_BAR; PG8_WAIT_L(0); PG8_MMA(1, 0, At, B0); PG8_BAR; PG8_SCHED;
            PG8_STAGE(PG8_SB(1, 1), b3 + hstep, voffB);
            PG8_WAIT_V(6); PG8_BAR; PG8_MMA(1, 1, At, B1); PG8_BAR;
            }
        }
        if constexpr (ALIGN_EPI) { if (wr == 0) PG8_BAR; }
        if constexpr (I8) {
#pragma unroll
            for (int a = 0; a < 2; ++a)
#pragma unroll
                for (int b = 0; b < 2; ++b)
#pragma unroll
                    for (int m = 0; m < 4; ++m)
#pragma unroll
                        for (int n = 0; n < 2; ++n) acc[a][b][m][n] = __builtin_convertvector(__builtin_bit_cast(i32x4_t, acc[a][b][m][n]), f32x4);
        }
        if constexpr (!Epi::AFTER_DRAIN) { E(acc, cur, wr, wc, fr, fq); S.done(cur); }
        if (!has_next) break;
#pragma unroll
        for (int a = 0; a < 2; ++a)
#pragma unroll
            for (int b = 0; b < 2; ++b)
#pragma unroll
                for (int m = 0; m < 4; ++m)
#pragma unroll
                    for (int n = 0; n < 2; ++n) acc[a][b][m][n] = (f32x4){0.f, 0.f, 0.f, 0.f};
        cur = nxt; cA = nA; cB = nB; ++ui;
        if constexpr (ALIGN_EPI) { if (wr == 1) PG8_BAR; }
    }
    PG8_WAIT_V(0);
    if constexpr (!ALIGN_EPI) { if (wr == 0) PG8_BAR; }
    PG8_BAR;
    if constexpr (Epi::AFTER_DRAIN) { E.fused(acc, cur, wr, wc, fr, fq, lds, wid, lane); S.done(cur); }
#undef PG8_SA
#undef PG8_SB
#undef PG8_STAGE
#undef PG8_LDA
#undef PG8_LDB
#undef PG8_MMA
#undef PG8_WAIT_V
#undef PG8_WAIT_L
#undef PG8_BAR
#undef PG8_SCHED
}
}

#ifndef DUP_MASK
#define DUP_MASK 0
#endif
constexpr int NWAVES = 8;
#ifndef MK_N_LAUNCHES
#define MK_N_LAUNCHES 1
#endif
constexpr int N_PHASES = 11;
constexpr int N_LAUNCHES = MK_N_LAUNCHES;

constexpr int BATCH = 8, SEQ = 2048, DM = 2048, T = BATCH * SEQ;
constexpr int IN_W = 12288, ADA_W = 6 * DM;
constexpr float EPS = 1e-6f;
constexpr float LAMBDA_INIT = 0.2f;
constexpr float THRL = 11.541560327111707f;

constexpr size_t MiB = 1u << 20;
constexpr size_t WS_CTL = 0, CTL_ZERO_BYTES = 192 * 1024;
constexpr size_t WS_COLMAX = 64 * 1024;
constexpr int CM_IN = 0, CM_Q = 12288, CM_A = 14336, CM_B = 16384, CM_O = 18432, CM_END = 20480;
constexpr size_t WS_ADA = 256 * 1024;
constexpr size_t WS_SA = 1 * MiB, WS_SB = 1 * MiB + 128 * 1024;
constexpr size_t WS_SBC = 1 * MiB + 448 * 1024;
constexpr size_t WS_SA2 = 1 * MiB + 64 * 1024;
constexpr size_t WS_SAO = 1 * MiB + 256 * 1024, WS_SAB = 1 * MiB + 320 * 1024, WS_SAY = 1 * MiB + 384 * 1024;
constexpr size_t WS_WIN = 4 * MiB;
constexpr size_t WS_OA = WS_WIN, WS_OA8 = 36 * MiB;
constexpr size_t WS_WA = 52 * MiB, WS_WB = 56 * MiB, WS_WOUT = 60 * MiB, WS_WQ = 68 * MiB;
constexpr size_t WS_H = 76 * MiB;
constexpr size_t WS_OF = WS_H, WS_OBW = WS_H + 32 * MiB, WS_H2 = WS_H;
constexpr size_t WS_DAQ = 140 * MiB, WS_DAK = 172 * MiB, WS_DAV = 204 * MiB;
constexpr size_t WS_Y = WS_DAQ;
constexpr size_t WS_Y8 = WS_DAV;
constexpr size_t WS_OB = WS_DAV;
constexpr size_t WS_HGQ = 236 * MiB, WS_HGI = 268 * MiB, WS_HGG = 300 * MiB, WS_HFF = 332 * MiB, WS_HFB = 364 * MiB;
constexpr size_t WS_GA = 396 * MiB, WS_GB = 460 * MiB;
constexpr size_t WS_QP = WS_GA;
constexpr size_t WS_EIDX = WS_GB, WS_EG = WS_GB + 8 * MiB, WS_AP = WS_GB + 16 * MiB;
constexpr size_t WS_U8 = 524 * MiB, WS_V8 = 548 * MiB, WS_SCU = 572 * MiB, WS_SCV = 572 * MiB + 65536;
constexpr size_t WS_STASH = 588 * MiB;
constexpr size_t WS_END = 620 * MiB;

constexpr int CW_TMO = 0, CW_CODE = 1, CW_CHK = 2;
constexpr int CW_BAR = 1024;

constexpr int RING_OFF = 0, RING_BYTES = 131072;
constexpr int LDSCTL_OFF = RING_BYTES, MISC_OFF = LDSCTL_OFF + 320;
constexpr int LDS_BYTES = 147456;
static_assert(pg8::G1_O0 == WS_DAQ && pg8::G1_O1 == WS_DAK && pg8::G1_O2 == WS_DAV && pg8::G1_O3 == WS_HGQ && pg8::G1_O4 == WS_HFF && pg8::G1_O5 == WS_HFB && pg8::G1_O6 == WS_HGI && pg8::G1_O7 == WS_HGG && pg8::G1_O8 == WS_GA && pg8::G1_O9 == WS_GB, "G1 part offsets");
#define GAS __attribute__((address_space(1)))
#define LAS __attribute__((address_space(3)))
typedef unsigned short bf16;
typedef unsigned v4u __attribute__((ext_vector_type(4)));
typedef float f32x4 __attribute__((ext_vector_type(4)));
typedef short bf16x8 __attribute__((ext_vector_type(8)));
typedef GAS unsigned gu32;
typedef GAS unsigned long long gu64;
#define RLX_AGENT __ATOMIC_RELAXED, __HIP_MEMORY_SCOPE_AGENT
#define LDS_WAIT() asm volatile("s_waitcnt lgkmcnt(0)" ::: "memory")
#define VM_WAIT() asm volatile("s_waitcnt vmcnt(0)" ::: "memory")
__device__ __forceinline__ unsigned long long rt() { return __builtin_amdgcn_s_memrealtime(); }
__device__ __forceinline__ unsigned f2bf(float f) { unsigned u = __builtin_bit_cast(unsigned, f); return (u + 0x7fffu + ((u >> 16) & 1u)) >> 16; }
__device__ __forceinline__ unsigned pk2(float lo, float hi) { return f2bf(lo) | (f2bf(hi) << 16); }

#define XB_TMO      128
#define XB_XCNT(j)  (256  + 64 * (j))
#define XB_XSUB(j)  (1280 + 64 * (j))
#define XB_XGEN(j)  (2304 + 64 * (j))
#define XB_TOP      3328
#define XB_TOPGEN   3392
#define XCD_BAR_WORDS 3456
#define XB_SPIN_CAP (1u << 18)

__device__ __forceinline__ unsigned xb_ld(unsigned* p)              { return __hip_atomic_load(p, __ATOMIC_RELAXED, __HIP_MEMORY_SCOPE_AGENT); }
__device__ __forceinline__ unsigned xb_add(unsigned* p, unsigned v) { return __hip_atomic_fetch_add(p, v, __ATOMIC_RELAXED, __HIP_MEMORY_SCOPE_AGENT); }
__device__ __forceinline__ unsigned xb_xcc_id() { return (unsigned)__builtin_amdgcn_s_getreg((3 << 11) | 20) & 0xFu; }
#define XB_SPIN(cond, bar) do { unsigned _sp = 0; while (cond) { __builtin_amdgcn_s_sleep(1); \
    if ((++_sp & 255u) == 0u) { if (xb_ld(&(bar)[XB_TMO])) break; if (_sp > XB_SPIN_CAP) { atomicAdd(&(bar)[XB_TMO], 1u); break; } } } } while (0)

struct XcdBarrier {
    unsigned* bar; unsigned x;
    volatile LAS unsigned* st;
};

__device__ __forceinline__ XcdBarrier xcd_barrier_post(unsigned* bar, volatile LAS unsigned* st) {
    XcdBarrier b; b.bar = bar; b.x = xb_xcc_id(); b.st = st;
    if (threadIdx.x == 0) (void)xb_add(&bar[XB_XCNT(b.x)], 1u);
    return b;
}
__device__ __forceinline__ void xcd_barrier_complete(unsigned* bar, unsigned x, unsigned& nloc, unsigned& nx) {
    const unsigned G = gridDim.x * gridDim.y * gridDim.z;
    unsigned sum, cnt, mine, sp = 0u;
    for (;;) {
        sum = 0u; cnt = 0u; mine = 0u;
#pragma unroll
        for (unsigned j = 0; j < 16; ++j) { const unsigned c = xb_ld(&bar[XB_XCNT(j)]); sum += c; cnt += (c > 0u) ? 1u : 0u; mine = (j == x) ? c : mine; }
        if (sum == G) break;
        __builtin_amdgcn_s_sleep(1);
        if ((++sp & 255u) == 0u) { if (xb_ld(&bar[XB_TMO])) break; if (sp > XB_SPIN_CAP) { atomicAdd(&bar[XB_TMO], 1u); break; } }
    }
    nloc = mine > 0u ? mine : 1u; nx = cnt > 0u ? cnt : 1u;
}

__device__ __forceinline__ void xcd_barrier(const XcdBarrier& b) {
    asm volatile("s_waitcnt vmcnt(0)" ::: "memory");
    __syncthreads();
    if (threadIdx.x == 0) {
        unsigned* bar = b.bar;
        __builtin_amdgcn_s_waitcnt(0);
        unsigned nloc = b.st[0], nx = b.st[1];
        if (nloc == 0u) { xcd_barrier_complete(bar, b.x, nloc, nx); b.st[0] = nloc; b.st[1] = nx; }
        const unsigned old = xb_add(&bar[XB_XSUB(b.x)], 1u);
        const unsigned gen = old / nloc;
        if (old + 1u == (gen + 1u) * nloc) {
            __builtin_amdgcn_fence(__ATOMIC_RELEASE, "agent");
            asm volatile("s_waitcnt vmcnt(0)" ::: "memory");
            const unsigned og = xb_add(&bar[XB_TOP], 1u);
            const unsigned tg = og / nx;
            if (og + 1u == (tg + 1u) * nx) xb_add(&bar[XB_TOPGEN], 1u);
            else XB_SPIN(xb_ld(&bar[XB_TOPGEN]) == tg, bar);
            __builtin_amdgcn_fence(__ATOMIC_ACQUIRE, "agent");
            xb_add(&bar[XB_XGEN(b.x)], 1u);
            asm volatile("s_waitcnt vmcnt(0)" ::: "memory");
        } else {
            XB_SPIN(xb_ld(&bar[XB_XGEN(b.x)]) == gen, bar);
            __builtin_amdgcn_fence(__ATOMIC_ACQUIRE, "agent");
            asm volatile("s_waitcnt vmcnt(0)" ::: "memory");
        }
    }
    __syncthreads();
}

typedef float f32x16 __attribute__((ext_vector_type(16)));
typedef short s16x4 __attribute__((ext_vector_type(4)));
typedef __bf16 bf16x2v __attribute__((ext_vector_type(2)));
typedef float f32x2v __attribute__((ext_vector_type(2)));

struct Frame {
    LAS unsigned char* lds;
    unsigned char* ldsg;
    volatile LAS unsigned* MISC;
    gu32* ctl;
    int tid, lane, wave;
    int vcu, G;
    unsigned char* ws;
    float* out;
};
#define IN_F(k) ((const float*)args.in[k])

__device__ __forceinline__ float wave_sum(float v) {
#pragma unroll
    for (int o = 1; o < 64; o <<= 1) v += __shfl_xor(v, o);
    return v;
}
__device__ __forceinline__ float fsig(float x) { return __builtin_amdgcn_rcpf(1.0f + __expf(-x)); }
__device__ __forceinline__ float bf_lo(unsigned u) { return __builtin_bit_cast(float, u << 16); }
__device__ __forceinline__ float bf_hi(unsigned u) { return __builtin_bit_cast(float, u & 0xffff0000u); }
__device__ __forceinline__ unsigned cvtpk(float lo, float hi) { f32x2v v = {lo, hi}; bf16x2v b = __builtin_convertvector(v, bf16x2v); return __builtin_bit_cast(unsigned, b); }
__device__ __forceinline__ float dot2bf(unsigned a, unsigned b, float acc) { return __builtin_amdgcn_fdot2_f32_bf16(__builtin_bit_cast(bf16x2v, a), __builtin_bit_cast(bf16x2v, b), acc, false); }

struct TrItem { const float* W; bf16* WT; int K, N, k0, n0; int cm; int pc; };
__device__ __forceinline__ void tr_load(const TrItem& t, float (&r)[32], int lane) {
#pragma unroll
    for (int i = 0; i < 32; ++i) { const int kk = 2 * i + (lane >> 5); r[i] = t.W[(size_t)(t.k0 + kk) * t.N + t.n0 + (lane & 31)]; }
}
__device__ __forceinline__ void tr_proc(const TrItem& t, const float (&r)[32], LAS float* scr, int lane) {
#pragma unroll
    for (int i = 0; i < 32; ++i) { const int kk = 2 * i + (lane >> 5); scr[kk * 33 + (lane & 31)] = r[i]; }
    LDS_WAIT(); asm volatile("" ::: "memory");
    const int c = lane & 7;
#pragma unroll
    for (int j = 0; j < 4; ++j) { const int n = (lane >> 3) + 8 * j; const LAS float* s = scr + (8 * c) * 33 + n;
        v4u o; o.x = pk2(s[0 * 33], s[1 * 33]); o.y = pk2(s[2 * 33], s[3 * 33]); o.z = pk2(s[4 * 33], s[5 * 33]); o.w = pk2(s[6 * 33], s[7 * 33]);
        *(GAS v4u*)(t.WT + (size_t)(t.n0 + n) * t.K + t.k0 + 8 * c) = o; }
    LDS_WAIT(); asm volatile("" ::: "memory");
}
#define SAT8(v_) ((v_) < -127 ? -127 : ((v_) > 127 ? 127 : (v_)))
__device__ __forceinline__ void tr_proc_i8(const TrItem& t, const float (&r)[32], LAS float* scr, int lane, const unsigned* colmax, float* sb, float* sbc) {
#pragma unroll
    for (int i = 0; i < 32; ++i) { const int kk = 2 * i + (lane >> 5); scr[kk * 33 + (lane & 31)] = r[i]; }
    LDS_WAIT(); asm volatile("" ::: "memory");
    const int c = lane & 3;
    float tile_am;
    { const unsigned* cp = colmax + t.cm + (t.n0 & ~255) + 4 * lane; unsigned mx = cp[0] > cp[1] ? cp[0] : cp[1]; const unsigned m2 = cp[2] > cp[3] ? cp[2] : cp[3]; mx = mx > m2 ? mx : m2;
#pragma unroll
      for (int o = 1; o < 64; o <<= 1) { const unsigned ot = (unsigned)__shfl_xor((int)mx, o); mx = mx > ot ? mx : ot; }
      tile_am = __uint_as_float(mx); }
#pragma unroll
    for (int j = 0; j < 2; ++j) { const int n = (lane >> 2) + 16 * j; const LAS float* s = scr + (16 * c) * 33 + n;
        const float am = t.pc ? __uint_as_float(colmax[t.cm + t.n0 + n]) * 1.35f : tile_am; const float inv = am > 0.f ? 127.0f / am : 0.f;
        unsigned w[4];
#pragma unroll
        for (int q = 0; q < 4; ++q) { const int a0 = SAT8(__float2int_rn(s[(4 * q) * 33] * inv)), a1 = SAT8(__float2int_rn(s[(4 * q + 1) * 33] * inv)), a2 = SAT8(__float2int_rn(s[(4 * q + 2) * 33] * inv)), a3 = SAT8(__float2int_rn(s[(4 * q + 3) * 33] * inv));
            w[q] = (unsigned)(a0 & 255) | ((unsigned)(a1 & 255) << 8) | ((unsigned)(a2 & 255) << 16) | ((unsigned)a3 << 24); }
        *(GAS v4u*)((unsigned char*)t.WT + (size_t)(t.n0 + n) * t.K + t.k0 + 16 * c) = (v4u){w[0], w[1], w[2], w[3]};
        if (t.pc) { if (t.k0 == 0 && c == 0) sbc[t.n0 + n] = am * (1.0f / 127.0f); }
        else if (t.k0 == 0 && (t.n0 & 255) == 0 && lane == 0 && j == 0) sb[(t.cm + t.n0) >> 8] = am * (1.0f / 127.0f); }
    LDS_WAIT(); asm volatile("" ::: "memory");
}
#ifndef CM_STRIDE
#define CM_STRIDE 8
#endif
__device__ __forceinline__ void colmax_item(const float* W, int N, int item, int lane, unsigned* colmax) {
    const int nblk = N / 256, kb = item / nblk, nb = item % nblk;
    const float* p = W + (size_t)(64 * kb) * N + 256 * nb + 4 * lane;
    f32x4 mx = {0.f, 0.f, 0.f, 0.f};
#pragma unroll
    for (int i = 0; i < 64; i += CM_STRIDE) { const f32x4 v = *(const f32x4*)(p + (size_t)i * N); mx = __builtin_elementwise_max(mx, __builtin_elementwise_abs(v)); }
    unsigned* c = colmax + 256 * nb + 4 * lane;
    atomicMax(c, __float_as_uint(mx[0])); atomicMax(c + 1, __float_as_uint(mx[1])); atomicMax(c + 2, __float_as_uint(mx[2])); atomicMax(c + 3, __float_as_uint(mx[3]));
}
__device__ __forceinline__ void p0_ada_item(Frame& F, const float* c, const float* W, const float* bias, float* ada, int item) {
    const int n0 = item * 64, lane = F.lane, w = F.wave;
    float acc[8];
#pragma unroll
    for (int b = 0; b < 8; ++b) acc[b] = 0.f;
    float wa[16], wb[16];
    const float* Wp = W + (size_t)(256 * w) * ADA_W + n0 + lane;
#define ADA_LOAD(V, g_) do { _Pragma("unroll") for (int i = 0; i < 16; ++i) V[i] = Wp[(size_t)((g_) * 16 + i) * ADA_W]; } while (0)
#define ADA_FMA(V, gi_) do { _Pragma("unroll") for (int i = 0; i < 16; ++i) _Pragma("unroll") for (int b = 0; b < 8; ++b) { \
        const float s_ = __builtin_bit_cast(float, __builtin_amdgcn_readlane(__builtin_bit_cast(int, sc[b]), (gi_) * 16 + i)); acc[b] += s_ * V[i]; } } while (0)
    ADA_LOAD(wa, 0);
    for (int kb = 0; kb < 4; ++kb) {
        const int k0 = 256 * w + 64 * kb;
        float sc[8];
#pragma unroll
        for (int b = 0; b < 8; ++b) { const float cv = c[b * DM + k0 + lane]; sc[b] = cv * fsig(cv); }
        ADA_LOAD(wb, 4 * kb + 1); ADA_FMA(wa, 0);
        ADA_LOAD(wa, 4 * kb + 2); ADA_FMA(wb, 1);
        ADA_LOAD(wb, 4 * kb + 3); ADA_FMA(wa, 2);
        if (kb < 3) ADA_LOAD(wa, 4 * kb + 4);
        ADA_FMA(wb, 3);
    }
#undef ADA_LOAD
#undef ADA_FMA
    LAS float* red = (LAS float*)(F.lds + RING_OFF);
#pragma unroll
    for (int b = 0; b < 8; ++b) red[(w * 8 + b) * 64 + lane] = acc[b];
    __syncthreads();
    { const int b = F.tid >> 6, col = F.tid & 63; float s = 0.f;
#pragma unroll
      for (int ww = 0; ww < 8; ++ww) s += red[(ww * 8 + b) * 64 + col];
      ada[b * ADA_W + n0 + col] = s + bias[n0 + col]; }
    __syncthreads();
}
#ifndef I8_Q
#define I8_Q 1
#endif
#ifndef I8_AB
#define I8_AB 1
#endif
#ifndef I8_O
#define I8_O 1
#endif
template <int PART> __device__ __forceinline__ void p0_prologue(Frame& F, const float* c, const int* positions, const float* w_ada, const float* b_ada,
                                            const float* w_in, const float* w_ba, const float* w_bh, const float* w_out, const float* w_q) {
    float* ada = (float*)(F.ws + WS_ADA);
    unsigned* colmax = (unsigned*)(F.ws + WS_COLMAX); float* sb = (float*)(F.ws + WS_SB);
    const int gw = F.vcu * NWAVES + F.wave, NGW = F.G * NWAVES, lane = F.lane;
    if (PART == 0) {
        constexpr int C_IN = (DM / 64) * (IN_W / 256), C_Q = I8_Q ? (DM / 64) * (DM / 256) : 0, C_A = I8_AB ? (1024 / 64) * (DM / 256) : 0, C_O = I8_O ? (DM / 64) * (DM / 256) : 0;
        for (int it = gw; it < C_IN + C_Q + 2 * C_A + C_O; it += NGW) { int r = it;
            if (r < C_IN) { colmax_item(w_in, IN_W, r, lane, colmax + CM_IN); continue; } r -= C_IN;
            if (r < C_Q) { colmax_item(w_q, DM, r, lane, colmax + CM_Q); continue; } r -= C_Q;
            if (r < C_A) { colmax_item(w_ba, DM, r, lane, colmax + CM_A); continue; } r -= C_A;
            if (r < C_A) { colmax_item(w_bh, DM, r, lane, colmax + CM_B); continue; } r -= C_A;
            colmax_item(w_out, DM, r, lane, colmax + CM_O); }
        for (int it = F.vcu; it < ADA_W / 64; it += F.G) p0_ada_item(F, c, w_ada, b_ada, ada, it);
    }
    LAS float* scr = (LAS float*)(F.lds + RING_OFF + 16384 + F.wave * 12288);
    constexpr int I_IN = (DM / 64) * (IN_W / 32), I_B = (1024 / 64) * (DM / 32), I_O = (DM / 64) * (DM / 32);
    constexpr int I_BF = 2 * I_B + 2 * I_O, NITEMS = I_BF + I_IN;
    constexpr int N_EARLY_OK = (I8_AB ? 0 : 2 * I_B) + ((I8_AB || I8_O) ? 0 : I_O);
    constexpr int TR_EARLY = N_EARLY_OK < 64 * NWAVES * 4 ? N_EARLY_OK : 64 * NWAVES * 4;
    auto mk = [&](int it) { TrItem t; int r = it;
        if (r < I_B) { t.W = w_ba; t.WT = (bf16*)(F.ws + WS_WA); t.K = 1024; t.N = DM; t.cm = I8_AB ? CM_A : -1; t.pc = 0; }
        else if ((r -= I_B) < I_B) { t.W = w_bh; t.WT = (bf16*)(F.ws + WS_WB); t.K = 1024; t.N = DM; t.cm = I8_AB ? CM_B : -1; t.pc = 0; }
        else if ((r -= I_B) < I_O) { t.W = w_out; t.WT = (bf16*)(F.ws + WS_WOUT); t.K = DM; t.N = DM; t.cm = I8_O ? CM_O : -1; t.pc = 0; }
        else if ((r -= I_O) < I_O) { t.W = w_q; t.WT = (bf16*)(F.ws + WS_WQ); t.K = DM; t.N = DM; t.cm = I8_Q ? CM_Q : -1; t.pc = 1; }
        else { r -= I_O; t.W = w_in; t.WT = (bf16*)(F.ws + WS_WIN); t.K = DM; t.N = IN_W; t.cm = CM_IN; t.pc = 0; }
        const int nblk = t.N / 32; t.k0 = 64 * (r / nblk); t.n0 = 32 * (r % nblk); return t; };
    float ra[32], rb[32];
    int it, step, end;
    if (PART == 0) { if (F.vcu < ADA_W / 64) return; it = (F.vcu - ADA_W / 64) * NWAVES + F.wave; step = (F.G - ADA_W / 64) * NWAVES; end = TR_EARLY; }
    else { it = TR_EARLY + gw; step = NGW; end = NITEMS; }
#define TR_PROC(T_, R_, IT_) do { if ((T_).cm >= 0) tr_proc_i8(T_, R_, scr, lane, colmax, sb, (float*)(F.ws + WS_SBC)); else tr_proc(T_, R_, scr, lane); } while (0)
    if (it < end) { const TrItem t = mk(it); tr_load(t, ra, lane); }
    for (; it < end; it += 2 * step) {
        const TrItem ta = mk(it);
        if (it + step < end) { const TrItem tb = mk(it + step); tr_load(tb, rb, lane); }
        TR_PROC(ta, ra, it);
        if (it + step < end) { const TrItem tb = mk(it + step);
            if (it + 2 * step < end) { const TrItem tc = mk(it + 2 * step); tr_load(tc, ra, lane); }
            TR_PROC(tb, rb, it + step); }
    }
#undef TR_PROC
}

__device__ __forceinline__ void mod_rows(Frame& F, const float* X, const float* g, const float* shift, const float* scale, bf16* O) {
    const int gw = F.vcu * NWAVES + F.wave, NGW = F.G * NWAVES, lane = F.lane;
    f32x4 va[8], vb[8];
#define MR_LOAD(V, m_) do { const GAS f32x4* xr_ = (const GAS f32x4*)(X + (size_t)(m_) * DM) + lane; _Pragma("unroll") for (int j = 0; j < 8; ++j) V[j] = xr_[64 * j]; } while (0)
#define MR_PROC(V, m_) do { const int b_ = (m_) / SEQ; float s_ = 0.f; \
        _Pragma("unroll") for (int j = 0; j < 8; ++j) s_ += (V[j].x * V[j].x + V[j].y * V[j].y) + (V[j].z * V[j].z + V[j].w * V[j].w); \
        const float rstd_ = __builtin_amdgcn_rsqf(wave_sum(s_) * (1.0f / DM) + EPS); \
        GAS unsigned long long* o8_ = (GAS unsigned long long*)(O + (size_t)(m_) * DM) + lane; \
        _Pragma("unroll") for (int j = 0; j < 8; ++j) { const int col_ = (64 * j + lane) * 4; \
            const f32x4 gg_ = *(const f32x4*)(g + col_), sc_ = *(const f32x4*)(scale + (size_t)b_ * ADA_W + col_), sh_ = *(const f32x4*)(shift + (size_t)b_ * ADA_W + col_); \
            const f32x4 h_ = V[j] * rstd_ * gg_ * (sc_ + 1.0f) + sh_; \
            o8_[64 * j] = (unsigned long long)cvtpk(h_.x, h_.y) | ((unsigned long long)cvtpk(h_.z, h_.w) << 32); } } while (0)
    int m = gw;
    if (m < T) MR_LOAD(va, m);
    for (; m < T; m += 2 * NGW) {
        if (m + NGW < T) MR_LOAD(vb, m + NGW);
        MR_PROC(va, m);
        if (m + NGW < T) { if (m + 2 * NGW < T) MR_LOAD(va, m + 2 * NGW); MR_PROC(vb, m + NGW); }
    }
#undef MR_LOAD
#undef MR_PROC
}

template <int QMAX = 127> __device__ __forceinline__ void mod_rows_i8(Frame& F, const float* X, const float* g, const float* shift, const float* scale, unsigned char* O, float* sa) {
    const int gw = F.vcu * NWAVES + F.wave, NGW = F.G * NWAVES, lane = F.lane;
    f32x4 va[8], vb[8];
#define MR_LOAD(V, m_) do { const GAS f32x4* xr_ = (const GAS f32x4*)(X + (size_t)(m_) * DM) + lane; _Pragma("unroll") for (int j = 0; j < 8; ++j) V[j] = xr_[64 * j]; } while (0)
#define MR_PROC(V, m_) do { const int b_ = (m_) / SEQ; float s_ = 0.f; \
        _Pragma("unroll") for (int j = 0; j < 8; ++j) s_ += (V[j].x * V[j].x + V[j].y * V[j].y) + (V[j].z * V[j].z + V[j].w * V[j].w); \
        const float rstd_ = __builtin_amdgcn_rsqf(wave_sum(s_) * (1.0f / DM) + EPS); float am_ = 0.f; \
        _Pragma("unroll") for (int j = 0; j < 8; ++j) { const int col_ = (64 * j + lane) * 4; \
            const f32x4 gg_ = *(const f32x4*)(g + col_), sc_ = *(const f32x4*)(scale + (size_t)b_ * ADA_W + col_), sh_ = *(const f32x4*)(shift + (size_t)b_ * ADA_W + col_); \
            V[j] = V[j] * rstd_ * gg_ * (sc_ + 1.0f) + sh_; \
            am_ = fmaxf(am_, fmaxf(fmaxf(__builtin_fabsf(V[j].x), __builtin_fabsf(V[j].y)), fmaxf(__builtin_fabsf(V[j].z), __builtin_fabsf(V[j].w)))); } \
        _Pragma("unroll") for (int o = 1; o < 64; o <<= 1) am_ = fmaxf(am_, __shfl_xor(am_, o)); \
        const float inv_ = am_ > 0.f ? (float)QMAX / am_ : 0.f; \
        GAS unsigned* o4_ = (GAS unsigned*)(O + (size_t)(m_) * DM) + lane; \
        _Pragma("unroll") for (int j = 0; j < 8; ++j) { const int a0 = __float2int_rn(V[j].x * inv_), a1 = __float2int_rn(V[j].y * inv_), a2 = __float2int_rn(V[j].z * inv_), a3 = __float2int_rn(V[j].w * inv_); \
            o4_[64 * j] = (unsigned)(a0 & 255) | ((unsigned)(a1 & 255) << 8) | ((unsigned)(a2 & 255) << 16) | ((unsigned)a3 << 24); } \
        if (lane == 0) sa[m_] = am_ * (1.0f / (float)QMAX); } while (0)
    int m = gw;
    if (m < T) MR_LOAD(va, m);
    for (; m < T; m += 2 * NGW) {
        if (m + NGW < T) MR_LOAD(vb, m + NGW);
        MR_PROC(va, m);
        if (m + NGW < T) { if (m + 2 * NGW < T) MR_LOAD(va, m + 2 * NGW); MR_PROC(vb, m + NGW); }
    }
#undef MR_LOAD
#undef MR_PROC
}

__device__ __forceinline__ void quant_rows_bf16(Frame& F, const bf16* X, unsigned char* O, float* sa) {
    const int gw = F.vcu * NWAVES + F.wave, NGW = F.G * NWAVES, lane = F.lane;
    v4u va[4], vb[4];
#define QR_LOAD(V, m_) do { _Pragma("unroll") for (int j = 0; j < 4; ++j) V[j] = *(const v4u*)(X + (size_t)(m_) * DM + (j * 64 + lane) * 8); } while (0)
#define QR_PROC(V, m_) do { float f_[32]; float am_ = 0.f; \
        _Pragma("unroll") for (int j = 0; j < 4; ++j) { const unsigned w_[4] = {V[j].x, V[j].y, V[j].z, V[j].w}; \
            _Pragma("unroll") for (int q = 0; q < 4; ++q) { f_[8 * j + 2 * q] = bf_lo(w_[q]); f_[8 * j + 2 * q + 1] = bf_hi(w_[q]); am_ = fmaxf(am_, fmaxf(__builtin_fabsf(f_[8 * j + 2 * q]), __builtin_fabsf(f_[8 * j + 2 * q + 1]))); } } \
        _Pragma("unroll") for (int o = 1; o < 64; o <<= 1) am_ = fmaxf(am_, __shfl_xor(am_, o)); \
        const float inv_ = am_ > 0.f ? 127.0f / am_ : 0.f; \
        _Pragma("unroll") for (int j = 0; j < 4; ++j) { unsigned o_[2]; \
            _Pragma("unroll") for (int h = 0; h < 2; ++h) { const int a0 = __float2int_rn(f_[8 * j + 4 * h] * inv_), a1 = __float2int_rn(f_[8 * j + 4 * h + 1] * inv_), a2 = __float2int_rn(f_[8 * j + 4 * h + 2] * inv_), a3 = __float2int_rn(f_[8 * j + 4 * h + 3] * inv_); \
                o_[h] = (unsigned)(a0 & 255) | ((unsigned)(a1 & 255) << 8) | ((unsigned)(a2 & 255) << 16) | ((unsigned)a3 << 24); } \
            *(unsigned long long*)(O + (size_t)(m_) * DM + (j * 64 + lane) * 8) = (unsigned long long)o_[0] | ((unsigned long long)o_[1] << 32); } \
        if (lane == 0) sa[m_] = am_ * (1.0f / 127.0f); } while (0)
    int m = gw;
    if (m < T) QR_LOAD(va, m);
    for (; m < T; m += 2 * NGW) {
        if (m + NGW < T) QR_LOAD(vb, m + NGW);
        QR_PROC(va, m);
        if (m + NGW < T) { if (m + 2 * NGW < T) QR_LOAD(va, m + 2 * NGW); QR_PROC(vb, m + NGW); }
    }
#undef QR_LOAD
#undef QR_PROC
}

namespace hg {
constexpr int LQ = 272, LV = 144;
constexpr int O_QI = 0, O_KI = 17408, O_QB = 34816, O_KDT = 52224, O_VT = 70656, O_AM = 79872, O_ST = 89088, O_PART = 106496, O_A = 110592, O_END = 111104;
typedef short bf16x8 __attribute__((ext_vector_type(8)));
typedef float f32x4 __attribute__((ext_vector_type(4)));
__device__ __forceinline__ bf16x8 ldfrag(const LAS unsigned char* p) { return *(const LAS bf16x8*)p; }
}
__device__ __forceinline__ void hgrn_item(Frame& F, int item, const float* lb_fwd, const float* lb_bwd) {
    using namespace hg;
    const int b = item >> 5, h = (item >> 2) & 7, dir = (item >> 1) & 1, vh = item & 1;
    LAS unsigned char* L = F.lds + RING_OFF;
    const int tid = F.tid, lane = F.lane, w = F.wave;
    const int d0 = 2 * lane;
    float lb[2];
    { const float* tbl = dir ? lb_bwd : lb_fwd;
#pragma unroll
      for (int i = 0; i < 2; ++i) { const float t0 = tbl[h * 128 + d0 + i], t1 = tbl[1024 + h * 128 + d0 + i]; lb[i] = 1.0f / (1.0f + __expf(t0 - t1)); } }
    f32x4 st[4];
#pragma unroll
    for (int i = 0; i < 4; ++i) st[i] = (f32x4){0.f, 0.f, 0.f, 0.f};
    for (int i = tid; i < 17408 / 4; i += 512) ((LAS unsigned*)(L + O_ST))[i] = 0u;
    const size_t rowbase = (size_t)b * SEQ;
    const bf16* Qg = (const bf16*)(F.ws + WS_HGQ) + rowbase * 1024 + h * 128 + d0;
    const bf16* Fg = (const bf16*)(F.ws + (dir ? WS_HFB : WS_HFF)) + rowbase * 1024 + h * 128 + d0;
    const int vp = tid & 31, pg = (tid >> 5) & 7;
    const bf16* Vg = (const bf16*)(F.ws + WS_HGI) + rowbase * 1024 + h * 128 + vh * 64 + 2 * vp;
    bf16* Og = (bf16*)(F.ws + (dir ? WS_OBW : WS_OF)) + rowbase * 1024 + h * 128 + vh * 64;
    unsigned qrawA[8], frawA[8], vrawA[8], qrawB[8], frawB[8], vrawB[8];
#define HG_LOAD(QR, FR, VR, ch) do { const size_t t0_ = (size_t)(ch) * 64; \
        _Pragma("unroll") for (int p = 0; p < 8; ++p) { QR[p] = *(const unsigned*)(Qg + (t0_ + 8 * w + p) * 1024); FR[p] = *(const unsigned*)(Fg + (t0_ + 8 * w + p) * 1024); } \
        if (tid < 256) { _Pragma("unroll") for (int p = 0; p < 8; ++p) VR[p] = *(const unsigned*)(Vg + (t0_ + 8 * pg + p) * 1024); } } while (0)
    HG_LOAD(qrawA, frawA, vrawA, dir ? 31 : 0);
    HG_LOAD(qrawB, frawB, vrawB, dir ? 30 : 1);
    __syncthreads();
    const int tb = w >> 1, hf = w & 1, l15 = lane & 15, l4 = lane >> 4;
    auto step = [&](const int c, unsigned (&qraw)[8], unsigned (&fraw)[8], unsigned (&vraw)[8]) __attribute__((always_inline)) {
        const int ch = dir ? 31 - c : c;
        float lf[8][2], kk[8][2], qq[8][2];
#pragma unroll
        for (int p = 0; p < 8; ++p) {
#pragma unroll
            for (int i = 0; i < 2; ++i) { const float x = i ? bf_hi(fraw[p]) : bf_lo(fraw[p]); const float sg = __builtin_amdgcn_rcpf(1.0f + __builtin_amdgcn_exp2f(x * -1.4426950408889634f)); const float f = lb[i] + (1.0f - lb[i]) * sg;
                lf[p][i] = __builtin_amdgcn_logf(f);     kk[p][i] = 1.0f - f; qq[p][i] = i ? bf_hi(qraw[p]) : bf_lo(qraw[p]); } }
        float bl[8][2], tot[2];
#pragma unroll
        for (int i = 0; i < 2; ++i) { float run = 0.f;
            if (!dir) {
#pragma unroll
                for (int p = 0; p < 8; ++p) { run += lf[p][i]; bl[p][i] = run; }
            } else {
#pragma unroll
                for (int p = 7; p >= 0; --p) { run += lf[p][i]; bl[p][i] = run; }
            }
            tot[i] = run; }
        { LAS float* part = (LAS float*)(L + O_PART); *(LAS f32x2v*)(part + w * 128 + d0) = (f32x2v){tot[0], tot[1]}; }
        __syncthreads();
        float offs[2] = {0.f, 0.f}, rr[2] = {0.f, 0.f}, bt[2] = {0.f, 0.f};
        { const LAS float* part = (const LAS float*)(L + O_PART);
#pragma unroll
          for (int w2 = 0; w2 < 8; ++w2) { const f32x2v pv = *(const LAS f32x2v*)(part + w2 * 128 + d0);
              const bool before = dir ? (w2 > w) : (w2 < w); const bool inr = dir ? (w2 >= 4) : (w2 < 4);
#pragma unroll
              for (int i = 0; i < 2; ++i) { bt[i] += pv[i]; offs[i] += before ? pv[i] : 0.f; rr[i] += inr ? pv[i] : 0.f; } } }
        float er[2], el[2];
#pragma unroll
        for (int i = 0; i < 2; ++i) { er[i] = __builtin_amdgcn_exp2f(rr[i]); el[i] = __builtin_amdgcn_exp2f(bt[i] - rr[i]); }
        if (w == 0) { LAS float* aa = (LAS float*)(L + O_A); *(LAS f32x2v*)(aa + d0) = (f32x2v){__builtin_amdgcn_exp2f(bt[0]), __builtin_amdgcn_exp2f(bt[1])}; }
        unsigned kdp[2][4];
#pragma unroll
        for (int p = 0; p < 8; ++p) {
            float qi[2], ki[2], qb[2], kd[2];
#pragma unroll
            for (int i = 0; i < 2; ++i) { const float bb = bl[p][i] + offs[i]; const float e1 = __builtin_amdgcn_exp2f(bb - rr[i]), e2 = __builtin_amdgcn_exp2f(rr[i] - bb);
                qi[i] = qq[p][i] * e1; ki[i] = kk[p][i] * e2; qb[i] = qi[i] * er[i]; kd[i] = ki[i] * el[i]; }
            const int pos = 8 * w + p;
            *(LAS unsigned*)(L + O_QI + pos * LQ + d0 * 2) = cvtpk(qi[0], qi[1]);
            *(LAS unsigned*)(L + O_KI + pos * LQ + d0 * 2) = cvtpk(ki[0], ki[1]);
            *(LAS unsigned*)(L + O_QB + pos * LQ + d0 * 2) = cvtpk(qb[0], qb[1]);
            if (p & 1) { kdp[0][p >> 1] = (kdp[0][p >> 1] & 0xffffu) | (cvtpk(0.f, kd[0]) & 0xffff0000u); kdp[1][p >> 1] = (kdp[1][p >> 1] & 0xffffu) | (cvtpk(0.f, kd[1]) & 0xffff0000u); }
            else { kdp[0][p >> 1] = cvtpk(kd[0], 0.f) & 0xffffu; kdp[1][p >> 1] = cvtpk(kd[1], 0.f) & 0xffffu; }
        }
#pragma unroll
        for (int i = 0; i < 2; ++i) *(LAS v4u*)(L + O_KDT + (d0 + i) * LV + (8 * w) * 2) = (v4u){kdp[i][0], kdp[i][1], kdp[i][2], kdp[i][3]};
        if (tid < 256) {
            unsigned v0[4], v1[4];
#pragma unroll
            for (int p = 0; p < 8; p += 2) { v0[p >> 1] = (vraw[p] & 0xffffu) | (vraw[p + 1] << 16); v1[p >> 1] = (vraw[p] >> 16) | (vraw[p + 1] & 0xffff0000u); }
            *(LAS v4u*)(L + O_VT + (2 * vp) * LV + (8 * pg) * 2) = (v4u){v0[0], v0[1], v0[2], v0[3]};
            *(LAS v4u*)(L + O_VT + (2 * vp + 1) * LV + (8 * pg) * 2) = (v4u){v1[0], v1[1], v1[2], v1[3]};
        }
        if (c + 2 < 32) HG_LOAD(qraw, fraw, vraw, dir ? 29 - c : c + 2);
        __syncthreads();
        f32x4 ao[2], au[4];
#pragma unroll
        for (int sbi = 0; sbi < 2; ++sbi) {
            const int sb = 2 * hf + sbi; f32x4 a = (f32x4){0.f, 0.f, 0.f, 0.f};
#pragma unroll
            for (int ks = 0; ks < 4; ++ks) a = __builtin_amdgcn_mfma_f32_16x16x32_bf16(ldfrag(L + O_KI + (16 * sb + l15) * LQ + ks * 64 + l4 * 16), ldfrag(L + O_QI + (16 * tb + l15) * LQ + ks * 64 + l4 * 16), a, 0, 0, 0);
            const int tt = 16 * tb + l15, s0 = 16 * sb + 4 * l4;
            float m[4];
#pragma unroll
            for (int r = 0; r < 4; ++r) { const int ss = s0 + r; const bool keep = dir ? (ss >= tt) : (ss <= tt); m[r] = keep ? a[r] : 0.f; }
            *(LAS unsigned long long*)(L + O_AM + tt * LV + s0 * 2) = (unsigned long long)cvtpk(m[0], m[1]) | ((unsigned long long)cvtpk(m[2], m[3]) << 32);
        }
#pragma unroll
        for (int vbi = 0; vbi < 2; ++vbi) {
            const int vb = 2 * hf + vbi; f32x4 a = (f32x4){0.f, 0.f, 0.f, 0.f};
#pragma unroll
            for (int ks = 0; ks < 4; ++ks) a = __builtin_amdgcn_mfma_f32_16x16x32_bf16(ldfrag(L + O_ST + (16 * vb + l15) * LQ + ks * 64 + l4 * 16), ldfrag(L + O_QB + (16 * tb + l15) * LQ + ks * 64 + l4 * 16), a, 0, 0, 0);
            ao[vbi] = a;
        }
#pragma unroll
        for (int vb = 0; vb < 4; ++vb) {
            f32x4 a = (f32x4){0.f, 0.f, 0.f, 0.f};
#pragma unroll
            for (int ks = 0; ks < 2; ++ks) a = __builtin_amdgcn_mfma_f32_16x16x32_bf16(ldfrag(L + O_KDT + (16 * w + l15) * LV + ks * 64 + l4 * 16), ldfrag(L + O_VT + (16 * vb + l15) * LV + ks * 64 + l4 * 16), a, 0, 0, 0);
            au[vb] = a;
        }
        __syncthreads();
#pragma unroll
        for (int vbi = 0; vbi < 2; ++vbi) {
            const int vb = 2 * hf + vbi; f32x4 a = ao[vbi];
#pragma unroll
            for (int ks = 0; ks < 2; ++ks) a = __builtin_amdgcn_mfma_f32_16x16x32_bf16(ldfrag(L + O_VT + (16 * vb + l15) * LV + ks * 64 + l4 * 16), ldfrag(L + O_AM + (16 * tb + l15) * LV + ks * 64 + l4 * 16), a, 0, 0, 0);
            *(unsigned long long*)(Og + ((size_t)ch * 64 + 16 * tb + l15) * 1024 + 16 * vb + 4 * l4) = (unsigned long long)cvtpk(a[0], a[1]) | ((unsigned long long)cvtpk(a[2], a[3]) << 32);
        }
        { const f32x4 av = *(const LAS f32x4*)(L + O_A + (16 * w + 4 * l4) * 4);
#pragma unroll
          for (int vb = 0; vb < 4; ++vb) { st[vb] = av * st[vb] + au[vb];
              *(LAS unsigned long long*)(L + O_ST + (16 * vb + l15) * LQ + (16 * w + 4 * l4) * 2) = (unsigned long long)cvtpk(st[vb][0], st[vb][1]) | ((unsigned long long)cvtpk(st[vb][2], st[vb][3]) << 32); } }
    };
#pragma unroll 1
    for (int c = 0; c < 32; c += 2) { step(c, qrawA, frawA, vrawA); step(c + 1, qrawB, frawB, vrawB); }
    __syncthreads();
#undef HG_LOAD
}


namespace at {
typedef short bf16x8 __attribute__((ext_vector_type(8)));
constexpr int SHM_V = 16384, SHM_K = 8192, O_V = 0, O_K = 32768, O_WS = 49152, LDK = 1024;
#define AT_SBAR() __builtin_amdgcn_sched_barrier(0)
#define KSWZ64(row, ch) ((row) * 128 + ((((ch) ^ (((row) >> 1) & 7))) << 4))
__device__ __forceinline__ int crow(int r, int hi) { return (r & 3) + 8 * (r >> 2) + 4 * hi; }
__device__ __forceinline__ void partialSM(f32x16& p0, f32x16& p1, float& m_reg, float& mn, float& alpha) {
  float pmax = p0[0];
#pragma unroll
  for (int r = 1; r < 16; ++r) pmax = fmaxf(pmax, p0[r]);
#pragma unroll
  for (int r = 0; r < 16; ++r) pmax = fmaxf(pmax, p1[r]);
  { auto rr = __builtin_amdgcn_permlane32_swap(__float_as_uint(pmax), __float_as_uint(pmax), false, false);
    pmax = fmaxf(__uint_as_float(rr[0]), __uint_as_float(rr[1])); }
  if (__builtin_expect(__all(pmax - m_reg <= THRL), 1)) { mn = m_reg; alpha = 1.f; }
  else { mn = fmaxf(m_reg, pmax); alpha = __builtin_amdgcn_exp2f(m_reg - mn); m_reg = mn; }
#pragma unroll
  for (int r = 0; r < 16; ++r) p0[r] = p0[r] - mn;
#pragma unroll
  for (int r = 0; r < 16; ++r) p1[r] = p1[r] - mn;
#pragma unroll
  for (int r = 0; r < 16; ++r) p0[r] = __builtin_amdgcn_exp2f(p0[r]);
}
__device__ __forceinline__ void partialSM_rel(f32x16& p0, f32x16& p1, float& m_reg, float& alpha) {
  float pmax = p0[0];
#pragma unroll
  for (int r = 1; r < 16; ++r) pmax = fmaxf(pmax, p0[r]);
#pragma unroll
  for (int r = 0; r < 16; ++r) pmax = fmaxf(pmax, p1[r]);
  { auto rr = __builtin_amdgcn_permlane32_swap(__float_as_uint(pmax), __float_as_uint(pmax), false, false);
    pmax = fmaxf(__uint_as_float(rr[0]), __uint_as_float(rr[1])); }
  if (__builtin_expect(__all(pmax <= THRL), 1)) { alpha = 1.f; }
  else { const float d = fmaxf(pmax, 0.f); alpha = __builtin_amdgcn_exp2f(-d); m_reg += d;
#pragma unroll
    for (int r = 0; r < 16; ++r) { p0[r] -= d; p1[r] -= d; } }
#pragma unroll
  for (int r = 0; r < 16; ++r) p0[r] = __builtin_amdgcn_exp2f(p0[r]);
}
__device__ __forceinline__ void finishSM(f32x16& p0, f32x16& p1, float alpha, float& l_reg, bf16x8& pa0, bf16x8& pa1, bf16x8& pa2, bf16x8& pa3) {
#pragma unroll
  for (int r = 0; r < 16; ++r) p1[r] = __builtin_amdgcn_exp2f(p1[r]);
  float ps = 0;
#pragma unroll
  for (int r = 0; r < 16; ++r) ps += p0[r];
#pragma unroll
  for (int r = 0; r < 16; ++r) ps += p1[r];
  { auto rr = __builtin_amdgcn_permlane32_swap(__float_as_uint(ps), __float_as_uint(ps), false, false);
    ps = __uint_as_float(rr[0]) + __uint_as_float(rr[1]); }
  l_reg = l_reg * alpha + ps;
#define AT_PK4(P, BASE, OUT) do { unsigned a0 = cvtpk(P[BASE + 0], P[BASE + 1]), a1 = cvtpk(P[BASE + 2], P[BASE + 3]);   \
    unsigned b0 = cvtpk(P[BASE + 4], P[BASE + 5]), b1 = cvtpk(P[BASE + 6], P[BASE + 7]);                              \
    auto r0 = __builtin_amdgcn_permlane32_swap(a0, b0, false, false); auto r1 = __builtin_amdgcn_permlane32_swap(a1, b1, false, false); \
    v4u w_ = {r0[0], r1[0], r0[1], r1[1]}; OUT = __builtin_bit_cast(bf16x8, w_); } while (0)
  AT_PK4(p0, 0, pa0); AT_PK4(p0, 8, pa1); AT_PK4(p1, 0, pa2); AT_PK4(p1, 8, pa3);
#undef AT_PK4
}
__device__ __forceinline__ void qkt(f32x16& p0, f32x16& p1, const char* Ks, const bf16x8* qr, int r32, int hi, const float init = 0.f) {
#pragma unroll
  for (int r = 0; r < 16; ++r) { p0[r] = init; p1[r] = init; }
#pragma unroll
  for (int d0 = 0; d0 < 4; ++d0) { const int ch = d0 * 2 + hi;
    bf16x8 b0 = *reinterpret_cast<const bf16x8*>(Ks + KSWZ64(r32, ch));
    bf16x8 b1 = *reinterpret_cast<const bf16x8*>(Ks + 4096 + KSWZ64(r32, ch));
    p0 = __builtin_amdgcn_mfma_f32_32x32x16_bf16(b0, qr[d0], p0, 0, 0, 0);
    p1 = __builtin_amdgcn_mfma_f32_32x32x16_bf16(b1, qr[d0], p1, 0, 0, 0); }
}
__device__ __forceinline__ int v_st(int k, int c) { const int kk = (k & ~0xC) | ((k & 4) << 1) | ((k & 8) >> 1); return ((kk >> 3) * 4 + (c >> 5)) * 512 + ((kk & 7) * 32 + (c & 31)) * 2; }
__device__ __forceinline__ int v_rd_base(int lane) { return ((lane & 3) << 3) | (((lane >> 2) & 3) << 6) | (((lane >> 4) & 1) << 5) | (((lane >> 5) & 1) << 8); }
constexpr int v_rd_off(int d0, int ks, int half) { return d0 * 512 + ks * 4096 + half * 2048; }
template <int OFF> __device__ __forceinline__ s16x4 tr_read(int vb) {
  s16x4 r; asm volatile("ds_read_b64_tr_b16 %0, %1 offset:%2" : "=&v"(r) : "v"(vb), "i"(OFF) : "memory"); return r;
}
template <int D0> __device__ __forceinline__ void pv_one(f32x16& od, int vb, bf16x8 pa0, bf16x8 pa1, bf16x8 pa2, bf16x8 pa3) {
  const s16x4 l0 = tr_read<v_rd_off(D0, 0, 0)>(vb), h0 = tr_read<v_rd_off(D0, 0, 1)>(vb), l1 = tr_read<v_rd_off(D0, 1, 0)>(vb), h1 = tr_read<v_rd_off(D0, 1, 1)>(vb);
  const s16x4 l2 = tr_read<v_rd_off(D0, 2, 0)>(vb), h2 = tr_read<v_rd_off(D0, 2, 1)>(vb), l3 = tr_read<v_rd_off(D0, 3, 0)>(vb), h3 = tr_read<v_rd_off(D0, 3, 1)>(vb);
  asm volatile("s_waitcnt lgkmcnt(0)" ::: "memory"); AT_SBAR();
#define AT_PK(L, H) (bf16x8){L[0], L[1], L[2], L[3], H[0], H[1], H[2], H[3]}
  od = __builtin_amdgcn_mfma_f32_32x32x16_bf16(pa0, AT_PK(l0, h0), od, 0, 0, 0);
  od = __builtin_amdgcn_mfma_f32_32x32x16_bf16(pa1, AT_PK(l1, h1), od, 0, 0, 0);
  od = __builtin_amdgcn_mfma_f32_32x32x16_bf16(pa2, AT_PK(l2, h2), od, 0, 0, 0);
  od = __builtin_amdgcn_mfma_f32_32x32x16_bf16(pa3, AT_PK(l3, h3), od, 0, 0, 0);
#undef AT_PK
}
__device__ __forceinline__ void pv_d0(f32x16* o, int vb, bf16x8 pa0, bf16x8 pa1, bf16x8 pa2, bf16x8 pa3) {
  pv_one<0>(o[0], vb, pa0, pa1, pa2, pa3); pv_one<1>(o[1], vb, pa0, pa1, pa2, pa3); pv_one<2>(o[2], vb, pa0, pa1, pa2, pa3); pv_one<3>(o[3], vb, pa0, pa1, pa2, pa3);
}
__device__ __forceinline__ void attn_pass(const bf16* __restrict__ Qw, const bf16* __restrict__ Kh, const bf16* __restrict__ Vh, int seq, char* lds, f32x16 (&o)[4]) {
  int tid_ = threadIdx.x; asm volatile("" : "+v"(tid_));
  const int tid = tid_, wid = tid >> 6, lane = tid & 63, r32 = lane & 31, hi = lane >> 5;
  char* V_lds = lds + O_V; char* K_lds = lds + O_K;
  float* ws = (float*)(lds + O_WS) + wid * 64; float* li_l = ws; float* al_l = ws + 32;
  float m_reg = -1e30f, l_reg = 0; bf16x8 qr[4];
#pragma unroll
  for (int d = 0; d < 4; ++d) o[d] = f32x16{};
  const bf16* Ql = Qw + (long)r32 * LDK + hi * 8;
#pragma unroll
  for (int d0 = 0; d0 < 4; ++d0) qr[d0] = *reinterpret_cast<const bf16x8*>(Ql + d0 * 16);
  const int sr = tid >> 4, sc = (tid & 15) * 8, vst0 = v_st(sr, sc), vst1 = v_st(32 + sr, sc);
  const int kr = tid >> 3, kc = tid & 7, kst = KSWZ64(kr, kc);
  const int vb0 = (int)(uintptr_t)V_lds + v_rd_base(lane);
  struct { bf16x8 vs0, vs1, ks0; } sr_[2];
#define AT_SLOAD(i, k0) do { sr_[i].vs0 = *reinterpret_cast<const bf16x8*>(&Vh[(long)((k0) + sr) * LDK + sc]); sr_[i].vs1 = *reinterpret_cast<const bf16x8*>(&Vh[(long)((k0) + 32 + sr) * LDK + sc]); \
    sr_[i].ks0 = *reinterpret_cast<const bf16x8*>(&Kh[(long)((k0) + kr) * LDK + kc * 8]); } while (0)
#define AT_SWRITE(b, i) do { *(bf16x8*)(V_lds + (b) * SHM_V + vst0) = sr_[i].vs0; *(bf16x8*)(V_lds + (b) * SHM_V + vst1) = sr_[i].vs1; \
    *(bf16x8*)(K_lds + (b) * SHM_K + kst) = sr_[i].ks0; } while (0)
#define AT_SWAIT() asm volatile("s_waitcnt vmcnt(3)" ::: "memory")
#define AT_RESC(a) do { if (__any((a) < 1.f)) { if (hi == 0) al_l[r32] = (a); asm volatile("s_waitcnt lgkmcnt(0)" ::: "memory"); \
    _Pragma("unroll") for (int d = 0; d < 4; ++d) _Pragma("unroll") for (int r = 0; r < 16; ++r) o[d][r] *= al_l[crow(r, hi)]; } } while (0)
  f32x16 pA0, pA1, pB0, pB1; float mnA, mnB, alA, alB; bf16x8 pa0, pa1, pa2, pa3; const int NT = seq / 64;
  constexpr int SE = 0, SO = 1;
  AT_SLOAD(SE, 0); asm volatile("s_waitcnt vmcnt(0)" ::: "memory"); AT_SWRITE(0, SE); __syncthreads();
  qkt(pA0, pA1, K_lds, qr, r32, hi); partialSM(pA0, pA1, m_reg, mnA, alA);
  AT_SLOAD(SO, 64); if (2 < NT) AT_SLOAD(SE, 128);
  AT_SWAIT(); AT_SWRITE(1, SO); __syncthreads();
#ifdef AT_PRIO
  if (__builtin_amdgcn_readfirstlane(tid) >= 256) __builtin_amdgcn_s_setprio(1);
#endif
  for (int j = 1; j + 1 < NT; j += 2) {
    AT_SBAR(); qkt(pB0, pB1, K_lds + SHM_K, qr, r32, hi, -m_reg);
    finishSM(pA0, pA1, alA, l_reg, pa0, pa1, pa2, pa3); AT_SBAR();
    AT_SLOAD(SO, (j + 2) * 64); AT_SBAR();
    pv_d0(o, vb0, pa0, pa1, pa2, pa3); partialSM_rel(pB0, pB1, m_reg, alB);
    __syncthreads(); AT_SWAIT(); AT_SWRITE(0, SE);
    AT_RESC(alB); __syncthreads();
    AT_SBAR(); qkt(pA0, pA1, K_lds, qr, r32, hi, -m_reg);
    finishSM(pB0, pB1, alB, l_reg, pa0, pa1, pa2, pa3); AT_SBAR();
    if (j + 3 < NT) AT_SLOAD(SE, (j + 3) * 64); AT_SBAR();
    pv_d0(o, vb0 + SHM_V, pa0, pa1, pa2, pa3); partialSM_rel(pA0, pA1, m_reg, alA);
    __syncthreads(); AT_SWAIT(); AT_SWRITE(1, SO);
    AT_RESC(alA); __syncthreads();
  }
  AT_SBAR(); qkt(pB0, pB1, K_lds + SHM_K, qr, r32, hi, -m_reg);
  finishSM(pA0, pA1, alA, l_reg, pa0, pa1, pa2, pa3); AT_SBAR();
  pv_d0(o, vb0, pa0, pa1, pa2, pa3); partialSM_rel(pB0, pB1, m_reg, alB);
  __syncthreads(); AT_RESC(alB);
  finishSM(pB0, pB1, alB, l_reg, pa0, pa1, pa2, pa3); AT_SBAR();
  pv_d0(o, vb0 + SHM_V, pa0, pa1, pa2, pa3);
#ifdef AT_PRIO
  __builtin_amdgcn_s_setprio(0);
#endif
  if (hi == 0) li_l[r32] = l_reg; asm volatile("s_waitcnt lgkmcnt(0)" ::: "memory");
#pragma unroll
  for (int r = 0; r < 16; ++r) { const float rl = __builtin_amdgcn_rcpf(li_l[crow(r, hi)]);
#pragma unroll
    for (int d = 0; d < 4; ++d) o[d][r] *= rl; }
  __syncthreads();
#undef AT_SLOAD
#undef AT_SWRITE
#undef AT_SWAIT
#undef AT_RESC
}
}

__device__ __forceinline__ void attn_unit(Frame& F, int unit, float lam, const float* subln_g) {
    const int b = unit >> 6, h = (unit >> 3) & 7, qb = unit & 7;
    int tid_ = threadIdx.x; asm volatile("" : "+v"(tid_));
    const int tid = tid_, wid = tid >> 6, lane = tid & 63, r32 = lane & 31, hi = lane >> 5;
    const size_t rowbase = (size_t)b * SEQ;
    const bf16* Qb = (const bf16*)(F.ws + WS_DAQ) + (rowbase + qb * 256 + wid * 32) * 1024 + h * 128;
    const bf16* Kb = (const bf16*)(F.ws + WS_DAK) + rowbase * 1024 + h * 128;
    const bf16* Vb = (const bf16*)(F.ws + WS_DAV) + rowbase * 1024 + h * 128;
    GAS f32x4* stash = (GAS f32x4*)(F.ws + WS_STASH) + (size_t)blockIdx.x * 16 * 512 + tid;
    asm volatile("" : "+v"(stash));
    char* lds = (char*)F.ldsg + RING_OFF;
    f32x16 o[4];
    at::attn_pass(Qb, Kb, Vb, SEQ, lds, o);
#pragma unroll
    for (int d = 0; d < 4; ++d)
#pragma unroll
        for (int g = 0; g < 4; ++g) stash[(d * 4 + g) * 512] = (f32x4){o[d][4 * g], o[d][4 * g + 1], o[d][4 * g + 2], o[d][4 * g + 3]};
    at::attn_pass(Qb + 64, Kb + 64, Vb, SEQ, lds, o);
    float gsc[4];
#pragma unroll
    for (int d = 0; d < 4; ++d) gsc[d] = subln_g[d * 32 + r32] * (1.0f - LAMBDA_INIT);
    bf16* Ob = (bf16*)(F.ws + WS_OA) + (rowbase + qb * 256 + wid * 32) * 1024 + h * 128;
    LAS unsigned char* stg = F.lds + RING_OFF + 51200 + wid * 8704;
#pragma unroll
    for (int g = 0; g < 4; ++g) {
        f32x4 s0[4];
#pragma unroll
        for (int d = 0; d < 4; ++d) s0[d] = stash[(d * 4 + g) * 512];
#pragma unroll
        for (int q = 0; q < 4; ++q) { const int r = 4 * g + q;
            float v[4], ss = 0.f;
#pragma unroll
            for (int d = 0; d < 4; ++d) { v[d] = s0[d][q] - lam * o[d][r]; ss += v[d] * v[d]; }
#pragma unroll
            for (int x = 1; x < 32; x <<= 1) ss += __shfl_xor(ss, x);
            const float rstd = __builtin_amdgcn_rsqf(ss * (1.0f / 128.0f) + EPS);
            const int orow = at::crow(r, hi);
#pragma unroll
            for (int d = 0; d < 4; ++d) *(LAS unsigned short*)(stg + orow * 272 + (d * 32 + r32) * 2) = (unsigned short)(cvtpk(v[d] * rstd * gsc[d], 0.f) & 0xffffu);
        }
    }
    asm volatile("s_waitcnt lgkmcnt(0)" ::: "memory");
#pragma unroll
    for (int i = 0; i < 8; ++i) { const int row = i * 4 + (lane >> 4), ch = lane & 15;
        const v4u w = *(const LAS v4u*)(stg + row * 272 + ch * 16);
        *(v4u*)(Ob + (size_t)row * 1024 + ch * 8) = w; }
}


__device__ __forceinline__ void hgrn_combine(Frame& F, const float* norm_g) {
    const int gw = F.vcu * NWAVES + F.wave, NGW = F.G * NWAVES, lane = F.lane;
    const bf16* OFp = (const bf16*)(F.ws + WS_OF); const bf16* OBp = (const bf16*)(F.ws + WS_OBW);
    const bf16* GG = (const bf16*)(F.ws + WS_HGG); bf16* OB = (bf16*)(F.ws + WS_OB);
    f32x4 ng[4];
#pragma unroll
    for (int j = 0; j < 4; ++j) ng[j] = *(const f32x4*)(norm_g + (16 * lane + 4 * j) % 128);
    v4u fa[2], ba[2], ga[2], fb[2], bb[2], gb[2];
#if I8_AB
    v4u oa_a[2], oa_b[2];
    const bf16* OAp = (const bf16*)(F.ws + WS_OA);
#define HC_LOADA(AV, m_) do { const size_t off_ = (size_t)(m_) * 1024 + 16 * lane; AV[0] = *(const v4u*)(OAp + off_); AV[1] = *(const v4u*)(OAp + off_ + 8); } while (0)
#define HC_Q16(VAL, DST, SC, m_) do { float am_ = 0.f; _Pragma("unroll") for (int j = 0; j < 16; ++j) am_ = fmaxf(am_, __builtin_fabsf(VAL[j])); \
        _Pragma("unroll") for (int o = 1; o < 64; o <<= 1) am_ = fmaxf(am_, __shfl_xor(am_, o)); const float inv_ = am_ > 0.f ? 127.0f / am_ : 0.f; unsigned w_[4]; \
        _Pragma("unroll") for (int q = 0; q < 4; ++q) { const int a0 = __float2int_rn(VAL[4 * q] * inv_), a1 = __float2int_rn(VAL[4 * q + 1] * inv_), a2 = __float2int_rn(VAL[4 * q + 2] * inv_), a3 = __float2int_rn(VAL[4 * q + 3] * inv_); \
            w_[q] = (unsigned)(a0 & 255) | ((unsigned)(a1 & 255) << 8) | ((unsigned)(a2 & 255) << 16) | ((unsigned)a3 << 24); } \
        *(v4u*)((DST) + (size_t)(m_) * 1024 + 16 * lane) = (v4u){w_[0], w_[1], w_[2], w_[3]}; if (lane == 0) (SC)[m_] = am_ * (1.0f / 127.0f); } while (0)
#else
#define HC_LOADA(AV, m_) do { } while (0)
#endif
#define HC_LOAD(FV, BV, GV, m_) do { const size_t off_ = (size_t)(m_) * 1024 + 16 * lane; \
        FV[0] = *(const v4u*)(OFp + off_); FV[1] = *(const v4u*)(OFp + off_ + 8); BV[0] = *(const v4u*)(OBp + off_); BV[1] = *(const v4u*)(OBp + off_ + 8); \
        GV[0] = *(const v4u*)(GG + off_); GV[1] = *(const v4u*)(GG + off_ + 8); } while (0)
#define HC_PROC(FV, BV, GV, AV, m_) do { const size_t off_ = (size_t)(m_) * 1024 + 16 * lane; float v_[16]; float ss_ = 0.f; \
        const unsigned ff_[8] = {FV[0].x, FV[0].y, FV[0].z, FV[0].w, FV[1].x, FV[1].y, FV[1].z, FV[1].w}, bq_[8] = {BV[0].x, BV[0].y, BV[0].z, BV[0].w, BV[1].x, BV[1].y, BV[1].z, BV[1].w}; \
        _Pragma("unroll") for (int j = 0; j < 8; ++j) { v_[2 * j] = bf_lo(ff_[j]) + bf_lo(bq_[j]); v_[2 * j + 1] = bf_hi(ff_[j]) + bf_hi(bq_[j]); ss_ += v_[2 * j] * v_[2 * j] + v_[2 * j + 1] * v_[2 * j + 1]; } \
        ss_ += __shfl_xor(ss_, 1); ss_ += __shfl_xor(ss_, 2); ss_ += __shfl_xor(ss_, 4); \
        const float rstd_ = __builtin_amdgcn_rsqf(ss_ * (1.0f / 128.0f) + EPS); \
        const unsigned gg_[8] = {GV[0].x, GV[0].y, GV[0].z, GV[0].w, GV[1].x, GV[1].y, GV[1].z, GV[1].w}; \
        _Pragma("unroll") for (int j = 0; j < 8; ++j) { v_[2 * j] = v_[2 * j] * rstd_ * ng[j >> 1][(2 * j) & 3] * bf_lo(gg_[j]); v_[2 * j + 1] = v_[2 * j + 1] * rstd_ * ng[j >> 1][(2 * j + 1) & 3] * bf_hi(gg_[j]); } \
        HC_STORE(v_, AV, m_, off_); } while (0)
#if I8_AB
#define HC_STORE(V, AV, m_, off_) do { HC_Q16(V, (unsigned char*)(F.ws + WS_OB), (float*)(F.ws + WS_SAB), m_); \
        const unsigned aa_[8] = {AV[0].x, AV[0].y, AV[0].z, AV[0].w, AV[1].x, AV[1].y, AV[1].z, AV[1].w}; float a_[16]; \
        _Pragma("unroll") for (int j = 0; j < 8; ++j) { a_[2 * j] = bf_lo(aa_[j]); a_[2 * j + 1] = bf_hi(aa_[j]); } \
        HC_Q16(a_, (unsigned char*)(F.ws + WS_OA8), (float*)(F.ws + WS_SAO), m_); } while (0)
#else
#define HC_STORE(V, AV, m_, off_) do { unsigned o_[8]; _Pragma("unroll") for (int j = 0; j < 8; ++j) o_[j] = cvtpk(V[2 * j], V[2 * j + 1]); \
        *(v4u*)(OB + off_) = (v4u){o_[0], o_[1], o_[2], o_[3]}; *(v4u*)(OB + off_ + 8) = (v4u){o_[4], o_[5], o_[6], o_[7]}; } while (0)
    v4u oa_a[2], oa_b[2];
#endif
    int m = gw;
    if (m < T) { HC_LOAD(fa, ba, ga, m); HC_LOADA(oa_a, m); }
    for (; m < T; m += 2 * NGW) {
        if (m + NGW < T) { HC_LOAD(fb, bb, gb, m + NGW); HC_LOADA(oa_b, m + NGW); }
        HC_PROC(fa, ba, ga, oa_a, m);
        if (m + NGW < T) { if (m + 2 * NGW < T) { HC_LOAD(fa, ba, ga, m + 2 * NGW); HC_LOADA(oa_a, m + 2 * NGW); } HC_PROC(fb, bb, gb, oa_b, m + NGW); }
    }
#undef HC_LOAD
#undef HC_LOADA
#undef HC_PROC
#undef HC_STORE
#if I8_AB
#undef HC_Q16
#endif
}
__device__ __forceinline__ void cvt_table(Frame& F, const float* src, bf16* dst, size_t n) {
    const size_t n8 = n / 8, stride = (size_t)F.G * 512;
    for (size_t i = (size_t)F.vcu * 512 + F.tid; i < n8; i += stride) {
        const f32x4 a = *(const f32x4*)(src + i * 8), b = *(const f32x4*)(src + i * 8 + 4);
        *(v4u*)(dst + i * 8) = (v4u){cvtpk(a.x, a.y), cvtpk(a.z, a.w), cvtpk(b.x, b.y), cvtpk(b.z, b.w)};
    }
}

namespace pr {
typedef short bf16x8 __attribute__((ext_vector_type(8)));
constexpr int LK = 272;
#define PR_CE(a, b) do { const unsigned hi_ = (a) > (b) ? (a) : (b); const unsigned lo_ = (a) > (b) ? (b) : (a); (a) = hi_; (b) = lo_; } while (0)
__device__ __forceinline__ void sort16(unsigned (&v)[16]) {
#pragma unroll
    for (int k = 2; k <= 16; k <<= 1)
#pragma unroll
        for (int j = k >> 1; j > 0; j >>= 1)
#pragma unroll
            for (int i = 0; i < 16; ++i) { const int l = i ^ j; if (l > i) { if ((i & k) == 0) PR_CE(v[i], v[l]); else PR_CE(v[l], v[i]); } }
}
__device__ __forceinline__ void merge16(unsigned (&a)[16], const unsigned (&b)[16]) {
#pragma unroll
    for (int i = 0; i < 16; ++i) a[i] = a[i] > b[15 - i] ? a[i] : b[15 - i];
#pragma unroll
    for (int j = 8; j > 0; j >>= 1)
#pragma unroll
        for (int i = 0; i < 16; ++i) { const int l = i ^ j; if (l > i) PR_CE(a[i], a[l]); }
}
__device__ __forceinline__ unsigned ord(float f) { const unsigned u = __float_as_uint(f); return u ^ ((unsigned)((int)u >> 31) | 0x80000000u); }
__device__ __forceinline__ float unord(unsigned u) { return __uint_as_float((u & 0x80000000u) ? (u ^ 0x80000000u) : ~u); }
}
__device__ __forceinline__ void peer_route_unit(Frame& F, int unit, const float* keys1, const float* keys2) {
    using namespace pr;
    const int hp = unit >> 6, tt = unit & 63;
    LAS unsigned char* L = F.lds + RING_OFF;
    const int tid = F.tid, lane = F.lane, w = F.wave, r32 = lane & 31, hi = lane >> 5;
    for (int i = tid; i < 2 * 128 * 16; i += 512) { const int half = i >> 11, rem = i & 2047, kr = rem >> 4, kc = rem & 15;
        const float* src = (half ? keys2 : keys1) + ((size_t)hp * 128 + kr) * 128 + kc * 8;
        const f32x4 a = *(const f32x4*)src, b = *(const f32x4*)(src + 4);
        *(LAS v4u*)(L + half * (128 * LK) + kr * LK + kc * 16) = (v4u){cvtpk(a.x, a.y), cvtpk(a.z, a.w), cvtpk(b.x, b.y), cvtpk(b.z, b.w)}; }
    __syncthreads();
    const int tok = tt * 256 + w * 32 + r32;
    const bf16* qrow = (const bf16*)(F.ws + WS_QP) + (size_t)tok * DM + hp * 256 + hi * 8;
    unsigned top[2][16];
#pragma unroll
    for (int half = 0; half < 2; ++half) {
        bf16x8 qf[8];
#pragma unroll
        for (int ks = 0; ks < 8; ++ks) qf[ks] = *(const bf16x8*)(qrow + half * 128 + ks * 16);
        unsigned res[16];
#pragma unroll
        for (int kb = 0; kb < 4; ++kb) {
            f32x16 acc = f32x16{};
#pragma unroll
            for (int ks = 0; ks < 8; ++ks) acc = __builtin_amdgcn_mfma_f32_32x32x16_bf16(*(const LAS bf16x8*)(L + half * (128 * LK) + (32 * kb + r32) * LK + ks * 32 + hi * 16), qf[ks], acc, 0, 0, 0);
            unsigned kv[16];
#pragma unroll
            for (int r = 0; r < 16; ++r) { const int idx = 32 * kb + (r & 3) + 8 * (r >> 2) + 4 * hi; kv[r] = (ord(acc[r]) & 0xFFFFFF80u) | (unsigned)(127 - idx); }
            sort16(kv);
            if (kb == 0) {
#pragma unroll
                for (int r = 0; r < 16; ++r) res[r] = kv[r];
            } else merge16(res, kv);
        }
        unsigned oth[16];
#pragma unroll
        for (int r = 0; r < 16; ++r) { auto rr = __builtin_amdgcn_permlane32_swap(res[r], res[r], false, false); oth[r] = hi ? rr[0] : rr[1]; }
        merge16(res, oth);
#pragma unroll
        for (int r = 0; r < 16; ++r) top[half][r] = res[r];
    }
    float f1[16], f2[16]; unsigned ip1[4] = {0u, 0u, 0u, 0u}, ip2[4] = {0u, 0u, 0u, 0u};
#pragma unroll
    for (int r = 0; r < 16; ++r) { f1[r] = unord((top[0][r] & 0xFFFFFF80u) | 0x40u); f2[r] = unord((top[1][r] & 0xFFFFFF80u) | 0x40u);
        ip1[r >> 2] |= (127u - (top[0][r] & 127u)) << (8 * (r & 3)); ip2[r >> 2] |= (127u - (top[1][r] & 127u)) << (8 * (r & 3)); }
    unsigned cand[64];
    { int n = 0;
#pragma unroll
      for (int i = 0; i < 16; ++i)
#pragma unroll
          for (int j = 0; j < 16; ++j) if ((i + 1) * (j + 1) <= 16) { cand[n] = (ord(f1[i] + f2[j]) & 0xFFFFFF00u) | (unsigned)(255 - (i * 16 + j)); ++n; }
#pragma unroll
      for (int q = 50; q < 64; ++q) cand[q] = 0u; }
    unsigned res[16];
#pragma unroll
    for (int g = 0; g < 4; ++g) { unsigned kv[16];
#pragma unroll
        for (int r = 0; r < 16; ++r) kv[r] = cand[g * 16 + r];
        sort16(kv);
        if (g == 0) {
#pragma unroll
            for (int r = 0; r < 16; ++r) res[r] = kv[r];
        } else merge16(res, kv); }
    float sc[16]; int ex[16];
#pragma unroll
    for (int r = 0; r < 16; ++r) { sc[r] = unord((res[r] & 0xFFFFFF00u) | 0x80u); const unsigned ci = 255u - (res[r] & 255u), i = ci >> 4, j = ci & 15u;
        unsigned wi = ip1[0]; wi = (i >> 2) == 1 ? ip1[1] : wi; wi = (i >> 2) == 2 ? ip1[2] : wi; wi = (i >> 2) == 3 ? ip1[3] : wi;
        unsigned wj = ip2[0]; wj = (j >> 2) == 1 ? ip2[1] : wj; wj = (j >> 2) == 2 ? ip2[2] : wj; wj = (j >> 2) == 3 ? ip2[3] : wj;
        ex[r] = (int)(((wi >> (8 * (i & 3))) & 255u) * 128u + ((wj >> (8 * (j & 3))) & 255u)); }
    const float mx = sc[0];
    float ev[16], sum = 0.f;
#pragma unroll
    for (int r = 0; r < 16; ++r) { ev[r] = __expf(sc[r] - mx); sum += ev[r]; }
    const float inv = 1.0f / sum;
    int eo[8]; float go[8];
#pragma unroll
    for (int q = 0; q < 8; ++q) { eo[q] = hi ? ex[8 + q] : ex[q]; go[q] = (hi ? ev[8 + q] : ev[q]) * inv; }
    int* EI = (int*)(F.ws + WS_EIDX) + (size_t)tok * 128 + hp * 16 + 8 * hi;
    float* EGp = (float*)(F.ws + WS_EG) + (size_t)tok * 128 + hp * 16 + 8 * hi;
    typedef int i32x4 __attribute__((ext_vector_type(4)));
    *(i32x4*)EI = (i32x4){eo[0], eo[1], eo[2], eo[3]}; *(i32x4*)(EI + 4) = (i32x4){eo[4], eo[5], eo[6], eo[7]};
    *(f32x4*)EGp = (f32x4){go[0], go[1], go[2], go[3]}; *(f32x4*)(EGp + 4) = (f32x4){go[4], go[5], go[6], go[7]};
    __syncthreads();
}

typedef float f32x32 __attribute__((ext_vector_type(32)));
typedef int i32x6 __attribute__((ext_vector_type(6)));
typedef __bf16 bf16x32 __attribute__((ext_vector_type(32)));
typedef unsigned v2u __attribute__((ext_vector_type(2)));
constexpr int ROWB = 1536;
__device__ __forceinline__ void cvt_table_fp6(Frame& F, const float* src, unsigned char* dst, float* scale) {
    const int gw = F.vcu * NWAVES + F.wave, NGW = F.G * NWAVES, lane = F.lane;
    f32x4 va[8], vb[8];
#define CT_LOAD(V, r_) do { const float* rp_ = src + (size_t)(r_) * DM; _Pragma("unroll") for (int q = 0; q < 8; ++q) V[q] = *(const f32x4*)(rp_ + q * 256 + 4 * lane); } while (0)
#define CT_PROC(V, r_) do { float am_ = 0.f; \
        _Pragma("unroll") for (int q = 0; q < 8; ++q) am_ = fmaxf(am_, fmaxf(fmaxf(__builtin_fabsf(V[q].x), __builtin_fabsf(V[q].y)), fmaxf(__builtin_fabsf(V[q].z), __builtin_fabsf(V[q].w)))); \
        _Pragma("unroll") for (int o = 1; o < 64; o <<= 1) am_ = fmaxf(am_, __shfl_xor(am_, o)); \
        const float sc_ = am_ > 0.f ? am_ * (1.0f / 7.5f) : 1.0f, inv_ = 1.0f / sc_; bf16x32 b_; \
        _Pragma("unroll") for (int q = 0; q < 8; ++q) { b_[4 * q] = (__bf16)(V[q].x * inv_); b_[4 * q + 1] = (__bf16)(V[q].y * inv_); b_[4 * q + 2] = (__bf16)(V[q].z * inv_); b_[4 * q + 3] = (__bf16)(V[q].w * inv_); } \
        const i32x6 w_ = __builtin_amdgcn_cvt_scalef32_pk32_fp6_bf16(b_, 1.0f); unsigned char* op_ = dst + (size_t)(r_) * ROWB; \
        *(v4u*)(op_ + lane * 16) = (v4u){(unsigned)w_[0], (unsigned)w_[1], (unsigned)w_[2], (unsigned)w_[3]}; \
        *(v2u*)(op_ + 1024 + lane * 8) = (v2u){(unsigned)w_[4], (unsigned)w_[5]}; \
        if (lane == 0) scale[r_] = sc_; } while (0)
    int row = gw;
    if (row < 16384) CT_LOAD(va, row);
    for (; row < 16384; row += 2 * NGW) {
        if (row + NGW < 16384) CT_LOAD(vb, row + NGW);
        CT_PROC(va, row);
        if (row + NGW < 16384) { if (row + 2 * NGW < 16384) CT_LOAD(va, row + 2 * NGW); CT_PROC(vb, row + NGW); }
    }
#undef CT_LOAD
#undef CT_PROC
}
template <bool F4> __device__ __forceinline__ f32x32 dec_row(const v4u a, const v2u b) {
    if constexpr (F4) { f32x32 d; const unsigned ww[4] = {a.x, a.y, a.z, a.w};
#pragma unroll
        for (int q = 0; q < 4; ++q) { const f32x2v d0 = __builtin_amdgcn_cvt_scalef32_pk_f32_fp4(ww[q], 1.0f, 0), d1 = __builtin_amdgcn_cvt_scalef32_pk_f32_fp4(ww[q], 1.0f, 1), d2 = __builtin_amdgcn_cvt_scalef32_pk_f32_fp4(ww[q], 1.0f, 2), d3 = __builtin_amdgcn_cvt_scalef32_pk_f32_fp4(ww[q], 1.0f, 3);
            d[8 * q] = d0.x; d[8 * q + 1] = d0.y; d[8 * q + 2] = d1.x; d[8 * q + 3] = d1.y; d[8 * q + 4] = d2.x; d[8 * q + 5] = d2.y; d[8 * q + 6] = d3.x; d[8 * q + 7] = d3.y; }
        return d; }
    else { const i32x6 w = {(int)a.x, (int)a.y, (int)a.z, (int)a.w, (int)b.x, (int)b.y}; return __builtin_amdgcn_cvt_scalef32_pk32_f32_fp6(w, 1.0f); }
}
__device__ __forceinline__ f32x32 dec_fp6(const v4u a, const v2u b) { const i32x6 w = {(int)a.x, (int)a.y, (int)a.z, (int)a.w, (int)b.x, (int)b.y}; return __builtin_amdgcn_cvt_scalef32_pk32_f32_fp6(w, 1.0f); }
__device__ __forceinline__ float dot32_fp6(const v4u a, const v2u b, const f32x2v* h2) {
    const f32x32 d = dec_row<PEER_U4 != 0>(a, b); f32x2v p0 = {0.f, 0.f}, p1 = {0.f, 0.f};
#pragma unroll
    for (int q = 0; q < 16; q += 2) { p0 = __builtin_elementwise_fma((f32x2v){d[2 * q], d[2 * q + 1]}, h2[q], p0); p1 = __builtin_elementwise_fma((f32x2v){d[2 * q + 2], d[2 * q + 3]}, h2[q + 1], p1); }
    const f32x2v p = p0 + p1; return p.x + p.y;
}
__device__ __forceinline__ void axpy32_fp6(const v4u a, const v2u b, float c, f32x2v* acc2) {
    const f32x32 d = dec_row<PEER_V4 != 0>(a, b); const f32x2v cc = {c, c};
#pragma unroll
    for (int q = 0; q < 16; ++q) acc2[q] = __builtin_elementwise_fma(cc, (f32x2v){d[2 * q], d[2 * q + 1]}, acc2[q]);
}
#if PEER_UI4
template <int MODE> __device__ __forceinline__ void peer_dots_sweep(Frame& F) {
    const int gw = F.vcu * NWAVES + F.wave, NGW = F.G * NWAVES;
    int lane_ = F.lane; asm volatile("" : "+v"(lane_)); const int lane = lane_;
    const unsigned char* H2 = F.ws + WS_H2; const unsigned char* U8 = F.ws + WS_U8;
    const int* EI = (const int*)(F.ws + WS_EIDX); float* AP = (float*)(F.ws + WS_AP);
    LAS unsigned char* dig = F.lds + RING_OFF + F.wave * 8192;
    LAS unsigned* list = (LAS unsigned*)(F.lds + RING_OFF + 65536 + F.wave * 2176);
    typedef int i32x4v __attribute__((ext_vector_type(4)));
#pragma unroll 1
    for (int half = 0; half < 2; ++half) {
        int evr[4][2];
#pragma unroll
        for (int tl = 0; tl < 4; ++tl) { const int t = gw + NGW * (4 * half + tl);
            evr[tl][0] = EI[(size_t)t * 128 + lane]; evr[tl][1] = EI[(size_t)t * 128 + 64 + lane];
            unsigned hn[8], ln[8];
#pragma unroll
            for (int q = 0; q < 8; ++q) { const unsigned a = *(const unsigned*)(H2 + (size_t)t * DM + q * 256 + 4 * lane);
                ln[q] = a & 0x0F0F0F0Fu; hn[q] = ((((a ^ 0x80808080u) + 0x08080808u) >> 4) & 0x0F0F0F0Fu) ^ 0x08080808u; }
            *(LAS v4u*)(dig + tl * 2048 + lane * 16) = (v4u){hn[0] | (hn[1] << 4), hn[2] | (hn[3] << 4), hn[4] | (hn[5] << 4), hn[6] | (hn[7] << 4)};
            *(LAS v4u*)(dig + tl * 2048 + 1024 + lane * 16) = (v4u){ln[0] | (ln[1] << 4), ln[2] | (ln[3] << 4), ln[4] | (ln[5] << 4), ln[6] | (ln[7] << 4)}; }
#pragma unroll 1
        for (int s = 0; s < 8; ++s) {
            int n = 0;
#pragma unroll
            for (int tl = 0; tl < 4; ++tl)
#pragma unroll
                for (int h = 0; h < 2; ++h) { const int ev = evr[tl][h]; const bool c = (ev >> 11) == s; const unsigned long long m = __ballot(c);
                    const int pos = n + (int)__builtin_amdgcn_mbcnt_hi((unsigned)(m >> 32), __builtin_amdgcn_mbcnt_lo((unsigned)m, 0u));
                    if (c) list[pos] = (unsigned)ev | ((unsigned)tl << 14) | ((unsigned)(h * 64 + lane) << 16);
                    n += __builtin_popcountll(m); }
            if (lane < 16) list[n + lane] = ((unsigned)s << 11) | 0x80000000u;
            __builtin_amdgcn_fence(__ATOMIC_RELEASE, "wavefront"); __builtin_amdgcn_wave_barrier();
            const int G16 = (n + 15) >> 4;
            v4u bufA[4][4], bufB[4][4]; unsigned entA[4], entB[4];
            const int grp = lane >> 4, li = lane & 15;
#define PS_LOAD(BUF, ENT, g_) do { _Pragma("unroll") for (int j_ = 0; j_ < 4; ++j_) { ENT[j_] = list[16 * (g_) + 4 * j_ + grp]; \
                const unsigned char* rp_ = U8 + (size_t)(ENT[j_] & (MODE == 1 ? 63u : 0x3FFFu)) * 1024 + li * 16; \
                if (!(ENT[j_] >> 31)) { _Pragma("unroll") for (int k_ = 0; k_ < 4; ++k_) BUF[j_][k_] = *(const v4u*)(rp_ + 256 * k_); } } } while (0)
#define PS_DPP(x_, ctrl_) __builtin_bit_cast(float, __builtin_amdgcn_update_dpp(0, __builtin_bit_cast(int, (x_)), (ctrl_), 0xF, 0xF, true))
#define PS_PROC(BUF, ENT, g_) do { float part[4]; \
                _Pragma("unroll") for (int j_ = 0; j_ < 4; ++j_) { const LAS unsigned char* dp_ = dig + ((ENT[j_] >> 14) & 3u) * 2048 + li * 16; int ah = 0, al = 0; \
                    _Pragma("unroll") for (int k_ = 0; k_ < 4; ++k_) { const i32x4v dh = *(const LAS i32x4v*)(dp_ + 256 * k_), dl = *(const LAS i32x4v*)(dp_ + 1024 + 256 * k_); \
                        ah = __builtin_amdgcn_sdot8((int)BUF[j_][k_].x, dh.x, ah, false); al = __builtin_amdgcn_sdot8((int)BUF[j_][k_].x, dl.x, al, false); \
                        ah = __builtin_amdgcn_sdot8((int)BUF[j_][k_].y, dh.y, ah, false); al = __builtin_amdgcn_sdot8((int)BUF[j_][k_].y, dl.y, al, false); \
                        ah = __builtin_amdgcn_sdot8((int)BUF[j_][k_].z, dh.z, ah, false); al = __builtin_amdgcn_sdot8((int)BUF[j_][k_].z, dl.z, al, false); \
                        ah = __builtin_amdgcn_sdot8((int)BUF[j_][k_].w, dh.w, ah, false); al = __builtin_amdgcn_sdot8((int)BUF[j_][k_].w, dl.w, al, false); } \
                    part[j_] = (float)(ah * 16 + al); } \
                { const bool up_ = (lane & 1) != 0; \
                  const float s0 = up_ ? part[0] : part[2], k0 = up_ ? part[2] : part[0], s1 = up_ ? part[1] : part[3], k1 = up_ ? part[3] : part[1]; \
                  part[0] = k0 + PS_DPP(s0, 0xB1); part[1] = k1 + PS_DPP(s1, 0xB1); } \
                { const bool up_ = (lane & 2) != 0; const float s0 = up_ ? part[0] : part[1], k0 = up_ ? part[1] : part[0]; part[0] = k0 + PS_DPP(s0, 0x4E); } \
                float tot = part[0]; tot = (tot + PS_DPP(tot, 0x124)) + (PS_DPP(tot, 0x128) + PS_DPP(tot, 0x12C));              \
                if ((lane & 12) == 0) { const unsigned en_ = list[16 * (g_) + 4 * (2 * (lane & 1) + ((lane >> 1) & 1)) + grp]; \
                    if (!(en_ >> 31)) { const int t_ = gw + NGW * (4 * half + (int)((en_ >> 14) & 3u)); AP[(size_t)t_ * 128 + ((en_ >> 16) & 127u)] = tot; } } } while (0)
            if (G16 > 0) PS_LOAD(bufA, entA, 0);
#pragma unroll 1
            for (int g = 0; g < G16; g += 2) {
                if (g + 1 < G16) PS_LOAD(bufB, entB, g + 1);
                PS_PROC(bufA, entA, g);
                if (g + 1 < G16) { if (g + 2 < G16) PS_LOAD(bufA, entA, g + 2); PS_PROC(bufB, entB, g + 1); }
            }
#undef PS_LOAD
#undef PS_PROC
#undef PS_DPP
            __builtin_amdgcn_fence(__ATOMIC_RELEASE, "wavefront"); __builtin_amdgcn_wave_barrier();
        }
    }
}
#endif
#ifndef PEER_VSWEEP
#define PEER_VSWEEP 0
#endif
#ifndef PEER_VSORT
#define PEER_VSORT 1
#endif
#ifndef PEER_VBAR
#define PEER_VBAR 1
#endif
#if PEER_UI4 && PEER_VSWEEP
#ifndef VS_SHIFT
#define VS_SHIFT 11
#endif
template <int MODE> __device__ __forceinline__ void peer_vsweep_pass(Frame& F, const float* ada, const float* final_g_, const int pass) {
    const float* final_g = final_g_; asm volatile("" : "+s"(final_g));
    const int gw = F.vcu * NWAVES + F.wave, NGW = F.G * NWAVES;
    int lane_ = F.lane; asm volatile("" : "+v"(lane_)); const int lane = lane_;
    const unsigned char* V8 = F.ws + WS_V8;
    const float* SU = (const float*)(F.ws + WS_SCU); const float* SV = (const float*)(F.ws + WS_SCV);
    const int* EI = (const int*)(F.ws + WS_EIDX); const float* EGp = (const float*)(F.ws + WS_EG); const float* AP = (const float*)(F.ws + WS_AP);
    LAS unsigned* le = (LAS unsigned*)(F.lds + RING_OFF + F.wave * 8192);
    LAS float* lc = (LAS float*)(le + 384);
    int evr[2][2]; float cfr[2][2];
#pragma unroll
    for (int tl = 0; tl < 2; ++tl) { const int t = gw + NGW * (2 * pass + tl);
        const float sa2 = ((const float*)(F.ws + WS_SA2))[t];
        const int ev0 = EI[(size_t)t * 128 + lane], ev1 = EI[(size_t)t * 128 + 64 + lane];
        const float gv0 = EGp[(size_t)t * 128 + lane], gv1 = EGp[(size_t)t * 128 + 64 + lane];
        const float at0 = AP[(size_t)t * 128 + lane], at1 = AP[(size_t)t * 128 + 64 + lane];
        const float su0 = SU[ev0], su1 = SU[ev1], sv0 = SV[ev0], sv1 = SV[ev1];
        const pg8::f32x2 gl = pg8::gelu_pk((pg8::f32x2){at0 * su0 * sa2, at1 * su1 * sa2});
        evr[tl][0] = ev0; evr[tl][1] = ev1; cfr[tl][0] = gl.x * gv0 * sv0; cfr[tl][1] = gl.y * gv1 * sv1; }
    int n = 0;
#pragma unroll 1
    for (int s = 0; s < (16384 >> VS_SHIFT); ++s) {
#pragma unroll
        for (int tl = 0; tl < 2; ++tl) { const int n0 = n;
#pragma unroll
            for (int h = 0; h < 2; ++h) { const int ev = evr[tl][h]; const bool c = (ev >> VS_SHIFT) == s; const unsigned long long m = __ballot(c);
                const int pos = n + (int)__builtin_amdgcn_mbcnt_hi((unsigned)(m >> 32), __builtin_amdgcn_mbcnt_lo((unsigned)m, 0u));
                if (c) { le[pos] = (unsigned)ev | ((unsigned)tl << 14); lc[pos] = cfr[tl][h]; }
                n += __builtin_popcountll(m); }
            const int padn = (n0 - n) & 3;
            if (lane < padn) { le[n + lane] = ((unsigned)s << VS_SHIFT) | ((unsigned)tl << 14); lc[n + lane] = 0.f; }
            n += padn; }
    }
    if (lane < 4) { le[n + lane] = (7u << 11); lc[n + lane] = 0.f; }
    __builtin_amdgcn_fence(__ATOMIC_RELEASE, "wavefront"); __builtin_amdgcn_wave_barrier();
    const int G4 = ((n + 7) & ~7) >> 2;
    f32x2v acc0[16], acc1[16];
#pragma unroll
    for (int i = 0; i < 16; ++i) { acc0[i] = (f32x2v){0.f, 0.f}; acc1[i] = (f32x2v){0.f, 0.f}; }
    v4u bufA[4], bufB[4]; unsigned entA = 0u, entB = 0u; float cfA = 0.f, cfB = 0.f;
#pragma unroll
    for (int i = 0; i < 4; ++i) { bufA[i] = (v4u){0u, 0u, 0u, 0u}; bufB[i] = (v4u){0u, 0u, 0u, 0u}; }
    v2u bufA2[4], bufB2[4];
#pragma unroll
    for (int i = 0; i < 4; ++i) { bufA2[i] = (v2u){0u, 0u}; bufB2[i] = (v2u){0u, 0u}; }
#define PV_LOAD(BUF, ENT, CF, g_) do { ENT = le[4 * (g_) + (lane & 3)]; CF = lc[4 * (g_) + (lane & 3)]; \
        _Pragma("unroll") for (int i_ = 0; i_ < 4; ++i_) { const unsigned e_ = (unsigned)__builtin_amdgcn_readlane((int)ENT, i_) & (MODE == 2 ? 63u : 0x3FFFu); const unsigned char* p_ = V8 + (size_t)e_ * pg8::PEER_ROWB_V; BUF[i_] = *(const v4u*)(p_ + lane * 16); if (!(PEER_V4)) BUF##2[i_] = *(const v2u*)(p_ + 1024 + lane * 8); } } while (0)
#define PV_PROC(BUF, ENT, CF) do { const unsigned tg_ = ((unsigned)__builtin_amdgcn_readlane((int)ENT, 0) >> 14) & 1u; \
        if (tg_ != curtl) { curtl = tg_; _Pragma("unroll") for (int i_ = 0; i_ < 16; ++i_) { const f32x2v t_ = acc0[i_]; acc0[i_] = acc1[i_]; acc1[i_] = t_; } }     \
        _Pragma("unroll") for (int i_ = 0; i_ < 4; ++i_) axpy32_fp6(BUF[i_], BUF##2[i_], __builtin_bit_cast(float, __builtin_amdgcn_readlane(__builtin_bit_cast(int, CF), i_)), acc0); } while (0)
    unsigned curtl = 0u;
    PV_LOAD(bufA, entA, cfA, 0);
#pragma unroll 1
    for (int g = 0; g < G4; g += 2) {
        PV_LOAD(bufB, entB, cfB, g + 1);
        PV_PROC(bufA, entA, cfA);
        if (g + 2 < G4) PV_LOAD(bufA, entA, cfA, g + 2);
        PV_PROC(bufB, entB, cfB);
    }
#undef PV_LOAD
#undef PV_PROC
    __builtin_amdgcn_fence(__ATOMIC_RELEASE, "wavefront"); __builtin_amdgcn_wave_barrier();
#pragma unroll 1
    for (int tl = 0; tl < 2; ++tl) { const int t = gw + NGW * (2 * pass + tl);
        const int b = t / SEQ; float* xo = F.out + (size_t)t * DM; float ss = 0.f; f32x4 x2[8];
#pragma unroll
        for (int q = 0; q < 8; ++q) { const int col = q * 256 + 4 * lane;
            const f32x4 x1 = *(const f32x4*)(xo + col), g2 = *(const f32x4*)(ada + (size_t)b * ADA_W + 5 * DM + col);
            const f32x4 pe = ((unsigned)tl != curtl) ? (f32x4){acc1[2 * q].x, acc1[2 * q].y, acc1[2 * q + 1].x, acc1[2 * q + 1].y} : (f32x4){acc0[2 * q].x, acc0[2 * q].y, acc0[2 * q + 1].x, acc0[2 * q + 1].y};
            x2[q] = x1 + g2 * pe;
            ss += (x2[q].x * x2[q].x + x2[q].y * x2[q].y) + (x2[q].z * x2[q].z + x2[q].w * x2[q].w); }
        const float rstd = __builtin_amdgcn_rsqf(wave_sum(ss) * (1.0f / DM) + EPS);
#pragma unroll
        for (int q = 0; q < 8; ++q) { const int col = q * 256 + 4 * lane; const f32x4 fg = *(const f32x4*)(final_g + col);
            if (MODE == 0) *(f32x4*)(xo + col) = x2[q] * rstd * fg; else asm volatile("" :: "v"(x2[q] * rstd * fg)); } }
}
#endif
__device__ __forceinline__ void peer_main(Frame& F, const float* ada, const float* final_g, const XcdBarrier* barp) {
    const int gw = F.vcu * NWAVES + F.wave, NGW = F.G * NWAVES;
    int lane_ = F.lane; asm volatile("" : "+v"(lane_)); const int lane = lane_;
    const bf16* H2 = (const bf16*)(F.ws + WS_H2); const unsigned char* U8 = F.ws + WS_U8; const unsigned char* V8 = F.ws + WS_V8;
    const float* SU = (const float*)(F.ws + WS_SCU); const float* SV = (const float*)(F.ws + WS_SCV);
    const int* EI = (const int*)(F.ws + WS_EIDX); const float* EGp = (const float*)(F.ws + WS_EG);
#if PEER_UI4
#ifdef PROBE_SWEEP_DUP
    peer_dots_sweep<PROBE_SWEEP_DUP>(F);
#endif
    peer_dots_sweep<0>(F);
    __threadfence();
#if PEER_VSWEEP
#pragma unroll 1
    for (int pass = 0; pass < 4; ++pass) {
#if PEER_VBAR
        if (barp) xcd_barrier(*barp);
#endif
#ifdef PROBE_VSWEEP_DUP
        peer_vsweep_pass<PROBE_VSWEEP_DUP>(F, ada, final_g, pass);
#endif
        peer_vsweep_pass<0>(F, ada, final_g, pass);
    }
    return;
#endif
#endif
    for (int t = gw; t < T; t += NGW) {
#if PEER_UI4
#ifdef PROBE_TOKBAR
        if (barp && (((t - gw) / NGW) % PROBE_TOKBAR) == 0) xcd_barrier(*barp);
#endif
        const float sa2 = ((const float*)(F.ws + WS_SA2))[t];
#elif I8_Q
        f32x2v hf[16];
#pragma unroll
        for (int q = 0; q < 8; ++q) { const int a = *(const int*)((const unsigned char*)H2 + (size_t)t * DM + q * 256 + 4 * lane);
            hf[2 * q] = (f32x2v){(float)((a << 24) >> 24), (float)((a << 16) >> 24)}; hf[2 * q + 1] = (f32x2v){(float)((a << 8) >> 24), (float)(a >> 24)}; }
        const float sa2 = ((const float*)(F.ws + WS_SA2))[t];
#else
        f32x2v hf[16];
#pragma unroll
        for (int q = 0; q < 8; ++q) { const v2u a = *(const v2u*)(H2 + (size_t)t * DM + q * 256 + 4 * lane);
            hf[2 * q] = (f32x2v){bf_lo(a.x), bf_hi(a.x)}; hf[2 * q + 1] = (f32x2v){bf_lo(a.y), bf_hi(a.y)}; }
        const float sa2 = 1.0f;
#endif
        int ev0 = EI[(size_t)t * 128 + lane], ev1 = EI[(size_t)t * 128 + 64 + lane];
        const float gv0 = EGp[(size_t)t * 128 + lane], gv1 = EGp[(size_t)t * 128 + 64 + lane];
        const float su0 = SU[ev0], su1 = SU[ev1], sv0 = SV[ev0], sv1 = SV[ev1];
        v4u bufA[4], bufB[4]; v2u bufA2[4], bufB2[4];
#define PM_EMASK 0x7FFFFFFF
#define PM_LOAD(BUF, BUF2, TAB, RB, F4, g) do { const int evs_ = ((g) >= 16) ? ev1 : ev0; _Pragma("unroll") for (int i_ = 0; i_ < 4; ++i_) { const int e_ = __builtin_amdgcn_readlane(evs_, (4 * (g) + i_) & 63) & PM_EMASK; \
            const unsigned char* p_ = (TAB) + (size_t)e_ * (RB); BUF[i_] = *(const v4u*)(p_ + lane * 16); if (!(F4)) BUF2[i_] = *(const v2u*)(p_ + 1024 + lane * 8); else BUF2[i_] = (v2u){0u, 0u}; } } while (0)
#if PEER_UI4
        float at0 = ((const float*)(F.ws + WS_AP))[(size_t)t * 128 + lane], at1 = ((const float*)(F.ws + WS_AP))[(size_t)t * 128 + 64 + lane];
#else
        float at0 = 0.f, at1 = 0.f;
#ifdef PROBE_PEER_LOADL2
#undef PM_EMASK
#define PM_EMASK 2047
#define PROBE_PEER_LOADONLY 1
#endif
#ifdef PROBE_PEER_LOADDEEP
        { unsigned dz = 0u; v4u bufC[4], bufD[4]; v2u bufC2[4], bufD2[4];
#define PM_EAT(B) _Pragma("unroll") for (int i = 0; i < 4; ++i) dz ^= (B[i].x ^ B[i].y) ^ (B[i].z ^ B[i].w);
          PM_LOAD(bufA, bufA2, V8, pg8::PEER_ROWB_V, PEER_V4, 0); PM_LOAD(bufB, bufB2, V8, pg8::PEER_ROWB_V, PEER_V4, 1); PM_LOAD(bufC, bufC2, V8, pg8::PEER_ROWB_V, PEER_V4, 2);
#pragma unroll 1
          for (int g4 = 0; g4 < 32; g4 += 4) {
              PM_LOAD(bufD, bufD2, V8, pg8::PEER_ROWB_V, PEER_V4, g4 + 3); PM_EAT(bufA)
              if (g4 + 4 < 32) PM_LOAD(bufA, bufA2, V8, pg8::PEER_ROWB_V, PEER_V4, g4 + 4); PM_EAT(bufB)
              if (g4 + 4 < 32) PM_LOAD(bufB, bufB2, V8, pg8::PEER_ROWB_V, PEER_V4, g4 + 5); PM_EAT(bufC)
              if (g4 + 4 < 32) PM_LOAD(bufC, bufC2, V8, pg8::PEER_ROWB_V, PEER_V4, g4 + 6); PM_EAT(bufD)
          }
#undef PM_EAT
          asm volatile("" :: "v"(dz)); }
#endif
#ifdef PROBE_PEER_LOADONLY
        { unsigned dz = 0u;
          PM_LOAD(bufA, bufA2, V8, pg8::PEER_ROWB_V, PEER_V4, 0);
#pragma unroll 1
          for (int g2 = 0; g2 < 32; g2 += 2) {
              PM_LOAD(bufB, bufB2, V8, pg8::PEER_ROWB_V, PEER_V4, g2 + 1);
#pragma unroll
              for (int i = 0; i < 4; ++i) dz ^= (bufA[i].x ^ bufA[i].y) ^ (bufA[i].z ^ bufA[i].w);
              if (g2 + 2 < 32) PM_LOAD(bufA, bufA2, V8, pg8::PEER_ROWB_V, PEER_V4, g2 + 2);
#pragma unroll
              for (int i = 0; i < 4; ++i) dz ^= (bufB[i].x ^ bufB[i].y) ^ (bufB[i].z ^ bufB[i].w);
          }
          asm volatile("" :: "v"(dz)); }
#endif
#undef PM_EMASK
#define PM_EMASK 0x7FFFFFFF
#ifdef PROBE_PEER_A2
#pragma unroll 1
        for (int rep_ = 0; rep_ < 2; ++rep_) {
#else
        {
#endif
        PM_LOAD(bufA, bufA2, U8, pg8::PEER_ROWB_U, PEER_U4, 0);
#pragma unroll 1
        for (int sg = 0; sg < 8; ++sg) {
            float part[16]; const int g0 = 4 * sg;
            PM_LOAD(bufB, bufB2, U8, pg8::PEER_ROWB_U, PEER_U4, g0 + 1);
#pragma unroll
            for (int i = 0; i < 4; ++i) part[i] = dot32_fp6(bufA[i], bufA2[i], hf);
            PM_LOAD(bufA, bufA2, U8, pg8::PEER_ROWB_U, PEER_U4, g0 + 2);
#pragma unroll
            for (int i = 0; i < 4; ++i) part[4 + i] = dot32_fp6(bufB[i], bufB2[i], hf);
            PM_LOAD(bufB, bufB2, U8, pg8::PEER_ROWB_U, PEER_U4, g0 + 3);
#pragma unroll
            for (int i = 0; i < 4; ++i) part[8 + i] = dot32_fp6(bufA[i], bufA2[i], hf);
            if (sg < 7) PM_LOAD(bufA, bufA2, U8, pg8::PEER_ROWB_U, PEER_U4, g0 + 4);
#pragma unroll
            for (int i = 0; i < 4; ++i) part[12 + i] = dot32_fp6(bufB[i], bufB2[i], hf);
#define PM_STAGE(N, OFF) _Pragma("unroll") for (int i = 0; i < (N); ++i) { const bool up_ = (lane & (OFF)) != 0; const float send = up_ ? part[i] : part[i + (N)]; const float keep = up_ ? part[i + (N)] : part[i]; part[i] = keep + __shfl_xor(send, (OFF)); }
            PM_STAGE(8, 8) PM_STAGE(4, 4) PM_STAGE(2, 2) PM_STAGE(1, 1)
#undef PM_STAGE
            float tot = part[0]; tot += __shfl_xor(tot, 16); tot += __shfl_xor(tot, 32);
            const bool mine = (lane >> 4) == (sg & 3);
            if (sg < 4) at0 = mine ? tot : at0; else at1 = mine ? tot : at1;
        }
        }
#endif
        float cf0, cf1;
        { const pg8::f32x2 gl = pg8::gelu_pk((pg8::f32x2){at0 * su0 * sa2, at1 * su1 * sa2}); cf0 = gl.x * gv0 * sv0; cf1 = gl.y * gv1 * sv1; }
#if PEER_UI4 && PEER_VSORT
        { LAS unsigned* le = (LAS unsigned*)(F.lds + RING_OFF + F.wave * 8192); LAS float* lc = (LAS float*)(le + 128); int n = 0;
#pragma unroll 1
          for (int s = 0; s < 8; ++s) {
#pragma unroll
              for (int h = 0; h < 2; ++h) { const int ev = h ? ev1 : ev0; const bool c = (ev >> 11) == s; const unsigned long long m = __ballot(c);
                  const int pos = n + (int)__builtin_amdgcn_mbcnt_hi((unsigned)(m >> 32), __builtin_amdgcn_mbcnt_lo((unsigned)m, 0u));
                  if (c) { le[pos] = (unsigned)ev; lc[pos] = h ? cf1 : cf0; }
                  n += __builtin_popcountll(m); } }
          __builtin_amdgcn_fence(__ATOMIC_RELEASE, "wavefront"); __builtin_amdgcn_wave_barrier();
          ev0 = (int)le[lane]; ev1 = (int)le[64 + lane]; cf0 = lc[lane]; cf1 = lc[64 + lane];
          __builtin_amdgcn_fence(__ATOMIC_RELEASE, "wavefront"); __builtin_amdgcn_wave_barrier(); }
#endif
        f32x2v acc[16];
#pragma unroll
        for (int i = 0; i < 16; ++i) acc[i] = (f32x2v){0.f, 0.f};
#ifdef PROBE_PEER_VALU
        f32x2v accd[16];
#pragma unroll
        for (int i = 0; i < 16; ++i) accd[i] = (f32x2v){0.f, 0.f};
#endif
        PM_LOAD(bufA, bufA2, V8, pg8::PEER_ROWB_V, PEER_V4, 0);
#pragma unroll 1
        for (int g2 = 0; g2 < 32; g2 += 2) {
            PM_LOAD(bufB, bufB2, V8, pg8::PEER_ROWB_V, PEER_V4, g2 + 1);
            { const int cfs = __builtin_bit_cast(int, (g2 >= 16) ? cf1 : cf0);
#pragma unroll
              for (int i = 0; i < 4; ++i) { const float c = __builtin_bit_cast(float, __builtin_amdgcn_readlane(cfs, (4 * g2 + i) & 63)); axpy32_fp6(bufA[i], bufA2[i], c, acc);
#ifdef PROBE_PEER_VALU
                axpy32_fp6(bufA[i], bufA2[i], c * 0.5f, accd);
#endif
              } }
            if (g2 + 2 < 32) PM_LOAD(bufA, bufA2, V8, pg8::PEER_ROWB_V, PEER_V4, g2 + 2);
            { const int cfs = __builtin_bit_cast(int, (g2 + 1 >= 16) ? cf1 : cf0);
#pragma unroll
              for (int i = 0; i < 4; ++i) { const float c = __builtin_bit_cast(float, __builtin_amdgcn_readlane(cfs, (4 * (g2 + 1) + i) & 63)); axpy32_fp6(bufB[i], bufB2[i], c, acc);
#ifdef PROBE_PEER_VALU
                axpy32_fp6(bufB[i], bufB2[i], c * 0.5f, accd);
#endif
              } }
        }
#undef PM_LOAD
#ifdef PROBE_PEER_VALU
#pragma unroll
        for (int i = 0; i < 16; ++i) asm volatile("" :: "v"(accd[i]));
#endif
        const int b = t / SEQ; float* xo = F.out + (size_t)t * DM; float ss = 0.f; f32x4 x2[8];
#pragma unroll
        for (int q = 0; q < 8; ++q) { const int col = q * 256 + 4 * lane;
            const f32x4 x1 = *(const f32x4*)(xo + col), g2 = *(const f32x4*)(ada + (size_t)b * ADA_W + 5 * DM + col);
            const f32x4 pe = {acc[2 * q].x, acc[2 * q].y, acc[2 * q + 1].x, acc[2 * q + 1].y};
            x2[q] = x1 + g2 * pe;
            ss += (x2[q].x * x2[q].x + x2[q].y * x2[q].y) + (x2[q].z * x2[q].z + x2[q].w * x2[q].w); }
        const float rstd = __builtin_amdgcn_rsqf(wave_sum(ss) * (1.0f / DM) + EPS);
#pragma unroll
        for (int q = 0; q < 8; ++q) { const int col = q * 256 + 4 * lane; const f32x4 fg = *(const f32x4*)(final_g + col);
            *(f32x4*)(xo + col) = x2[q] * rstd * fg; }
    }
}


struct Args { const void* in[25]; float* out; unsigned char* ws; int ph_lo, ph_hi; };
__global__ void __launch_bounds__(NWAVES * 64, 2) mk_fwd(Args args) {
    extern __shared__ __attribute__((aligned(16))) unsigned char lds[];
    Frame F;
    F.lds = (LAS unsigned char*)lds; F.ldsg = lds;
    F.MISC = (volatile LAS unsigned*)(F.lds + MISC_OFF);
    F.tid = threadIdx.x; F.lane = F.tid & 63; F.wave = __builtin_amdgcn_readfirstlane(F.tid >> 6);
    F.G = gridDim.x; { const int bx = blockIdx.x; F.vcu = (F.G % 8 == 0) ? (bx % 8) * (F.G / 8) + bx / 8 : bx; }
    F.ws = args.ws; F.out = args.out; F.ctl = (gu32*)(args.ws + WS_CTL);
    for (int u = F.tid; u < (LDS_BYTES - LDSCTL_OFF) / 4; u += NWAVES * 64) ((LAS unsigned*)(F.lds + LDSCTL_OFF))[u] = 0u;
    __syncthreads();
    XcdBarrier bar; bar.bar = (unsigned*)(F.ctl + CW_BAR); bar.x = 0; bar.st = nullptr;
    if (N_LAUNCHES == 1) bar = xcd_barrier_post((unsigned*)(F.ctl + CW_BAR), F.MISC + 8);
#ifdef DOUBLE_BAR
#define GRID_BAR() do { if (N_LAUNCHES == 1) { xcd_barrier(bar); xcd_barrier(bar); } } while (0)
#else
#define GRID_BAR() do { if (N_LAUNCHES == 1) xcd_barrier(bar); } while (0)
#endif
    const int lo = args.ph_lo, hi = args.ph_hi;
#ifndef G1_SP2
#define G1_SP2 true
#endif
#ifndef G1_ALIGN
#define G1_ALIGN true
#endif
#ifndef PH_MASK
#define PH_MASK 0xFFFF
#endif
#define IN(k) ((((PH_MASK) >> (k)) & 1) && lo <= (k) && (k) < hi)
#define BOTH(k) (IN(k) && IN((k) + 1))
#ifndef DUP_MASK
#define DUP_MASK 0
#endif
#define REPS(k) for (int rep_ = 0; rep_ < ((((DUP_MASK) >> (k)) & 1) ? 2 : 1); ++rep_)
    const float* x = IN_F(0); const float* ada = (const float*)(F.ws + WS_ADA);

    if (IN(0)) REPS(0) { p0_prologue<0>(F, IN_F(1), (const int*)args.in[2], IN_F(3), IN_F(4), IN_F(6), IN_F(15), IN_F(16), IN_F(17), IN_F(19)); if (BOTH(0)) GRID_BAR(); }
    if (IN(1)) REPS(1) { p0_prologue<1>(F, IN_F(1), (const int*)args.in[2], IN_F(3), IN_F(4), IN_F(6), IN_F(15), IN_F(16), IN_F(17), IN_F(19)); mod_rows_i8(F, x, IN_F(5), ada + 0 * DM, ada + 1 * DM, F.ws + WS_H, (float*)(F.ws + WS_SA)); if (BOTH(1)) GRID_BAR(); }
    if (IN(2)) REPS(2) {
        pg8::Gemm g{(const bf16*)(F.ws + WS_H), (const bf16*)(F.ws + WS_WIN), T, IN_W, DM / 2}; pg8::StaticOrder S; S.init(T, IN_W, F.G, (int)blockIdx.x);
        pg8::EpiG1 E; E.ws = F.ws; E.positions = (const int*)args.in[2]; E.sa = (const float*)(F.ws + WS_SA); E.sb = (const float*)(F.ws + WS_SB) + CM_IN / 256;
        E.tsrc_u = IN_F(22); E.tsrc_v = IN_F(23); E.tdst_u = F.ws + WS_U8; E.tdst_v = F.ws + WS_V8; E.tsc_u = (float*)(F.ws + WS_SCU); E.tsc_v = (float*)(F.ws + WS_SCV); E.cnt = 0;
#ifndef G1_STAGGER_MASK
#define G1_STAGGER_MASK 3
#endif
#ifdef G1_STAGGER_TICKS
        { const unsigned long long t0_ = rt(); const unsigned long long d_ = (unsigned long long)(blockIdx.x & G1_STAGGER_MASK) * G1_STAGGER_TICKS; while (rt() - t0_ < d_) __builtin_amdgcn_s_sleep(8); }
#endif
#ifdef PROBE_G1_VAR
        { pg8::EpiG1T<PROBE_G1_VAR> EV; EV.ws = F.ws; EV.positions = E.positions; EV.sa = E.sa; EV.sb = E.sb; EV.cnt = 8; pg8::gemm_phase<pg8::EpiG1T<PROBE_G1_VAR>, pg8::StaticOrder, true, true, true>(F.lds + RING_OFF, g, S, EV); }
#endif
        pg8::gemm_phase<pg8::EpiG1, pg8::StaticOrder, G1_ALIGN, G1_SP2, true>(F.lds + RING_OFF, g, S, E);
#ifdef PROBE_G1_NULL
        { pg8::EpiNull EN; pg8::gemm_phase<pg8::EpiNull, pg8::StaticOrder, true, true, true>(F.lds + RING_OFF, g, S, EN); }
#endif
        if (BOTH(2)) GRID_BAR();
    }
    if (IN(3)) REPS(3) {
        for (int r2_ = 0; r2_ < ((((DUP_MASK) >> 11) & 1) ? 2 : 1); ++r2_) if ((PH_MASK >> 11) & 1) for (int it = F.vcu; it < 256; it += F.G) hgrn_item(F, it, IN_F(12), IN_F(13));
        float lam;
        { float s1 = 0.f, s2 = 0.f; const float* q1 = IN_F(7); const float* k1 = IN_F(8); const float* q2 = IN_F(9); const float* k2 = IN_F(10);
          for (int i = 0; i < 64; ++i) { s1 += q1[i] * k1[i]; s2 += q2[i] * k2[i]; }
          lam = __expf(s1) - __expf(s2) + LAMBDA_INIT; }
        for (int r2_ = 0; r2_ < ((((DUP_MASK) >> 12) & 1) ? 2 : 1); ++r2_) if ((PH_MASK >> 12) & 1) for (int u = F.vcu; u < 512; u += F.G) attn_unit(F, u, lam, IN_F(11));
        if (BOTH(3)) GRID_BAR();
    }
    if (IN(4)) REPS(4) { hgrn_combine(F, IN_F(14)); if (BOTH(4)) GRID_BAR(); }
    if (IN(5)) REPS(5) {
#if I8_AB
        { pg8::Gemm g{(const bf16*)(F.ws + WS_OA8), (const bf16*)(F.ws + WS_WA), T, DM, 512}; pg8::StaticOrder S; S.init(T, DM, F.G, (int)blockIdx.x);
          pg8::EpiGate<false> E{(bf16*)(F.ws + WS_Y), (const bf16*)(F.ws + WS_GA), DM, (const float*)(F.ws + WS_SAO), (const float*)(F.ws + WS_SB) + CM_A / 256};
          pg8::gemm_phase<pg8::EpiGate<false>, pg8::StaticOrder, true, true, true>(F.lds + RING_OFF, g, S, E); }
        { pg8::Gemm g{(const bf16*)(F.ws + WS_OB), (const bf16*)(F.ws + WS_WB), T, DM, 512}; pg8::StaticOrder S; S.init(T, DM, F.G, (int)blockIdx.x);
          pg8::EpiGate<true> E{(bf16*)(F.ws + WS_Y), (const bf16*)(F.ws + WS_GB), DM, (const float*)(F.ws + WS_SAB), (const float*)(F.ws + WS_SB) + CM_B / 256};
          pg8::gemm_phase<pg8::EpiGate<true>, pg8::StaticOrder, true, true, true>(F.lds + RING_OFF, g, S, E); }
#else
        { pg8::Gemm g{(const bf16*)(F.ws + WS_OA), (const bf16*)(F.ws + WS_WA), T, DM, 1024}; pg8::StaticOrder S; S.init(T, DM, F.G, (int)blockIdx.x);
          pg8::EpiGate<false> E{(bf16*)(F.ws + WS_Y), (const bf16*)(F.ws + WS_GA), DM, nullptr, nullptr};
          pg8::gemm_phase<pg8::EpiGate<false>, pg8::StaticOrder, true, true>(F.lds + RING_OFF, g, S, E); }
        { pg8::Gemm g{(const bf16*)(F.ws + WS_OB), (const bf16*)(F.ws + WS_WB), T, DM, 1024}; pg8::StaticOrder S; S.init(T, DM, F.G, (int)blockIdx.x);
          pg8::EpiGate<true> E{(bf16*)(F.ws + WS_Y), (const bf16*)(F.ws + WS_GB), DM, nullptr, nullptr};
          pg8::gemm_phase<pg8::EpiGate<true>, pg8::StaticOrder, true, true>(F.lds + RING_OFF, g, S, E); }
#endif
#if I8_O
        GRID_BAR();
        quant_rows_bf16(F, (const bf16*)(F.ws + WS_Y), F.ws + WS_Y8, (float*)(F.ws + WS_SAY));
#endif
        if (BOTH(5)) GRID_BAR();
    }
    if (IN(6)) REPS(6) {
#if I8_O
        pg8::Gemm g{(const bf16*)(F.ws + WS_Y8), (const bf16*)(F.ws + WS_WOUT), T, DM, DM / 2}; pg8::StaticOrder S; S.init(T, DM, F.G, (int)blockIdx.x);
        pg8::EpiResGate E{x, F.out, ada + 2 * DM, DM, ADA_W, SEQ, (const float*)(F.ws + WS_SAY), (const float*)(F.ws + WS_SB) + CM_O / 256};
        pg8::gemm_phase<pg8::EpiResGate, pg8::StaticOrder, true, true, true>(F.lds + RING_OFF, g, S, E);
#else
        pg8::Gemm g{(const bf16*)(F.ws + WS_Y), (const bf16*)(F.ws + WS_WOUT), T, DM, DM}; pg8::StaticOrder S; S.init(T, DM, F.G, (int)blockIdx.x);
        pg8::EpiResGate E{x, F.out, ada + 2 * DM, DM, ADA_W, SEQ, nullptr, nullptr};
        pg8::gemm_phase<pg8::EpiResGate, pg8::StaticOrder, true, true>(F.lds + RING_OFF, g, S, E);
#endif
        if (BOTH(6)) GRID_BAR();
    }
    if (IN(7)) REPS(7) {
#if I8_Q
        mod_rows_i8<(PEER_UI4 != 0) ? 119 : 127>(F, F.out, IN_F(18), ada + 3 * DM, ada + 4 * DM, F.ws + WS_H2, (float*)(F.ws + WS_SA2));
#else
        mod_rows(F, F.out, IN_F(18), ada + 3 * DM, ada + 4 * DM, (bf16*)(F.ws + WS_H2));
#endif
        if (BOTH(7)) GRID_BAR();
    }
    if (IN(8)) REPS(8) {
#if I8_Q
        pg8::Gemm g{(const bf16*)(F.ws + WS_H2), (const bf16*)(F.ws + WS_WQ), T, DM, DM / 2}; pg8::StaticOrder S; S.init(T, DM, F.G, (int)blockIdx.x);
        pg8::EpiPlainS E{(bf16*)(F.ws + WS_QP), DM, (const float*)(F.ws + WS_SA2), (const float*)(F.ws + WS_SBC)};
        pg8::gemm_phase<pg8::EpiPlainS, pg8::StaticOrder, true, true, true>(F.lds + RING_OFF, g, S, E);
#else
        pg8::Gemm g{(const bf16*)(F.ws + WS_H2), (const bf16*)(F.ws + WS_WQ), T, DM, DM}; pg8::StaticOrder S; S.init(T, DM, F.G, (int)blockIdx.x);
        pg8::EpiPlain E{(bf16*)(F.ws + WS_QP), DM};
        pg8::gemm_phase<pg8::EpiPlain, pg8::StaticOrder, true, true>(F.lds + RING_OFF, g, S, E);
#endif
        if (BOTH(8)) GRID_BAR();
    }
    if (IN(9)) REPS(9) { for (int u = F.vcu; u < 512; u += F.G) peer_route_unit(F, u, IN_F(20), IN_F(21)); if (BOTH(9)) GRID_BAR(); }
    if (IN(10)) REPS(10) { peer_main(F, ada, IN_F(24), (N_LAUNCHES == 1) ? &bar : nullptr); }
#undef IN
#undef BOTH
#undef GRID_BAR
}

extern "C" void kernel_launch(void* const* d_in, const int* in_sizes, int n_in, void* d_out, int out_size, void* d_ws, size_t ws_size, hipStream_t stream) {
    static int grid = 0;
    if (grid == 0) {
        if (n_in != 25 || in_sizes[0] != T * DM || out_size != T * DM || ws_size < WS_END) {
            fprintf(stderr, "kernel_launch: shape/workspace mismatch: n_in %d in0 %d out %d ws %zu (need >= %zu)\n", n_in, n_in > 0 ? in_sizes[0] : -1, out_size, ws_size, (size_t)WS_END); grid = -1; return; }
        int dev = 0, cus = 0, per_cu = 0;
        if (hipGetDevice(&dev) != hipSuccess || hipDeviceGetAttribute(&cus, hipDeviceAttributeMultiprocessorCount, dev) != hipSuccess) { fprintf(stderr, "kernel_launch: device query failed\n"); grid = -1; return; }
        if (hipFuncSetAttribute((const void*)mk_fwd, hipFuncAttributeMaxDynamicSharedMemorySize, LDS_BYTES) != hipSuccess) { fprintf(stderr, "kernel_launch: hipFuncSetAttribute failed\n"); grid = -1; return; }
        if (hipOccupancyMaxActiveBlocksPerMultiprocessor(&per_cu, (const void*)mk_fwd, NWAVES * 64, LDS_BYTES) != hipSuccess || per_cu < 1) {
            fprintf(stderr, "kernel_launch: occupancy query reports %d workgroups per CU\n", per_cu); (void)hipGetLastError(); per_cu = 1; }
        grid = cus;
        if (grid != 256) { fprintf(stderr, "kernel_launch: built for a 256-CU device (got %d)\n", cus); grid = -1; return; }
    }
    if (grid < 0) return;
    if (hipMemsetAsync((char*)d_ws + WS_CTL, 0, CTL_ZERO_BYTES, stream) != hipSuccess) { fprintf(stderr, "kernel_launch: memset failed\n"); return; }
    Args a{};
    for (int i = 0; i < 25; ++i) a.in[i] = d_in[i];
    a.out = (float*)d_out; a.ws = (unsigned char*)d_ws;
    for (int li = 0; li < N_LAUNCHES; ++li) {
        a.ph_lo = (N_LAUNCHES == 1) ? 0 : li; a.ph_hi = (N_LAUNCHES == 1) ? N_PHASES : li + 1;
        hipLaunchKernelGGL(mk_fwd, dim3(grid), dim3(NWAVES * 64), LDS_BYTES, stream, a);
        const hipError_t le = hipPeekAtLastError();
        if (le != hipSuccess) { fprintf(stderr, "kernel_launch: launch %d failed: %s\n", li, hipGetErrorName(le)); break; }
    }
}
```

```cpp
#include <hip/hip_runtime.h>
#include <cstdio>
#include <cstdint>
namespace pg8 {
#define PG8_LAS __attribute__((address_space(3)))
typedef unsigned short bf16_t;
typedef short bf16x8 __attribute__((ext_vector_type(8)));
typedef float f32x4 __attribute__((ext_vector_type(4)));
typedef unsigned u32x4 __attribute__((ext_vector_type(4)));
constexpr int BM = 256, BK = 64, HALF = 128, HTB = HALF * BK * 2  , STAGE_BYTES = 8 * HTB, NXCD = 8, WGM = 8;

__host__ __device__ __forceinline__ int lds_byte(int r, int c) { const int st = (r >> 4) * 2 + (c >> 5), rr = r & 15, cc = c & 31, ob = rr * 64 + cc * 2; return st * 1024 + (ob ^ (((ob >> 9) & 1) << 5)); }
__host__ __device__ __forceinline__ void stage_rc(int b, int& R, int& C) { const int st = b / 1024, sb = b % 1024, swz = sb ^ (((sb >> 9) & 1) << 5); R = (st >> 1) * 16 + swz / 64; C = (st & 1) * 32 + (swz % 64) / 2; }
__host__ __device__ __forceinline__ int perm32(int rho) { const int n = rho >> 4, i = rho & 15; return 8 * (i >> 2) + 4 * n + (i & 3); }

struct Unit { int pm, pn; };
struct Gemm { const bf16_t* A; const bf16_t* Bt; int M, N, K; };

struct StaticOrder {
    int nM, nN, nwg, G, c;
    __host__ __device__ void init(int M, int N, int G_, int c_) { nM = M / BM; nN = N / BM; nwg = nM * nN; G = G_; c = c_; }
    __host__ __device__ bool next(int i, Unit& u) const {
        const long L = (long)i * G + c; if (L >= nwg) return false;
        int wgid = (int)L; { const int q = nwg / NXCD, r = nwg % NXCD, xcd = wgid % NXCD, off = wgid / NXCD; wgid = (xcd < r ? xcd * (q + 1) : r * (q + 1) + (xcd - r) * q) + off; }
        const int nig = WGM * nN, gid = wgid / nig, fm = gid * WGM, gsz = (nM - fm) < WGM ? (nM - fm) : WGM;
        u.pm = fm + ((wgid % nig) % gsz); u.pn = (wgid % nig) / gsz; return true;
    }
    __device__ __forceinline__ void a_ready(const Unit&) const {}
    __device__ __forceinline__ void done(const Unit&) const {}
};

__device__ __forceinline__ unsigned cvt_pk_bf16(float lo, float hi) { unsigned r; asm volatile("v_cvt_pk_bf16_f32 %0, %1, %2" : "=v"(r) : "v"(lo), "v"(hi)); return r; }
typedef float f32x2 __attribute__((ext_vector_type(2)));
__device__ __forceinline__ f32x2 gelu_pk(f32x2 v) {
    const f32x2 av = __builtin_elementwise_abs(v), d = av * 0.2316418882f + 1.0f;
    f32x2 t; t.x = __builtin_amdgcn_rcpf(d.x); t.y = __builtin_amdgcn_rcpf(d.y);
    f32x2 q = t * 0.5307027145f + (-0.7265760135f); q = q * t + 0.7107068705f; q = q * t + (-0.142248368f); q = q * t + 0.127414796f; q = q * t;
    const f32x2 s = (v * v) * (-0.72134752044f);
    f32x2 e; e.x = __builtin_amdgcn_exp2f(s.x); e.y = __builtin_amdgcn_exp2f(s.y);
    const f32x2 m = v * (q * e), r = v - m;
    f32x2 o; o.x = v.x < 0.f ? m.x : r.x; o.y = v.y < 0.f ? m.y : r.y; return o;
}


__device__ __forceinline__ float fsigmoid(float x) { return __builtin_amdgcn_rcpf(1.0f + __expf(-x)); }
__device__ __forceinline__ float bflo(unsigned u) { return __builtin_bit_cast(float, u << 16); }
__device__ __forceinline__ float bfhi(unsigned u) { return __builtin_bit_cast(float, u & 0xffff0000u); }
#ifndef FP4_CLIP
#define FP4_CLIP 1.0f
#endif
#ifndef TJOB_NT
#define TJOB_NT 0
#endif
#ifndef G1_NT
#define G1_NT 0
#endif
#ifndef PEER_U4
#define PEER_U4 1
#endif
#ifndef PEER_V4
#define PEER_V4 1
#endif
#ifndef F6_ORDER
#define F6_ORDER 0
#endif
#ifndef PEER_UI4
#define PEER_UI4 1
#endif
#ifndef UI4_STEP
#define UI4_STEP 0.35f
#endif
constexpr int PEER_ROWB_U = PEER_U4 ? 1024 : 1536, PEER_ROWB_V = PEER_V4 ? 1024 : 1536;
constexpr float QSCALE = 0.18033688011112042f;

struct EpiPlain {
    static constexpr bool PERM = true, AFTER_DRAIN = false;
    bf16_t* O; int ldc;
    __device__ __forceinline__ void operator()(const f32x4 (&acc)[2][2][4][2], const Unit& u, int wr, int wc, int fr, int fq) const {
        const int row0 = u.pm * BM + wr * 64 + fr, col0 = u.pn * BM + wc * 32 + 8 * fq;
#pragma unroll
        for (int ai = 0; ai < 2; ++ai)
#pragma unroll
            for (int m = 0; m < 4; ++m) { bf16_t* rowp = O + (size_t)(row0 + ai * HALF + m * 16) * ldc + col0;
#pragma unroll
                for (int bj = 0; bj < 2; ++bj) { const f32x4 v0 = acc[ai][bj][m][0], v1 = acc[ai][bj][m][1];
                    u32x4 w; w.x = cvt_pk_bf16(v0[0], v0[1]); w.y = cvt_pk_bf16(v0[2], v0[3]); w.z = cvt_pk_bf16(v1[0], v1[1]); w.w = cvt_pk_bf16(v1[2], v1[3]);
                    *(u32x4*)(rowp + bj * HALF) = w; } }
    }
};

constexpr size_t G1_MiB = 1u << 20, G1_O0 = 140 * G1_MiB, G1_O1 = 172 * G1_MiB, G1_O2 = 204 * G1_MiB, G1_O3 = 236 * G1_MiB, G1_O4 = 332 * G1_MiB, G1_O5 = 364 * G1_MiB, G1_O6 = 268 * G1_MiB, G1_O7 = 300 * G1_MiB, G1_O8 = 396 * G1_MiB, G1_O9 = 460 * G1_MiB;
struct EpiPlainS {
    static constexpr bool PERM = true, AFTER_DRAIN = false;
    bf16_t* O; int ldc; const float* sa; const float* sb;
    __device__ __forceinline__ void operator()(const f32x4 (&acc)[2][2][4][2], const Unit& u, int wr, int wc, int fr, int fq) const {
        const int row0 = u.pm * BM + wr * 64 + fr, col0 = u.pn * BM + wc * 32 + 8 * fq;
        float rsc[8]; f32x4 csc[2][2];
#pragma unroll
        for (int ai = 0; ai < 2; ++ai)
#pragma unroll
            for (int m = 0; m < 4; ++m) rsc[ai * 4 + m] = sa[row0 + ai * HALF + m * 16];
#pragma unroll
        for (int bj = 0; bj < 2; ++bj) { csc[bj][0] = *(const f32x4*)(sb + col0 + bj * HALF); csc[bj][1] = *(const f32x4*)(sb + col0 + bj * HALF + 4); }
#pragma unroll
        for (int ai = 0; ai < 2; ++ai)
#pragma unroll
            for (int m = 0; m < 4; ++m) { bf16_t* rowp = O + (size_t)(row0 + ai * HALF + m * 16) * ldc + col0;
#pragma unroll
                for (int bj = 0; bj < 2; ++bj) { const f32x4 v0 = acc[ai][bj][m][0] * csc[bj][0] * rsc[ai * 4 + m], v1 = acc[ai][bj][m][1] * csc[bj][1] * rsc[ai * 4 + m];
                    u32x4 w; w.x = cvt_pk_bf16(v0[0], v0[1]); w.y = cvt_pk_bf16(v0[2], v0[3]); w.z = cvt_pk_bf16(v1[0], v1[1]); w.w = cvt_pk_bf16(v1[2], v1[3]);
                    *(u32x4*)(rowp + bj * HALF) = w; } }
    }
};

template <int VAR  > struct EpiG1T {
    static constexpr bool PERM = true, AFTER_DRAIN = false;
    unsigned char* ws; const int* positions; const float* sa; const float* sb;
    const float* tsrc_u; const float* tsrc_v; unsigned char* tdst_u; unsigned char* tdst_v; float* tsc_u; float* tsc_v; mutable int cnt;
    __device__ __forceinline__ void operator()(const f32x4 (&acc)[2][2][4][2], const Unit& u, int wr, int wc, int fr, int fq) const {
        const bool tjob = (VAR == 0) && (cnt < 8);
        const int tlane = fq * 16 + fr, trow0 = cnt * 4096 + 2 * ((int)blockIdx.x * 8 + wr * 4 + wc);
        f32x4 tv[8];
#define G1_TLOAD(j_) do { const int r_ = trow0 + (j_); const float* rp_ = (r_ < 16384 ? tsrc_u + (size_t)r_ * 2048 : tsrc_v + (size_t)(r_ - 16384) * 2048); \
            int tl_ = tlane; asm volatile("" : "+v"(tl_));     \
            _Pragma("unroll") for (int q = 0; q < 8; ++q) tv[q] = *(const f32x4*)(rp_ + q * 256 + 4 * tl_); } while (0)
#define G1_TPROC(j_) do { const int r = trow0 + (j_); float am = 0.f; const bool isu = r < 16384; const bool f4 = isu ? (PEER_U4 != 0) : (PEER_V4 != 0); \
            _Pragma("unroll") for (int q = 0; q < 8; ++q) am = fmaxf(am, fmaxf(fmaxf(__builtin_fabsf(tv[q][0]), __builtin_fabsf(tv[q][1])), fmaxf(__builtin_fabsf(tv[q][2]), __builtin_fabsf(tv[q][3])))); \
            _Pragma("unroll") for (int o = 1; o < 64; o <<= 1) am = fmaxf(am, __shfl_xor(am, o)); \
            float sc = am > 0.f ? am * (f4 ? (FP4_CLIP / 6.0f) : (1.0f / 7.5f)) : 1.0f; \
            if (isu && (PEER_UI4 != 0)) { float ss = 0.f; \
                _Pragma("unroll") for (int q = 0; q < 8; ++q) ss += (tv[q][0] * tv[q][0] + tv[q][1] * tv[q][1]) + (tv[q][2] * tv[q][2] + tv[q][3] * tv[q][3]); \
                _Pragma("unroll") for (int o = 1; o < 64; o <<= 1) ss += __shfl_xor(ss, o); \
                sc = am > 0.f ? fminf(am * (1.0f / 7.0f), UI4_STEP * __builtin_sqrtf(ss * (1.0f / 2048.0f))) : 1.0f; } \
            const float inv = 1.0f / sc; \
            unsigned char* op = isu ? tdst_u + (size_t)r * PEER_ROWB_U : tdst_v + (size_t)(r - 16384) * PEER_ROWB_V; \
            int tlane_s = tlane; asm volatile("" : "+v"(tlane_s));     \
            if (isu && (PEER_UI4 != 0)) { unsigned w4[4];        \
                _Pragma("unroll") for (int d = 0; d < 4; ++d) { unsigned w = 0u; \
                    _Pragma("unroll") for (int c = 0; c < 4; ++c) { \
                        const unsigned n0 = __builtin_bit_cast(unsigned, __builtin_amdgcn_fmed3f(tv[2 * d][c] * inv, -7.0f, 7.0f) + 12582912.0f) & 15u; \
                        const unsigned n1 = __builtin_bit_cast(unsigned, __builtin_amdgcn_fmed3f(tv[2 * d + 1][c] * inv, -7.0f, 7.0f) + 12582912.0f) & 15u; \
                        w |= (n0 << (8 * c)) | (n1 << (8 * c + 4)); } \
                    w4[d] = w; } \
                *(u32x4*)(op + tlane_s * 16) = (u32x4){w4[0], w4[1], w4[2], w4[3]}; \
            } else if (f4) { unsigned w4[4]; \
                _Pragma("unroll") for (int d = 0; d < 4; ++d) { unsigned w = 0u; \
                    w = __builtin_amdgcn_cvt_scalef32_pk_fp4_f32(w, tv[2 * d][0] * inv, tv[2 * d][1] * inv, 1.0f, 0); w = __builtin_amdgcn_cvt_scalef32_pk_fp4_f32(w, tv[2 * d][2] * inv, tv[2 * d][3] * inv, 1.0f, 1); \
                    w = __builtin_amdgcn_cvt_scalef32_pk_fp4_f32(w, tv[2 * d + 1][0] * inv, tv[2 * d + 1][1] * inv, 1.0f, 2); w = __builtin_amdgcn_cvt_scalef32_pk_fp4_f32(w, tv[2 * d + 1][2] * inv, tv[2 * d + 1][3] * inv, 1.0f, 3); \
                    w4[d] = w; } \
                *(u32x4*)(op + tlane_s * 16) = (u32x4){w4[0], w4[1], w4[2], w4[3]}; \
            } else { typedef __bf16 bf16x32 __attribute__((ext_vector_type(32))); typedef int i32x6 __attribute__((ext_vector_type(6))); typedef unsigned u32x2 __attribute__((ext_vector_type(2))); bf16x32 b; \
                typedef float f32x16 __attribute__((ext_vector_type(16))); f32x16 x16, y16; i32x6 w6; \
                if (F6_ORDER == 2) { _Pragma("unroll") for (int q = 0; q < 8; ++q) { b[4 * q] = (__bf16)(tv[q][0] * inv); b[4 * q + 1] = (__bf16)(tv[q][1] * inv); b[4 * q + 2] = (__bf16)(tv[q][2] * inv); b[4 * q + 3] = (__bf16)(tv[q][3] * inv); } \
                    w6 = __builtin_amdgcn_cvt_scalef32_pk32_fp6_bf16(b, 1.0f); } else { \
                _Pragma("unroll") for (int q = 0; q < 4; ++q) { _Pragma("unroll") for (int c = 0; c < 4; ++c) { \
                    if (F6_ORDER == 0) { x16[4 * q + c] = tv[q][c] * inv; y16[4 * q + c] = tv[q + 4][c] * inv; } \
                    else { const int i0 = 4 * q + c, i1 = 16 + 4 * q + c;     \
                        if (i0 & 1) y16[i0 >> 1] = tv[q][c] * inv; else x16[i0 >> 1] = tv[q][c] * inv; \
                        if (i1 & 1) y16[i1 >> 1] = tv[q + 4][c] * inv; else x16[i1 >> 1] = tv[q + 4][c] * inv; } } } \
                w6 = __builtin_amdgcn_cvt_scalef32_2xpk16_fp6_f32(x16, y16, 1.0f); } \
                *(u32x4*)(op + tlane_s * 16) = (u32x4){(unsigned)w6[0], (unsigned)w6[1], (unsigned)w6[2], (unsigned)w6[3]}; \
                *(u32x2*)(op + 1024 + tlane_s * 8) = (u32x2){(unsigned)w6[4], (unsigned)w6[5]}; } \
            if (tlane == 0) { if (isu) tsc_u[r] = sc; else tsc_v[r - 16384] = sc; } } while (0)
        if (tjob) G1_TLOAD(0);
        const int pn = u.pn; int part, colt, ldc;
        if (pn < 32) { part = pn >> 2; colt = (pn & 3) * 256; ldc = 1024; } else { part = 8 + ((pn - 32) >> 3); colt = ((pn - 32) & 7) * 256; ldc = 2048; }
        const size_t off = part == 0 ? G1_O0 : part == 1 ? G1_O1 : part == 2 ? G1_O2 : part == 3 ? G1_O3 : part == 4 ? G1_O4 : part == 5 ? G1_O5 : part == 6 ? G1_O6 : part == 7 ? G1_O7 : part == 8 ? G1_O8 : G1_O9;
        bf16_t* base = (bf16_t*)(ws + off);
        const int row0 = u.pm * BM + wr * 64 + fr, col0 = colt + wc * 32 + 8 * fq;
        const int mode = (VAR == 1 || VAR == 3) ? 0 : ((part <= 1) ? 1 : ((part == 3 || part == 7) ? 2 : (part >= 8 ? 3 : 0)));
        const bool do_rope = (mode == 1) && ((wc & 1) == 0);
        const float qs = (part == 0) ? QSCALE : 1.0f;
        float rsc[8]; const float cs = sb[u.pn];
#pragma unroll
        for (int ai = 0; ai < 2; ++ai)
#pragma unroll
            for (int m = 0; m < 4; ++m) rsc[ai * 4 + m] = sa[row0 + ai * HALF + m * 16] * cs;
        const float fr8[8] = {0.15915494309189535f, 0.03086376340470123f, 0.005985185712713705f, 0.001160663641240061f, 0.00022507907903927653f, 4.364795279280289e-05f, 8.464330808241401e-06f, 1.6414262627950345e-06f};
#pragma unroll
        for (int ai = 0; ai < 2; ++ai) {
            if (ai == 1 && tjob) { G1_TPROC(0); G1_TLOAD(1); }
#pragma unroll
            for (int m = 0; m < 4; ++m) {
                const int row = row0 + ai * HALF + m * 16;
                bf16_t* rowp = base + (size_t)row * ldc + col0;
                const float posf = do_rope ? (float)positions[row] : 0.f;
#pragma unroll
                for (int bj = 0; bj < 2; ++bj) {
                    f32x4 v[2] = {acc[ai][bj][m][0] * rsc[ai * 4 + m], acc[ai][bj][m][1] * rsc[ai * 4 + m]};
                    if (mode == 1) {
                        if (do_rope) {
#pragma unroll
                            for (int n = 0; n < 2; ++n)
#pragma unroll
                                for (int i = 0; i < 4; ++i) { const float val = v[n][i]; const float p = __shfl_xor(val, 16);
                                    float rv = posf * fr8[4 * n + i]; rv = rv - __builtin_floorf(rv); const float c = __builtin_amdgcn_cosf(rv), s = __builtin_amdgcn_sinf(rv);
                                    v[n][i] = (fq == 0) ? (val * c - p * s) : ((fq == 1) ? (val * c + p * s) : val); }
                        }
                        v[0] = v[0] * qs; v[1] = v[1] * qs;
                    } else if (mode == 2) {
#pragma unroll
                        for (int n = 0; n < 2; ++n)
#pragma unroll
                            for (int i = 0; i < 4; ++i) v[n][i] = v[n][i] * fsigmoid(v[n][i]);
                    } else if (mode == 3) {
#pragma unroll
                        for (int n = 0; n < 2; ++n)
#pragma unroll
                            for (int i = 0; i < 4; ++i) v[n][i] = fsigmoid(v[n][i]);
                    }
                    u32x4 w; w.x = cvt_pk_bf16(v[0][0], v[0][1]); w.y = cvt_pk_bf16(v[0][2], v[0][3]); w.z = cvt_pk_bf16(v[1][0], v[1][1]); w.w = cvt_pk_bf16(v[1][2], v[1][3]);
                    if (VAR == 2) asm volatile("" :: "v"(w), "v"(rowp)); else if (VAR == 3) { const int l3 = fq * 16 + fr; *(u32x4*)(base + (size_t)(u.pm * BM + (wr * 4 + wc) * 32 + ((ai * 4 + m) * 2 + bj) * 2 + (l3 >> 5)) * ldc + colt + (l3 & 31) * 8) = w; } else *(u32x4*)(rowp + bj * HALF) = w;
                }
            }
        }
        if (tjob) G1_TPROC(1);
#ifdef PROBE_EPI_DRAIN
        asm volatile("s_waitcnt vmcnt(0)" ::: "memory");
#endif
#ifdef PROBE_TJOB2
        if (tjob) { G1_TLOAD(0); G1_TPROC(0); G1_TLOAD(1); G1_TPROC(1); }
#endif
#undef G1_TLOAD
#undef G1_TPROC
        ++cnt;
    }
};
typedef EpiG1T<0> EpiG1;
template <bool ADD> struct EpiGate {
    static constexpr bool PERM = true, AFTER_DRAIN = false;
    bf16_t* Y; const bf16_t* G; int ldc; const float* sa; const float* sb;
    __device__ __forceinline__ void operator()(const f32x4 (&acc)[2][2][4][2], const Unit& u, int wr, int wc, int fr, int fq) const {
        const int row0 = u.pm * BM + wr * 64 + fr, col0 = u.pn * BM + wc * 32 + 8 * fq;
        const float cs = sa ? sb[u.pn] : 1.0f;
#pragma unroll
        for (int ai = 0; ai < 2; ++ai) {
            u32x4 gq[4][2], yq[4][2]; float rsc[4];
#pragma unroll
            for (int m = 0; m < 4; ++m) { rsc[m] = sa ? sa[row0 + ai * HALF + m * 16] * cs : 1.0f;
#pragma unroll
                for (int bj = 0; bj < 2; ++bj) { const size_t ro = (size_t)(row0 + ai * HALF + m * 16) * ldc + col0 + bj * HALF;
                    gq[m][bj] = *(const u32x4*)(G + ro); if (ADD) yq[m][bj] = *(const u32x4*)(Y + ro); } }
#pragma unroll
            for (int m = 0; m < 4; ++m)
#pragma unroll
                for (int bj = 0; bj < 2; ++bj) { const size_t ro = (size_t)(row0 + ai * HALF + m * 16) * ldc + col0 + bj * HALF;
                    const f32x4 v0 = acc[ai][bj][m][0] * rsc[m], v1 = acc[ai][bj][m][1] * rsc[m]; const u32x4 g = gq[m][bj];
                    float r[8] = {v0[0] * bflo(g.x), v0[1] * bfhi(g.x), v0[2] * bflo(g.y), v0[3] * bfhi(g.y), v1[0] * bflo(g.z), v1[1] * bfhi(g.z), v1[2] * bflo(g.w), v1[3] * bfhi(g.w)};
                    if (ADD) { const u32x4 y = yq[m][bj];
                        r[0] += bflo(y.x); r[1] += bfhi(y.x); r[2] += bflo(y.y); r[3] += bfhi(y.y); r[4] += bflo(y.z); r[5] += bfhi(y.z); r[6] += bflo(y.w); r[7] += bfhi(y.w); }
                    u32x4 w; w.x = cvt_pk_bf16(r[0], r[1]); w.y = cvt_pk_bf16(r[2], r[3]); w.z = cvt_pk_bf16(r[4], r[5]); w.w = cvt_pk_bf16(r[6], r[7]);
                    *(u32x4*)(Y + ro) = w; }
        }
    }
};

struct EpiResGate {
    static constexpr bool PERM = false, AFTER_DRAIN = false;
    const float* base; float* out; const float* gate; int ldc; int gate_ld; int rows_per_batch; const float* sa; const float* sb;
    __device__ __forceinline__ void operator()(const f32x4 (&acc)[2][2][4][2], const Unit& u, int wr, int wc, int fr, int fq) const {
        const int row0 = u.pm * BM + wr * 64 + fr, col0 = u.pn * BM + wc * 32 + 4 * fq;
        const float* gp = gate + (size_t)((u.pm * BM) / rows_per_batch) * gate_ld + col0;
        const float cs = sa ? sb[u.pn] : 1.0f;
        f32x4 gv[2][2];
#pragma unroll
        for (int bj = 0; bj < 2; ++bj)
#pragma unroll
            for (int n = 0; n < 2; ++n) gv[bj][n] = *(const f32x4*)(gp + bj * HALF + n * 16) * cs;
#pragma unroll
        for (int ai = 0; ai < 2; ++ai)
#pragma unroll
            for (int mh = 0; mh < 2; ++mh) {
                f32x4 xb[2][2][2]; float rs[2];
#pragma unroll
                for (int ml = 0; ml < 2; ++ml) rs[ml] = sa ? sa[row0 + ai * HALF + (2 * mh + ml) * 16] : 1.0f;
#pragma unroll
                for (int ml = 0; ml < 2; ++ml)
#pragma unroll
                    for (int bj = 0; bj < 2; ++bj)
#pragma unroll
                        for (int n = 0; n < 2; ++n) xb[ml][bj][n] = *(const f32x4*)(base + (size_t)(row0 + ai * HALF + (2 * mh + ml) * 16) * ldc + col0 + bj * HALF + n * 16);
#pragma unroll
                for (int ml = 0; ml < 2; ++ml)
#pragma unroll
                    for (int bj = 0; bj < 2; ++bj)
#pragma unroll
                        for (int n = 0; n < 2; ++n) *(f32x4*)(out + (size_t)(row0 + ai * HALF + (2 * mh + ml) * 16) * ldc + col0 + bj * HALF + n * 16) = xb[ml][bj][n] + gv[bj][n] * (acc[ai][bj][2 * mh + ml][n] * rs[ml]);
            }
    }
};

struct EpiNull {
    static constexpr bool PERM = true, AFTER_DRAIN = false;
    __device__ __forceinline__ void operator()(const f32x4 (&acc)[2][2][4][2], const Unit& u, int wr, int wc, int fr, int fq) const {
#pragma unroll
        for (int ai = 0; ai < 2; ++ai)
#pragma unroll
            for (int bj = 0; bj < 2; ++bj)
#pragma unroll
                for (int m = 0; m < 4; ++m)
#pragma unroll
                    for (int n = 0; n < 2; ++n) asm volatile("" :: "v"(acc[ai][bj][m][n]));
    }
};
template <class Epi, class Sched, bool ALIGN_EPI = false, bool SP2 = false, bool I8 = false>
__device__ __forceinline__ void gemm_phase(PG8_LAS unsigned char* lds, const Gemm g, const Sched& S, const Epi& E) {
    int tid_ = threadIdx.x; asm volatile("" : "+v"(tid_));
    const int tid = tid_, wid = __builtin_amdgcn_readfirstlane(tid >> 6), lane = tid & 63, wr = wid >> 2, wc = wid & 3, fr = lane & 15, fq = lane >> 4;
    const int K = g.K, nt = K / BK;
    unsigned voffA[2], voffB[2];
#pragma unroll
    for (int i = 0; i < 2; ++i) { int R, C; stage_rc(tid * 16 + i * 8192, R, C); const int Rb = Epi::PERM ? ((R & ~31) + perm32(R & 31)) : R;
        voffA[i] = (unsigned)(R * K + C) * 2u; voffB[i] = (unsigned)(Rb * K + C) * 2u; }
    const size_t kstep = (size_t)(BK * 2);
    const size_t hstep = (size_t)HALF * K * 2;
    const size_t tstep = 2 * hstep;
    const unsigned ldsw = (unsigned)wid * 1024u;
    const int aoff = lds_byte(wr * 64 + fr, fq * 8), boff = lds_byte(wc * 32 + fr, fq * 8);
#define PG8_SA(b, h) (((b) * 2 + (h)) * HTB)
#define PG8_SB(b, h) ((4 + (b) * 2 + (h)) * HTB)
#define PG8_STAGE(bufoff, gbase, voff) do { _Pragma("unroll") for (int _i = 0; _i < 2; ++_i) \
        __builtin_amdgcn_global_load_lds((const unsigned*)((const char*)(gbase) + (voff)[_i]), (PG8_LAS unsigned*)(lds + (bufoff) + ldsw + _i * 8192), 16, 0, 0); } while (0)
#define PG8_LDA(dst, b, h) do { _Pragma("unroll") for (int m = 0; m < 4; ++m) _Pragma("unroll") for (int k = 0; k < 2; ++k) dst[m][k] = *(const PG8_LAS bf16x8*)(lds + PG8_SA(b, h) + aoff + m * 2048 + k * 1024); } while (0)
#define PG8_LDB(dst, b, h) do { _Pragma("unroll") for (int n = 0; n < 2; ++n) _Pragma("unroll") for (int k = 0; k < 2; ++k) dst[n][k] = *(const PG8_LAS bf16x8*)(lds + PG8_SB(b, h) + boff + n * 2048 + k * 1024); } while (0)
#define PG8_MMA(ai, bj, At, Bt) do { __builtin_amdgcn_s_setprio(1); _Pragma("unroll") for (int m = 0; m < 4; ++m) _Pragma("unroll") for (int n = 0; n < 2; ++n) _Pragma("unroll") for (int k = 0; k < 2; ++k) \
        { if constexpr (I8) acc[ai][bj][m][n] = __builtin_bit_cast(acc_t, __builtin_amdgcn_mfma_i32_16x16x64_i8(__builtin_bit_cast(i32x4_t, Bt[n][k]), __builtin_bit_cast(i32x4_t, At[m][k]), __builtin_bit_cast(i32x4_t, acc[ai][bj][m][n]), 0, 0, 0)); \
          else acc[ai][bj][m][n] = __builtin_bit_cast(acc_t, __builtin_amdgcn_mfma_f32_16x16x32_bf16(Bt[n][k], At[m][k], __builtin_bit_cast(f32x4, acc[ai][bj][m][n]), 0, 0, 0)); } __builtin_amdgcn_s_setprio(0); } while (0)
#define PG8_WAIT_V(n) asm volatile("s_waitcnt vmcnt(" #n ")" ::: "memory")
#define PG8_WAIT_L(n) asm volatile("s_waitcnt lgkmcnt(" #n ")" ::: "memory")
#define PG8_BAR __builtin_amdgcn_s_barrier()
#define PG8_SCHED __builtin_amdgcn_sched_barrier(0)
    Unit cur, nxt; int ui = 0;
    if (!S.next(0, cur)) return;
    typedef int i32x4_t __attribute__((ext_vector_type(4)));
    typedef f32x4 acc_t;
    acc_t acc[2][2][4][2];
#pragma unroll
    for (int a = 0; a < 2; ++a)
#pragma unroll
        for (int b = 0; b < 2; ++b)
#pragma unroll
            for (int m = 0; m < 4; ++m)
#pragma unroll
                for (int n = 0; n < 2; ++n) acc[a][b][m][n] = (f32x4){0.f, 0.f, 0.f, 0.f};
    bf16x8 At[4][2], B0[2][2], B1[2][2];
    const char* cA = (const char*)g.A + (size_t)cur.pm * tstep; const char* cB = (const char*)g.Bt + (size_t)cur.pn * tstep;
    S.a_ready(cur);
    if constexpr (SP2) {
        PG8_STAGE(PG8_SB(0, 0), cB, voffB); PG8_STAGE(PG8_SB(0, 1), cB + hstep, voffB); PG8_STAGE(PG8_SA(0, 0), cA, voffA); PG8_STAGE(PG8_SA(0, 1), cA + hstep, voffA);
        if (wr == 1) PG8_BAR;
        PG8_WAIT_V(2); PG8_BAR;
        PG8_STAGE(PG8_SB(1, 0), cB + kstep, voffB); PG8_STAGE(PG8_SA(1, 0), cA + kstep, voffA); PG8_STAGE(PG8_SB(1, 1), cB + hstep + kstep, voffB);
        PG8_WAIT_V(6); PG8_BAR;
    } else {
        PG8_STAGE(PG8_SB(0, 0), cB, voffB); PG8_STAGE(PG8_SA(0, 0), cA, voffA); PG8_STAGE(PG8_SB(0, 1), cB + hstep, voffB); PG8_STAGE(PG8_SA(0, 1), cA + hstep, voffA);
        if (wr == 1) PG8_BAR;
        PG8_WAIT_V(4); PG8_BAR;
        PG8_STAGE(PG8_SB(1, 0), cB + kstep, voffB); PG8_STAGE(PG8_SA(1, 0), cA + kstep, voffA); PG8_STAGE(PG8_SB(1, 1), cB + hstep + kstep, voffB);
        PG8_WAIT_V(6); PG8_BAR;
    }
    for (;;) {
        const bool has_next = S.next(ui + 1, nxt);
        const char* nA = has_next ? (const char*)g.A + (size_t)nxt.pm * tstep : cA; const char* nB = has_next ? (const char*)g.Bt + (size_t)nxt.pn * tstep : cB;
        for (int t = 0; t < nt; t += 2) {
            const bool last = (t == nt - 2);
            const char* a1 = cA + (size_t)(t + 1) * kstep;
            const char* a2 = last ? nA : cA + (size_t)(t + 2) * kstep; const char* b2 = last ? nB : cB + (size_t)(t + 2) * kstep;
            const char* a3 = a2 + kstep; const char* b3 = b2 + kstep;
            if (last && has_next) S.a_ready(nxt);
            if constexpr (SP2) {
            PG8_LDB(B0, 0, 0); PG8_LDB(B1, 0, 1); PG8_SCHED; PG8_LDA(At, 0, 0); PG8_STAGE(PG8_SA(1, 1), a1 + hstep, voffA);
            PG8_WAIT_V(8); PG8_WAIT_L(0); PG8_BAR; PG8_MMA(0, 0, At, B0); PG8_MMA(0, 1, At, B1); PG8_BAR; PG8_SCHED;
            PG8_LDA(At, 0, 1); PG8_STAGE(PG8_SB(0, 0), b2, voffB); PG8_STAGE(PG8_SB(0, 1), b2 + hstep, voffB); PG8_STAGE(PG8_SA(0, 0), a2, voffA);
            PG8_WAIT_V(8); PG8_WAIT_L(0); PG8_BAR; PG8_MMA(1, 0, At, B0); PG8_MMA(1, 1, At, B1); PG8_BAR; PG8_SCHED;
            PG8_LDB(B0, 1, 0); PG8_LDB(B1, 1, 1); PG8_SCHED; PG8_LDA(At, 1, 0); PG8_STAGE(PG8_SA(0, 1), a2 + hstep, voffA);
            PG8_WAIT_V(8); PG8_WAIT_L(0); PG8_BAR; PG8_MMA(0, 0, At, B0); PG8_MMA(0, 1, At, B1); PG8_BAR; PG8_SCHED;
            PG8_LDA(At, 1, 1); PG8_STAGE(PG8_SB(1, 0), b3, voffB); PG8_STAGE(PG8_SB(1, 1), b3 + hstep, voffB); PG8_STAGE(PG8_SA(1, 0), a3, voffA);
            PG8_WAIT_V(8); PG8_WAIT_L(0); PG8_BAR; PG8_MMA(1, 0, At, B0); PG8_MMA(1, 1, At, B1); PG8_BAR; PG8_SCHED;
            } else {
            PG8_LDB(B0, 0, 0); PG8_SCHED; PG8_LDA(At, 0, 0); PG8_STAGE(PG8_SA(1, 1), a1 + hstep, voffA);
            PG8_WAIT_L(8); PG8_BAR; PG8_WAIT_L(0); PG8_MMA(0, 0, At, B0); PG8_BAR; PG8_SCHED;
            PG8_LDB(B1, 0, 1); PG8_STAGE(PG8_SB(0, 0), b2, voffB);
            PG8_BAR; PG8_WAIT_L(0); PG8_MMA(0, 1, At, B1); PG8_BAR;
            PG8_LDA(At, 0, 1); PG8_STAGE(PG8_SA(0, 0), a2, voffA);
            PG8_BAR; PG8_WAIT_L(0); PG8_MMA(1, 0, At, B0); PG8_BAR; PG8_SCHED;
            PG8_STAGE(PG8_SB(0, 1), b2 + hstep, voffB);
            PG8_WAIT_V(6); PG8_BAR; PG8_MMA(1, 1, At, B1); PG8_BAR;
            PG8_LDB(B0, 1, 0); PG8_SCHED; PG8_LDA(At, 1, 0); PG8_STAGE(PG8_SA(0, 1), a2 + hstep, voffA);
            PG8_WAIT_L(8); PG8_BAR; PG8_WAIT_L(0); PG8_MMA(0, 0, At, B0); PG8_BAR; PG8_SCHED;
            PG8_LDB(B1, 1, 1); PG8_STAGE(PG8_SB(1, 0), b3, voffB);
            PG8_BAR; PG8_WAIT_L(0); PG8_MMA(0, 1, At, B1); PG8_BAR;
            PG8_LDA(At, 1, 1); PG8_STAGE(PG8_SA(1, 0), a3, voffA);
            PG8_BAR; PG8_WAIT_L(0); PG8_MMA(1, 0, At, B0); PG8_BAR; PG8_SCHED;
            PG8_STAGE(PG8_SB(1, 1), b3 + hstep, voffB);
            PG8_WAIT_V(6); PG8_BAR; PG8_MMA(1, 1, At, B1); PG8_BAR;
            }
        }
        if constexpr (ALIGN_EPI) { if (wr == 0) PG8_BAR; }
        if constexpr (I8) {
#pragma unroll
            for (int a = 0; a < 2; ++a)
#pragma unroll
                for (int b = 0; b < 2; ++b)
#pragma unroll
                    for (int m = 0; m < 4; ++m)
#pragma unroll
                        for (int n = 0; n < 2; ++n) acc[a][b][m][n] = __builtin_convertvector(__builtin_bit_cast(i32x4_t, acc[a][b][m][n]), f32x4);
        }
        if constexpr (!Epi::AFTER_DRAIN) { E(acc, cur, wr, wc, fr, fq); S.done(cur); }
        if (!has_next) break;
#pragma unroll
        for (int a = 0; a < 2; ++a)
#pragma unroll
            for (int b = 0; b < 2; ++b)
#pragma unroll
                for (int m = 0; m < 4; ++m)
#pragma unroll
                    for (int n = 0; n < 2; ++n) acc[a][b][m][n] = (f32x4){0.f, 0.f, 0.f, 0.f};
        cur = nxt; cA = nA; cB = nB; ++ui;
        if constexpr (ALIGN_EPI) { if (wr == 1) PG8_BAR; }
    }
    PG8_WAIT_V(0);
    if constexpr (!ALIGN_EPI) { if (wr == 0) PG8_BAR; }
    PG8_BAR;
    if constexpr (Epi::AFTER_DRAIN) { E.fused(acc, cur, wr, wc, fr, fq, lds, wid, lane); S.done(cur); }
#undef PG8_SA
#undef PG8_SB
#undef PG8_STAGE
#undef PG8_LDA
#undef PG8_LDB
#undef PG8_MMA
#undef PG8_WAIT_V
#undef PG8_WAIT_L
#undef PG8_BAR
#undef PG8_SCHED
}
}

#ifndef DUP_MASK
#define DUP_MASK 0
#endif
constexpr int NWAVES = 8;
#ifndef MK_N_LAUNCHES
#define MK_N_LAUNCHES 1
#endif
constexpr int N_PHASES = 11;
constexpr int N_LAUNCHES = MK_N_LAUNCHES;

constexpr int BATCH = 8, SEQ = 2048, DM = 2048, T = BATCH * SEQ;
constexpr int IN_W = 12288, ADA_W = 6 * DM;
constexpr float EPS = 1e-6f;
constexpr float LAMBDA_INIT = 0.2f;
constexpr float THRL = 11.541560327111707f;

constexpr size_t MiB = 1u << 20;
constexpr size_t WS_CTL = 0, CTL_ZERO_BYTES = 192 * 1024;
constexpr size_t WS_COLMAX = 64 * 1024;
constexpr int CM_IN = 0, CM_Q = 12288, CM_A = 14336, CM_B = 16384, CM_O = 18432, CM_END = 20480;
constexpr size_t WS_ADA = 256 * 1024;
constexpr size_t WS_SA = 1 * MiB, WS_SB = 1 * MiB + 128 * 1024;
constexpr size_t WS_SBC = 1 * MiB + 448 * 1024;
constexpr size_t WS_SA2 = 1 * MiB + 64 * 1024;
constexpr size_t WS_SAO = 1 * MiB + 256 * 1024, WS_SAB = 1 * MiB + 320 * 1024, WS_SAY = 1 * MiB + 384 * 1024;
constexpr size_t WS_WIN = 4 * MiB;
constexpr size_t WS_OA = WS_WIN, WS_OA8 = 36 * MiB;
constexpr size_t WS_WA = 52 * MiB, WS_WB = 56 * MiB, WS_WOUT = 60 * MiB, WS_WQ = 68 * MiB;
constexpr size_t WS_H = 76 * MiB;
constexpr size_t WS_OF = WS_H, WS_OBW = WS_H + 32 * MiB, WS_H2 = WS_H;
constexpr size_t WS_DAQ = 140 * MiB, WS_DAK = 172 * MiB, WS_DAV = 204 * MiB;
constexpr size_t WS_Y = WS_DAQ;
constexpr size_t WS_Y8 = WS_DAV;
constexpr size_t WS_OB = WS_DAV;
constexpr size_t WS_HGQ = 236 * MiB, WS_HGI = 268 * MiB, WS_HGG = 300 * MiB, WS_HFF = 332 * MiB, WS_HFB = 364 * MiB;
constexpr size_t WS_GA = 396 * MiB, WS_GB = 460 * MiB;
constexpr size_t WS_QP = WS_GA;
constexpr size_t WS_EIDX = WS_GB, WS_EG = WS_GB + 8 * MiB, WS_AP = WS_GB + 16 * MiB;
constexpr size_t WS_U8 = 524 * MiB, WS_V8 = 548 * MiB, WS_SCU = 572 * MiB, WS_SCV = 572 * MiB + 65536;
constexpr size_t WS_STASH = 588 * MiB;
constexpr size_t WS_END = 620 * MiB;

constexpr int CW_TMO = 0, CW_CODE = 1, CW_CHK = 2;
constexpr int CW_BAR = 1024;

constexpr int RING_OFF = 0, RING_BYTES = 131072;
constexpr int LDSCTL_OFF = RING_BYTES, MISC_OFF = LDSCTL_OFF + 320;
constexpr int LDS_BYTES = 147456;
static_assert(pg8::G1_O0 == WS_DAQ && pg8::G1_O1 == WS_DAK && pg8::G1_O2 == WS_DAV && pg8::G1_O3 == WS_HGQ && pg8::G1_O4 == WS_HFF && pg8::G1_O5 == WS_HFB && pg8::G1_O6 == WS_HGI && pg8::G1_O7 == WS_HGG && pg8::G1_O8 == WS_GA && pg8::G1_O9 == WS_GB, "G1 part offsets");
#define GAS __attribute__((address_space(1)))
#define LAS __attribute__((address_space(3)))
typedef unsigned short bf16;
typedef unsigned v4u __attribute__((ext_vector_type(4)));
typedef float f32x4 __attribute__((ext_vector_type(4)));
typedef short bf16x8 __attribute__((ext_vector_type(8)));
typedef GAS unsigned gu32;
typedef GAS unsigned long long gu64;
#define RLX_AGENT __ATOMIC_RELAXED, __HIP_MEMORY_SCOPE_AGENT
#define LDS_WAIT() asm volatile("s_waitcnt lgkmcnt(0)" ::: "memory")
#define VM_WAIT() asm volatile("s_waitcnt vmcnt(0)" ::: "memory")
__device__ __forceinline__ unsigned long long rt() { return __builtin_amdgcn_s_memrealtime(); }
__device__ __forceinline__ unsigned f2bf(float f) { unsigned u = __builtin_bit_cast(unsigned, f); return (u + 0x7fffu + ((u >> 16) & 1u)) >> 16; }
__device__ __forceinline__ unsigned pk2(float lo, float hi) { return f2bf(lo) | (f2bf(hi) << 16); }

#define XB_TMO      128
#define XB_XCNT(j)  (256  + 64 * (j))
#define XB_XSUB(j)  (1280 + 64 * (j))
#define XB_XGEN(j)  (2304 + 64 * (j))
#define XB_TOP      3328
#define XB_TOPGEN   3392
#define XCD_BAR_WORDS 3456
#define XB_SPIN_CAP (1u << 18)

__device__ __forceinline__ unsigned xb_ld(unsigned* p)              { return __hip_atomic_load(p, __ATOMIC_RELAXED, __HIP_MEMORY_SCOPE_AGENT); }
__device__ __forceinline__ unsigned xb_add(unsigned* p, unsigned v) { return __hip_atomic_fetch_add(p, v, __ATOMIC_RELAXED, __HIP_MEMORY_SCOPE_AGENT); }
__device__ __forceinline__ unsigned xb_xcc_id() { return (unsigned)__builtin_amdgcn_s_getreg((3 << 11) | 20) & 0xFu; }
#define XB_SPIN(cond, bar) do { unsigned _sp = 0; while (cond) { __builtin_amdgcn_s_sleep(1); \
    if ((++_sp & 255u) == 0u) { if (xb_ld(&(bar)[XB_TMO])) break; if (_sp > XB_SPIN_CAP) { atomicAdd(&(bar)[XB_TMO], 1u); break; } } } } while (0)

struct XcdBarrier {
    unsigned* bar; unsigned x;
    volatile LAS unsigned* st;
};

__device__ __forceinline__ XcdBarrier xcd_barrier_post(unsigned* bar, volatile LAS unsigned* st) {
    XcdBarrier b; b.bar = bar; b.x = xb_xcc_id(); b.st = st;
    if (threadIdx.x == 0) (void)xb_add(&bar[XB_XCNT(b.x)], 1u);
    return b;
}
__device__ __forceinline__ void xcd_barrier_complete(unsigned* bar, unsigned x, unsigned& nloc, unsigned& nx) {
    const unsigned G = gridDim.x * gridDim.y * gridDim.z;
    unsigned sum, cnt, mine, sp = 0u;
    for (;;) {
        sum = 0u; cnt = 0u; mine = 0u;
#pragma unroll
        for (unsigned j = 0; j < 16; ++j) { const unsigned c = xb_ld(&bar[XB_XCNT(j)]); sum += c; cnt += (c > 0u) ? 1u : 0u; mine = (j == x) ? c : mine; }
        if (sum == G) break;
        __builtin_amdgcn_s_sleep(1);
        if ((++sp & 255u) == 0u) { if (xb_ld(&bar[XB_TMO])) break; if (sp > XB_SPIN_CAP) { atomicAdd(&bar[XB_TMO], 1u); break; } }
    }
    nloc = mine > 0u ? mine : 1u; nx = cnt > 0u ? cnt : 1u;
}

__device__ __forceinline__ void xcd_barrier(const XcdBarrier& b) {
    asm volatile("s_waitcnt vmcnt(0)" ::: "memory");
    __syncthreads();
    if (threadIdx.x == 0) {
        unsigned* bar = b.bar;
        __builtin_amdgcn_s_waitcnt(0);
        unsigned nloc = b.st[0], nx = b.st[1];
        if (nloc == 0u) { xcd_barrier_complete(bar, b.x, nloc, nx); b.st[0] = nloc; b.st[1] = nx; }
        const unsigned old = xb_add(&bar[XB_XSUB(b.x)], 1u);
        const unsigned gen = old / nloc;
        if (old + 1u == (gen + 1u) * nloc) {
            __builtin_amdgcn_fence(__ATOMIC_RELEASE, "agent");
            asm volatile("s_waitcnt vmcnt(0)" ::: "memory");
            const unsigned og = xb_add(&bar[XB_TOP], 1u);
            const unsigned tg = og / nx;
            if (og + 1u == (tg + 1u) * nx) xb_add(&bar[XB_TOPGEN], 1u);
            else XB_SPIN(xb_ld(&bar[XB_TOPGEN]) == tg, bar);
            __builtin_amdgcn_fence(__ATOMIC_ACQUIRE, "agent");
            xb_add(&bar[XB_XGEN(b.x)], 1u);
            asm volatile("s_waitcnt vmcnt(0)" ::: "memory");
        } else {
            XB_SPIN(xb_ld(&bar[XB_XGEN(b.x)]) == gen, bar);
            __builtin_amdgcn_fence(__ATOMIC_ACQUIRE, "agent");
            asm volatile("s_waitcnt vmcnt(0)" ::: "memory");
        }
    }
    __syncthreads();
}

typedef float f32x16 __attribute__((ext_vector_type(16)));
typedef short s16x4 __attribute__((ext_vector_type(4)));
typedef __bf16 bf16x2v __attribute__((ext_vector_type(2)));
typedef float f32x2v __attribute__((ext_vector_type(2)));

struct Frame {
    LAS unsigned char* lds;
    unsigned char* ldsg;
    volatile LAS unsigned* MISC;
    gu32* ctl;
    int tid, lane, wave;
    int vcu, G;
    unsigned char* ws;
    float* out;
};
#define IN_F(k) ((const float*)args.in[k])

__device__ __forceinline__ float wave_sum(float v) {
#pragma unroll
    for (int o = 1; o < 64; o <<= 1) v += __shfl_xor(v, o);
    return v;
}
__device__ __forceinline__ float fsig(float x) { return __builtin_amdgcn_rcpf(1.0f + __expf(-x)); }
__device__ __forceinline__ float bf_lo(unsigned u) { return __builtin_bit_cast(float, u << 16); }
__device__ __forceinline__ float bf_hi(unsigned u) { return __builtin_bit_cast(float, u & 0xffff0000u); }
__device__ __forceinline__ unsigned cvtpk(float lo, float hi) { f32x2v v = {lo, hi}; bf16x2v b = __builtin_convertvector(v, bf16x2v); return __builtin_bit_cast(unsigned, b); }
__device__ __forceinline__ float dot2bf(unsigned a, unsigned b, float acc) { return __builtin_amdgcn_fdot2_f32_bf16(__builtin_bit_cast(bf16x2v, a), __builtin_bit_cast(bf16x2v, b), acc, false); }

struct TrItem { const float* W; bf16* WT; int K, N, k0, n0; int cm; int pc; };
__device__ __forceinline__ void tr_load(const TrItem& t, float (&r)[32], int lane) {
#pragma unroll
    for (int i = 0; i < 32; ++i) { const int kk = 2 * i + (lane >> 5); r[i] = t.W[(size_t)(t.k0 + kk) * t.N + t.n0 + (lane & 31)]; }
}
__device__ __forceinline__ void tr_proc(const TrItem& t, const float (&r)[32], LAS float* scr, int lane) {
#pragma unroll
    for (int i = 0; i < 32; ++i) { const int kk = 2 * i + (lane >> 5); scr[kk * 33 + (lane & 31)] = r[i]; }
    LDS_WAIT(); asm volatile("" ::: "memory");
    const int c = lane & 7;
#pragma unroll
    for (int j = 0; j < 4; ++j) { const int n = (lane >> 3) + 8 * j; const LAS float* s = scr + (8 * c) * 33 + n;
        v4u o; o.x = pk2(s[0 * 33], s[1 * 33]); o.y = pk2(s[2 * 33], s[3 * 33]); o.z = pk2(s[4 * 33], s[5 * 33]); o.w = pk2(s[6 * 33], s[7 * 33]);
        *(GAS v4u*)(t.WT + (size_t)(t.n0 + n) * t.K + t.k0 + 8 * c) = o; }
    LDS_WAIT(); asm volatile("" ::: "memory");
}
#define SAT8(v_) ((v_) < -127 ? -127 : ((v_) > 127 ? 127 : (v_)))
__device__ __forceinline__ void tr_proc_i8(const TrItem& t, const float (&r)[32], LAS float* scr, int lane, const unsigned* colmax, float* sb, float* sbc) {
#pragma unroll
    for (int i = 0; i < 32; ++i) { const int kk = 2 * i + (lane >> 5); scr[kk * 33 + (lane & 31)] = r[i]; }
    LDS_WAIT(); asm volatile("" ::: "memory");
    const int c = lane & 3;
    float tile_am;
    { const unsigned* cp = colmax + t.cm + (t.n0 & ~255) + 4 * lane; unsigned mx = cp[0] > cp[1] ? cp[0] : cp[1]; const unsigned m2 = cp[2] > cp[3] ? cp[2] : cp[3]; mx = mx > m2 ? mx : m2;
#pragma unroll
      for (int o = 1; o < 64; o <<= 1) { const unsigned ot = (unsigned)__shfl_xor((int)mx, o); mx = mx > ot ? mx : ot; }
      tile_am = __uint_as_float(mx); }
#pragma unroll
    for (int j = 0; j < 2; ++j) { const int n = (lane >> 2) + 16 * j; const LAS float* s = scr + (16 * c) * 33 + n;
        const float am = t.pc ? __uint_as_float(colmax[t.cm + t.n0 + n]) * 1.35f : tile_am; const float inv = am > 0.f ? 127.0f / am : 0.f;
        unsigned w[4];
#pragma unroll
        for (int q = 0; q < 4; ++q) { const int a0 = SAT8(__float2int_rn(s[(4 * q) * 33] * inv)), a1 = SAT8(__float2int_rn(s[(4 * q + 1) * 33] * inv)), a2 = SAT8(__float2int_rn(s[(4 * q + 2) * 33] * inv)), a3 = SAT8(__float2int_rn(s[(4 * q + 3) * 33] * inv));
            w[q] = (unsigned)(a0 & 255) | ((unsigned)(a1 & 255) << 8) | ((unsigned)(a2 & 255) << 16) | ((unsigned)a3 << 24); }
        *(GAS v4u*)((unsigned char*)t.WT + (size_t)(t.n0 + n) * t.K + t.k0 + 16 * c) = (v4u){w[0], w[1], w[2], w[3]};
        if (t.pc) { if (t.k0 == 0 && c == 0) sbc[t.n0 + n] = am * (1.0f / 127.0f); }
        else if (t.k0 == 0 && (t.n0 & 255) == 0 && lane == 0 && j == 0) sb[(t.cm + t.n0) >> 8] = am * (1.0f / 127.0f); }
    LDS_WAIT(); asm volatile("" ::: "memory");
}
#ifndef CM_STRIDE
#define CM_STRIDE 8
#endif
__device__ __forceinline__ void colmax_item(const float* W, int N, int item, int lane, unsigned* colmax) {
    const int nblk = N / 256, kb = item / nblk, nb = item % nblk;
    const float* p = W + (size_t)(64 * kb) * N + 256 * nb + 4 * lane;
    f32x4 mx = {0.f, 0.f, 0.f, 0.f};
#pragma unroll
    for (int i = 0; i < 64; i += CM_STRIDE) { const f32x4 v = *(const f32x4*)(p + (size_t)i * N); mx = __builtin_elementwise_max(mx, __builtin_elementwise_abs(v)); }
    unsigned* c = colmax + 256 * nb + 4 * lane;
    atomicMax(c, __float_as_uint(mx[0])); atomicMax(c + 1, __float_as_uint(mx[1])); atomicMax(c + 2, __float_as_uint(mx[2])); atomicMax(c + 3, __float_as_uint(mx[3]));
}
__device__ __forceinline__ void p0_ada_item(Frame& F, const float* c, const float* W, const float* bias, float* ada, int item) {
    const int n0 = item * 64, lane = F.lane, w = F.wave;
    float acc[8];
#pragma unroll
    for (int b = 0; b < 8; ++b) acc[b] = 0.f;
    float wa[16], wb[16];
    const float* Wp = W + (size_t)(256 * w) * ADA_W + n0 + lane;
#define ADA_LOAD(V, g_) do { _Pragma("unroll") for (int i = 0; i < 16; ++i) V[i] = Wp[(size_t)((g_) * 16 + i) * ADA_W]; } while (0)
#define ADA_FMA(V, gi_) do { _Pragma("unroll") for (int i = 0; i < 16; ++i) _Pragma("unroll") for (int b = 0; b < 8; ++b) { \
        const float s_ = __builtin_bit_cast(float, __builtin_amdgcn_readlane(__builtin_bit_cast(int, sc[b]), (gi_) * 16 + i)); acc[b] += s_ * V[i]; } } while (0)
    ADA_LOAD(wa, 0);
    for (int kb = 0; kb < 4; ++kb) {
        const int k0 = 256 * w + 64 * kb;
        float sc[8];
#pragma unroll
        for (int b = 0; b < 8; ++b) { const float cv = c[b * DM + k0 + lane]; sc[b] = cv * fsig(cv); }
        ADA_LOAD(wb, 4 * kb + 1); ADA_FMA(wa, 0);
        ADA_LOAD(wa, 4 * kb + 2); ADA_FMA(wb, 1);
        ADA_LOAD(wb, 4 * kb + 3); ADA_FMA(wa, 2);
        if (kb < 3) ADA_LOAD(wa, 4 * kb + 4);
        ADA_FMA(wb, 3);
    }
#undef ADA_LOAD
#undef ADA_FMA
    LAS float* red = (LAS float*)(F.lds + RING_OFF);
#pragma unroll
    for (int b = 0; b < 8; ++b) red[(w * 8 + b) * 64 + lane] = acc[b];
    __syncthreads();
    { const int b = F.tid >> 6, col = F.tid & 63; float s = 0.f;
#pragma unroll
      for (int ww = 0; ww < 8; ++ww) s += red[(ww * 8 + b) * 64 + col];
      ada[b * ADA_W + n0 + col] = s + bias[n0 + col]; }
    __syncthreads();
}
#ifndef I8_Q
#define I8_Q 1
#endif
#ifndef I8_AB
#define I8_AB 1
#endif
#ifndef I8_O
#define I8_O 1
#endif
template <int PART> __device__ __forceinline__ void p0_prologue(Frame& F, const float* c, const int* positions, const float* w_ada, const float* b_ada,
                                            const float* w_in, const float* w_ba, const float* w_bh, const float* w_out, const float* w_q) {
    float* ada = (float*)(F.ws + WS_ADA);
    unsigned* colmax = (unsigned*)(F.ws + WS_COLMAX); float* sb = (float*)(F.ws + WS_SB);
    const int gw = F.vcu * NWAVES + F.wave, NGW = F.G * NWAVES, lane = F.lane;
    if (PART == 0) {
        constexpr int C_IN = (DM / 64) * (IN_W / 256), C_Q = I8_Q ? (DM / 64) * (DM / 256) : 0, C_A = I8_AB ? (1024 / 64) * (DM / 256) : 0, C_O = I8_O ? (DM / 64) * (DM / 256) : 0;
        for (int it = gw; it < C_IN + C_Q + 2 * C_A + C_O; it += NGW) { int r = it;
            if (r < C_IN) { colmax_item(w_in, IN_W, r, lane, colmax + CM_IN); continue; } r -= C_IN;
            if (r < C_Q) { colmax_item(w_q, DM, r, lane, colmax + CM_Q); continue; } r -= C_Q;
            if (r < C_A) { colmax_item(w_ba, DM, r, lane, colmax + CM_A); continue; } r -= C_A;
            if (r < C_A) { colmax_item(w_bh, DM, r, lane, colmax + CM_B); continue; } r -= C_A;
            colmax_item(w_out, DM, r, lane, colmax + CM_O); }
        for (int it = F.vcu; it < ADA_W / 64; it += F.G) p0_ada_item(F, c, w_ada, b_ada, ada, it);
    }
    LAS float* scr = (LAS float*)(F.lds + RING_OFF + 16384 + F.wave * 12288);
    constexpr int I_IN = (DM / 64) * (IN_W / 32), I_B = (1024 / 64) * (DM / 32), I_O = (DM / 64) * (DM / 32);
    constexpr int I_BF = 2 * I_B + 2 * I_O, NITEMS = I_BF + I_IN;
    constexpr int N_EARLY_OK = (I8_AB ? 0 : 2 * I_B) + ((I8_AB || I8_O) ? 0 : I_O);
    constexpr int TR_EARLY = N_EARLY_OK < 64 * NWAVES * 4 ? N_EARLY_OK : 64 * NWAVES * 4;
    auto mk = [&](int it) { TrItem t; int r = it;
        if (r < I_B) { t.W = w_ba; t.WT = (bf16*)(F.ws + WS_WA); t.K = 1024; t.N = DM; t.cm = I8_AB ? CM_A : -1; t.pc = 0; }
        else if ((r -= I_B) < I_B) { t.W = w_bh; t.WT = (bf16*)(F.ws + WS_WB); t.K = 1024; t.N = DM; t.cm = I8_AB ? CM_B : -1; t.pc = 0; }
        else if ((r -= I_B) < I_O) { t.W = w_out; t.WT = (bf16*)(F.ws + WS_WOUT); t.K = DM; t.N = DM; t.cm = I8_O ? CM_O : -1; t.pc = 0; }
        else if ((r -= I_O) < I_O) { t.W = w_q; t.WT = (bf16*)(F.ws + WS_WQ); t.K = DM; t.N = DM; t.cm = I8_Q ? CM_Q : -1; t.pc = 1; }
        else { r -= I_O; t.W = w_in; t.WT = (bf16*)(F.ws + WS_WIN); t.K = DM; t.N = IN_W; t.cm = CM_IN; t.pc = 0; }
        const int nblk = t.N / 32; t.k0 = 64 * (r / nblk); t.n0 = 32 * (r % nblk); return t; };
    float ra[32], rb[32];
    int it, step, end;
    if (PART == 0) { if (F.vcu < ADA_W / 64) return; it = (F.vcu - ADA_W / 64) * NWAVES + F.wave; step = (F.G - ADA_W / 64) * NWAVES; end = TR_EARLY; }
    else { it = TR_EARLY + gw; step = NGW; end = NITEMS; }
#define TR_PROC(T_, R_, IT_) do { if ((T_).cm >= 0) tr_proc_i8(T_, R_, scr, lane, colmax, sb, (float*)(F.ws + WS_SBC)); else tr_proc(T_, R_, scr, lane); } while (0)
    if (it < end) { const TrItem t = mk(it); tr_load(t, ra, lane); }
    for (; it < end; it += 2 * step) {
        const TrItem ta = mk(it);
        if (it + step < end) { const TrItem tb = mk(it + step); tr_load(tb, rb, lane); }
        TR_PROC(ta, ra, it);
        if (it + step < end) { const TrItem tb = mk(it + step);
            if (it + 2 * step < end) { const TrItem tc = mk(it + 2 * step); tr_load(tc, ra, lane); }
            TR_PROC(tb, rb, it + step); }
    }
#undef TR_PROC
}

__device__ __forceinline__ void mod_rows(Frame& F, const float* X, const float* g, const float* shift, const float* scale, bf16* O) {
    const int gw = F.vcu * NWAVES + F.wave, NGW = F.G * NWAVES, lane = F.lane;
    f32x4 va[8], vb[8];
#define MR_LOAD(V, m_) do { const GAS f32x4* xr_ = (const GAS f32x4*)(X + (size_t)(m_) * DM) + lane; _Pragma("unroll") for (int j = 0; j < 8; ++j) V[j] = xr_[64 * j]; } while (0)
#define MR_PROC(V, m_) do { const int b_ = (m_) / SEQ; float s_ = 0.f; \
        _Pragma("unroll") for (int j = 0; j < 8; ++j) s_ += (V[j].x * V[j].x + V[j].y * V[j].y) + (V[j].z * V[j].z + V[j].w * V[j].w); \
        const float rstd_ = __builtin_amdgcn_rsqf(wave_sum(s_) * (1.0f / DM) + EPS); \
        GAS unsigned long long* o8_ = (GAS unsigned long long*)(O + (size_t)(m_) * DM) + lane; \
        _Pragma("unroll") for (int j = 0; j < 8; ++j) { const int col_ = (64 * j + lane) * 4; \
            const f32x4 gg_ = *(const f32x4*)(g + col_), sc_ = *(const f32x4*)(scale + (size_t)b_ * ADA_W + col_), sh_ = *(const f32x4*)(shift + (size_t)b_ * ADA_W + col_); \
            const f32x4 h_ = V[j] * rstd_ * gg_ * (sc_ + 1.0f) + sh_; \
            o8_[64 * j] = (unsigned long long)cvtpk(h_.x, h_.y) | ((unsigned long long)cvtpk(h_.z, h_.w) << 32); } } while (0)
    int m = gw;
    if (m < T) MR_LOAD(va, m);
    for (; m < T; m += 2 * NGW) {
        if (m + NGW < T) MR_LOAD(vb, m + NGW);
        MR_PROC(va, m);
        if (m + NGW < T) { if (m + 2 * NGW < T) MR_LOAD(va, m + 2 * NGW); MR_PROC(vb, m + NGW); }
    }
#undef MR_LOAD
#undef MR_PROC
}

template <int QMAX = 127> __device__ __forceinline__ void mod_rows_i8(Frame& F, const float* X, const float* g, const float* shift, const float* scale, unsigned char* O, float* sa) {
    const int gw = F.vcu * NWAVES + F.wave, NGW = F.G * NWAVES, lane = F.lane;
    f32x4 va[8], vb[8];
#define MR_LOAD(V, m_) do { const GAS f32x4* xr_ = (const GAS f32x4*)(X + (size_t)(m_) * DM) + lane; _Pragma("unroll") for (int j = 0; j < 8; ++j) V[j] = xr_[64 * j]; } while (0)
#define MR_PROC(V, m_) do { const int b_ = (m_) / SEQ; float s_ = 0.f; \
        _Pragma("unroll") for (int j = 0; j < 8; ++j) s_ += (V[j].x * V[j].x + V[j].y * V[j].y) + (V[j].z * V[j].z + V[j].w * V[j].w); \
        const float rstd_ = __builtin_amdgcn_rsqf(wave_sum(s_) * (1.0f / DM) + EPS); float am_ = 0.f; \
        _Pragma("unroll") for (int j = 0; j < 8; ++j) { const int col_ = (64 * j + lane) * 4; \
            const f32x4 gg_ = *(const f32x4*)(g + col_), sc_ = *(const f32x4*)(scale + (size_t)b_ * ADA_W + col_), sh_ = *(const f32x4*)(shift + (size_t)b_ * ADA_W + col_); \
            V[j] = V[j] * rstd_ * gg_ * (sc_ + 1.0f) + sh_; \
            am_ = fmaxf(am_, fmaxf(fmaxf(__builtin_fabsf(V[j].x), __builtin_fabsf(V[j].y)), fmaxf(__builtin_fabsf(V[j].z), __builtin_fabsf(V[j].w)))); } \
        _Pragma("unroll") for (int o = 1; o < 64; o <<= 1) am_ = fmaxf(am_, __shfl_xor(am_, o)); \
        const float inv_ = am_ > 0.f ? (float)QMAX / am_ : 0.f; \
        GAS unsigned* o4_ = (GAS unsigned*)(O + (size_t)(m_) * DM) + lane; \
        _Pragma("unroll") for (int j = 0; j < 8; ++j) { const int a0 = __float2int_rn(V[j].x * inv_), a1 = __float2int_rn(V[j].y * inv_), a2 = __float2int_rn(V[j].z * inv_), a3 = __float2int_rn(V[j].w * inv_); \
            o4_[64 * j] = (unsigned)(a0 & 255) | ((unsigned)(a1 & 255) << 8) | ((unsigned)(a2 & 255) << 16) | ((unsigned)a3 << 24); } \
        if (lane == 0) sa[m_] = am_ * (1.0f / (float)QMAX); } while (0)
    int m = gw;
    if (m < T) MR_LOAD(va, m);
    for (; m < T; m += 2 * NGW) {
        if (m + NGW < T) MR_LOAD(vb, m + NGW);
        MR_PROC(va, m);
        if (m + NGW < T) { if (m + 2 * NGW < T) MR_LOAD(va, m + 2 * NGW); MR_PROC(vb, m + NGW); }
    }
#undef MR_LOAD
#undef MR_PROC
}

__device__ __forceinline__ void quant_rows_bf16(Frame& F, const bf16* X, unsigned char* O, float* sa) {
    const int gw = F.vcu * NWAVES + F.wave, NGW = F.G * NWAVES, lane = F.lane;
    v4u va[4], vb[4];
#define QR_LOAD(V, m_) do { _Pragma("unroll") for (int j = 0; j < 4; ++j) V[j] = *(const v4u*)(X + (size_t)(m_) * DM + (j * 64 + lane) * 8); } while (0)
#define QR_PROC(V, m_) do { float f_[32]; float am_ = 0.f; \
        _Pragma("unroll") for (int j = 0; j < 4; ++j) { const unsigned w_[4] = {V[j].x, V[j].y, V[j].z, V[j].w}; \
            _Pragma("unroll") for (int q = 0; q < 4; ++q) { f_[8 * j + 2 * q] = bf_lo(w_[q]); f_[8 * j + 2 * q + 1] = bf_hi(w_[q]); am_ = fmaxf(am_, fmaxf(__builtin_fabsf(f_[8 * j + 2 * q]), __builtin_fabsf(f_[8 * j + 2 * q + 1]))); } } \
        _Pragma("unroll") for (int o = 1; o < 64; o <<= 1) am_ = fmaxf(am_, __shfl_xor(am_, o)); \
        const float inv_ = am_ > 0.f ? 127.0f / am_ : 0.f; \
        _Pragma("unroll") for (int j = 0; j < 4; ++j) { unsigned o_[2]; \
            _Pragma("unroll") for (int h = 0; h < 2; ++h) { const int a0 = __float2int_rn(f_[8 * j + 4 * h] * inv_), a1 = __float2int_rn(f_[8 * j + 4 * h + 1] * inv_), a2 = __float2int_rn(f_[8 * j + 4 * h + 2] * inv_), a3 = __float2int_rn(f_[8 * j + 4 * h + 3] * inv_); \
                o_[h] = (unsigned)(a0 & 255) | ((unsigned)(a1 & 255) << 8) | ((unsigned)(a2 & 255) << 16) | ((unsigned)a3 << 24); } \
            *(unsigned long long*)(O + (size_t)(m_) * DM + (j * 64 + lane) * 8) = (unsigned long long)o_[0] | ((unsigned long long)o_[1] << 32); } \
        if (lane == 0) sa[m_] = am_ * (1.0f / 127.0f); } while (0)
    int m = gw;
    if (m < T) QR_LOAD(va, m);
    for (; m < T; m += 2 * NGW) {
        if (m + NGW < T) QR_LOAD(vb, m + NGW);
        QR_PROC(va, m);
        if (m + NGW < T) { if (m + 2 * NGW < T) QR_LOAD(va, m + 2 * NGW); QR_PROC(vb, m + NGW); }
    }
#undef QR_LOAD
#undef QR_PROC
}

namespace hg {
constexpr int LQ = 272, LV = 144;
constexpr int O_QI = 0, O_KI = 17408, O_QB = 34816, O_KDT = 52224, O_VT = 70656, O_AM = 79872, O_ST = 89088, O_PART = 106496, O_A = 110592, O_END = 111104;
typedef short bf16x8 __attribute__((ext_vector_type(8)));
typedef float f32x4 __attribute__((ext_vector_type(4)));
__device__ __forceinline__ bf16x8 ldfrag(const LAS unsigned char* p) { return *(const LAS bf16x8*)p; }
}
__device__ __forceinline__ void hgrn_item(Frame& F, int item, const float* lb_fwd, const float* lb_bwd) {
    using namespace hg;
    const int b = item >> 5, h = (item >> 2) & 7, dir = (item >> 1) & 1, vh = item & 1;
    LAS unsigned char* L = F.lds + RING_OFF;
    const int tid = F.tid, lane = F.lane, w = F.wave;
    const int d0 = 2 * lane;
    float lb[2];
    { const float* tbl = dir ? lb_bwd : lb_fwd;
#pragma unroll
      for (int i = 0; i < 2; ++i) { const float t0 = tbl[h * 128 + d0 + i], t1 = tbl[1024 + h * 128 + d0 + i]; lb[i] = 1.0f / (1.0f + __expf(t0 - t1)); } }
    f32x4 st[4];
#pragma unroll
    for (int i = 0; i < 4; ++i) st[i] = (f32x4){0.f, 0.f, 0.f, 0.f};
    for (int i = tid; i < 17408 / 4; i += 512) ((LAS unsigned*)(L + O_ST))[i] = 0u;
    const size_t rowbase = (size_t)b * SEQ;
    const bf16* Qg = (const bf16*)(F.ws + WS_HGQ) + rowbase * 1024 + h * 128 + d0;
    const bf16* Fg = (const bf16*)(F.ws + (dir ? WS_HFB : WS_HFF)) + rowbase * 1024 + h * 128 + d0;
    const int vp = tid & 31, pg = (tid >> 5) & 7;
    const bf16* Vg = (const bf16*)(F.ws + WS_HGI) + rowbase * 1024 + h * 128 + vh * 64 + 2 * vp;
    bf16* Og = (bf16*)(F.ws + (dir ? WS_OBW : WS_OF)) + rowbase * 1024 + h * 128 + vh * 64;
    unsigned qrawA[8], frawA[8], vrawA[8], qrawB[8], frawB[8], vrawB[8];
#define HG_LOAD(QR, FR, VR, ch) do { const size_t t0_ = (size_t)(ch) * 64; \
        _Pragma("unroll") for (int p = 0; p < 8; ++p) { QR[p] = *(const unsigned*)(Qg + (t0_ + 8 * w + p) * 1024); FR[p] = *(const unsigned*)(Fg + (t0_ + 8 * w + p) * 1024); } \
        if (tid < 256) { _Pragma("unroll") for (int p = 0; p < 8; ++p) VR[p] = *(const unsigned*)(Vg + (t0_ + 8 * pg + p) * 1024); } } while (0)
    HG_LOAD(qrawA, frawA, vrawA, dir ? 31 : 0);
    HG_LOAD(qrawB, frawB, vrawB, dir ? 30 : 1);
    __syncthreads();
    const int tb = w >> 1, hf = w & 1, l15 = lane & 15, l4 = lane >> 4;
    auto step = [&](const int c, unsigned (&qraw)[8], unsigned (&fraw)[8], unsigned (&vraw)[8]) __attribute__((always_inline)) {
        const int ch = dir ? 31 - c : c;
        float lf[8][2], kk[8][2], qq[8][2];
#pragma unroll
        for (int p = 0; p < 8; ++p) {
#pragma unroll
            for (int i = 0; i < 2; ++i) { const float x = i ? bf_hi(fraw[p]) : bf_lo(fraw[p]); const float sg = __builtin_amdgcn_rcpf(1.0f + __builtin_amdgcn_exp2f(x * -1.4426950408889634f)); const float f = lb[i] + (1.0f - lb[i]) * sg;
                lf[p][i] = __builtin_amdgcn_logf(f);     kk[p][i] = 1.0f - f; qq[p][i] = i ? bf_hi(qraw[p]) : bf_lo(qraw[p]); } }
        float bl[8][2], tot[2];
#pragma unroll
        for (int i = 0; i < 2; ++i) { float run = 0.f;
            if (!dir) {
#pragma unroll
                for (int p = 0; p < 8; ++p) { run += lf[p][i]; bl[p][i] = run; }
            } else {
#pragma unroll
                for (int p = 7; p >= 0; --p) { run += lf[p][i]; bl[p][i] = run; }
            }
            tot[i] = run; }
        { LAS float* part = (LAS float*)(L + O_PART); *(LAS f32x2v*)(part + w * 128 + d0) = (f32x2v){tot[0], tot[1]}; }
        __syncthreads();
        float offs[2] = {0.f, 0.f}, rr[2] = {0.f, 0.f}, bt[2] = {0.f, 0.f};
        { const LAS float* part = (const LAS float*)(L + O_PART);
#pragma unroll
          for (int w2 = 0; w2 < 8; ++w2) { const f32x2v pv = *(const LAS f32x2v*)(part + w2 * 128 + d0);
              const bool before = dir ? (w2 > w) : (w2 < w); const bool inr = dir ? (w2 >= 4) : (w2 < 4);
#pragma unroll
              for (int i = 0; i < 2; ++i) { bt[i] += pv[i]; offs[i] += before ? pv[i] : 0.f; rr[i] += inr ? pv[i] : 0.f; } } }
        float er[2], el[2];
#pragma unroll
        for (int i = 0; i < 2; ++i) { er[i] = __builtin_amdgcn_exp2f(rr[i]); el[i] = __builtin_amdgcn_exp2f(bt[i] - rr[i]); }
        if (w == 0) { LAS float* aa = (LAS float*)(L + O_A); *(LAS f32x2v*)(aa + d0) = (f32x2v){__builtin_amdgcn_exp2f(bt[0]), __builtin_amdgcn_exp2f(bt[1])}; }
        unsigned kdp[2][4];
#pragma unroll
        for (int p = 0; p < 8; ++p) {
            float qi[2], ki[2], qb[2], kd[2];
#pragma unroll
            for (int i = 0; i < 2; ++i) { const float bb = bl[p][i] + offs[i]; const float e1 = __builtin_amdgcn_exp2f(bb - rr[i]), e2 = __builtin_amdgcn_exp2f(rr[i] - bb);
                qi[i] = qq[p][i] * e1; ki[i] = kk[p][i] * e2; qb[i] = qi[i] * er[i]; kd[i] = ki[i] * el[i]; }
            const int pos = 8 * w + p;
            *(LAS unsigned*)(L + O_QI + pos * LQ + d0 * 2) = cvtpk(qi[0], qi[1]);
            *(LAS unsigned*)(L + O_KI + pos * LQ + d0 * 2) = cvtpk(ki[0], ki[1]);
            *(LAS unsigned*)(L + O_QB + pos * LQ + d0 * 2) = cvtpk(qb[0], qb[1]);
            if (p & 1) { kdp[0][p >> 1] = (kdp[0][p >> 1] & 0xffffu) | (cvtpk(0.f, kd[0]) & 0xffff0000u); kdp[1][p >> 1] = (kdp[1][p >> 1] & 0xffffu) | (cvtpk(0.f, kd[1]) & 0xffff0000u); }
            else { kdp[0][p >> 1] = cvtpk(kd[0], 0.f) & 0xffffu; kdp[1][p >> 1] = cvtpk(kd[1], 0.f) & 0xffffu; }
        }
#pragma unroll
        for (int i = 0; i < 2; ++i) *(LAS v4u*)(L + O_KDT + (d0 + i) * LV + (8 * w) * 2) = (v4u){kdp[i][0], kdp[i][1], kdp[i][2], kdp[i][3]};
        if (tid < 256) {
            unsigned v0[4], v1[4];
#pragma unroll
            for (int p = 0; p < 8; p += 2) { v0[p >> 1] = (vraw[p] & 0xffffu) | (vraw[p + 1] << 16); v1[p >> 1] = (vraw[p] >> 16) | (vraw[p + 1] & 0xffff0000u); }
            *(LAS v4u*)(L + O_VT + (2 * vp) * LV + (8 * pg) * 2) = (v4u){v0[0], v0[1], v0[2], v0[3]};
            *(LAS v4u*)(L + O_VT + (2 * vp + 1) * LV + (8 * pg) * 2) = (v4u){v1[0], v1[1], v1[2], v1[3]};
        }
        if (c + 2 < 32) HG_LOAD(qraw, fraw, vraw, dir ? 29 - c : c + 2);
        __syncthreads();
        f32x4 ao[2], au[4];
#pragma unroll
        for (int sbi = 0; sbi < 2; ++sbi) {
            const int sb = 2 * hf + sbi; f32x4 a = (f32x4){0.f, 0.f, 0.f, 0.f};
#pragma unroll
            for (int ks = 0; ks < 4; ++ks) a = __builtin_amdgcn_mfma_f32_16x16x32_bf16(ldfrag(L + O_KI + (16 * sb + l15) * LQ + ks * 64 + l4 * 16), ldfrag(L + O_QI + (16 * tb + l15) * LQ + ks * 64 + l4 * 16), a, 0, 0, 0);
            const int tt = 16 * tb + l15, s0 = 16 * sb + 4 * l4;
            float m[4];
#pragma unroll
            for (int r = 0; r < 4; ++r) { const int ss = s0 + r; const bool keep = dir ? (ss >= tt) : (ss <= tt); m[r] = keep ? a[r] : 0.f; }
            *(LAS unsigned long long*)(L + O_AM + tt * LV + s0 * 2) = (unsigned long long)cvtpk(m[0], m[1]) | ((unsigned long long)cvtpk(m[2], m[3]) << 32);
        }
#pragma unroll
        for (int vbi = 0; vbi < 2; ++vbi) {
            const int vb = 2 * hf + vbi; f32x4 a = (f32x4){0.f, 0.f, 0.f, 0.f};
#pragma unroll
            for (int ks = 0; ks < 4; ++ks) a = __builtin_amdgcn_mfma_f32_16x16x32_bf16(ldfrag(L + O_ST + (16 * vb + l15) * LQ + ks * 64 + l4 * 16), ldfrag(L + O_QB + (16 * tb + l15) * LQ + ks * 64 + l4 * 16), a, 0, 0, 0);
            ao[vbi] = a;
        }
#pragma unroll
        for (int vb = 0; vb < 4; ++vb) {
            f32x4 a = (f32x4){0.f, 0.f, 0.f, 0.f};
#pragma unroll
            for (int ks = 0; ks < 2; ++ks) a = __builtin_amdgcn_mfma_f32_16x16x32_bf16(ldfrag(L + O_KDT + (16 * w + l15) * LV + ks * 64 + l4 * 16), ldfrag(L + O_VT + (16 * vb + l15) * LV + ks * 64 + l4 * 16), a, 0, 0, 0);
            au[vb] = a;
        }
        __syncthreads();
#pragma unroll
        for (int vbi = 0; vbi < 2; ++vbi) {
            const int vb = 2 * hf + vbi; f32x4 a = ao[vbi];
#pragma unroll
            for (int ks = 0; ks < 2; ++ks) a = __builtin_amdgcn_mfma_f32_16x16x32_bf16(ldfrag(L + O_VT + (16 * vb + l15) * LV + ks * 64 + l4 * 16), ldfrag(L + O_AM + (16 * tb + l15) * LV + ks * 64 + l4 * 16), a, 0, 0, 0);
            *(unsigned long long*)(Og + ((size_t)ch * 64 + 16 * tb + l15) * 1024 + 16 * vb + 4 * l4) = (unsigned long long)cvtpk(a[0], a[1]) | ((unsigned long long)cvtpk(a[2], a[3]) << 32);
        }
        { const f32x4 av = *(const LAS f32x4*)(L + O_A + (16 * w + 4 * l4) * 4);
#pragma unroll
          for (int vb = 0; vb < 4; ++vb) { st[vb] = av * st[vb] + au[vb];
              *(LAS unsigned long long*)(L + O_ST + (16 * vb + l15) * LQ + (16 * w + 4 * l4) * 2) = (unsigned long long)cvtpk(st[vb][0], st[vb][1]) | ((unsigned long long)cvtpk(st[vb][2], st[vb][3]) << 32); } }
    };
#pragma unroll 1
    for (int c = 0; c < 32; c += 2) { step(c, qrawA, frawA, vrawA); step(c + 1, qrawB, frawB, vrawB); }
    __syncthreads();
#undef HG_LOAD
}


namespace at {
typedef short bf16x8 __attribute__((ext_vector_type(8)));
constexpr int SHM_V = 16384, SHM_K = 8192, O_V = 0, O_K = 32768, O_WS = 49152, LDK = 1024;
#define AT_SBAR() __builtin_amdgcn_sched_barrier(0)
#define KSWZ64(row, ch) ((row) * 128 + ((((ch) ^ (((row) >> 1) & 7))) << 4))
__device__ __forceinline__ int crow(int r, int hi) { return (r & 3) + 8 * (r >> 2) + 4 * hi; }
__device__ __forceinline__ void partialSM(f32x16& p0, f32x16& p1, float& m_reg, float& mn, float& alpha) {
  float pmax = p0[0];
#pragma unroll
  for (int r = 1; r < 16; ++r) pmax = fmaxf(pmax, p0[r]);
#pragma unroll
  for (int r = 0; r < 16; ++r) pmax = fmaxf(pmax, p1[r]);
  { auto rr = __builtin_amdgcn_permlane32_swap(__float_as_uint(pmax), __float_as_uint(pmax), false, false);
    pmax = fmaxf(__uint_as_float(rr[0]), __uint_as_float(rr[1])); }
  if (__builtin_expect(__all(pmax - m_reg <= THRL), 1)) { mn = m_reg; alpha = 1.f; }
  else { mn = fmaxf(m_reg, pmax); alpha = __builtin_amdgcn_exp2f(m_reg - mn); m_reg = mn; }
#pragma unroll
  for (int r = 0; r < 16; ++r) p0[r] = p0[r] - mn;
#pragma unroll
  for (int r = 0; r < 16; ++r) p1[r] = p1[r] - mn;
#pragma unroll
  for (int r = 0; r < 16; ++r) p0[r] = __builtin_amdgcn_exp2f(p0[r]);
}
__device__ __forceinline__ void partialSM_rel(f32x16& p0, f32x16& p1, float& m_reg, float& alpha) {
  float pmax = p0[0];
#pragma unroll
  for (int r = 1; r < 16; ++r) pmax = fmaxf(pmax, p0[r]);
#pragma unroll
  for (int r = 0; r < 16; ++r) pmax = fmaxf(pmax, p1[r]);
  { auto rr = __builtin_amdgcn_permlane32_swap(__float_as_uint(pmax), __float_as_uint(pmax), false, false);
    pmax = fmaxf(__uint_as_float(rr[0]), __uint_as_float(rr[1])); }
  if (__builtin_expect(__all(pmax <= THRL), 1)) { alpha = 1.f; }
  else { const float d = fmaxf(pmax, 0.f); alpha = __builtin_amdgcn_exp2f(-d); m_reg += d;
#pragma unroll
    for (int r = 0; r < 16; ++r) { p0[r] -= d; p1[r] -= d; } }
#pragma unroll
  for (int r = 0; r < 16; ++r) p0[r] = __builtin_amdgcn_exp2f(p0[r]);
}
__device__ __forceinline__ void finishSM(f32x16& p0, f32x16& p1, float alpha, float& l_reg, bf16x8& pa0, bf16x8& pa1, bf16x8& pa2, bf16x8& pa3) {
#pragma unroll
  for (int r = 0; r < 16; ++r) p1[r] = __builtin_amdgcn_exp2f(p1[r]);
  float ps = 0;
#pragma unroll
  for (int r = 0; r < 16; ++r) ps += p0[r];
#pragma unroll
  for (int r = 0; r < 16; ++r) ps += p1[r];
  { auto rr = __builtin_amdgcn_permlane32_swap(__float_as_uint(ps), __float_as_uint(ps), false, false);
    ps = __uint_as_float(rr[0]) + __uint_as_float(rr[1]); }
  l_reg = l_reg * alpha + ps;
#define AT_PK4(P, BASE, OUT) do { unsigned a0 = cvtpk(P[BASE + 0], P[BASE + 1]), a1 = cvtpk(P[BASE + 2], P[BASE + 3]);   \
    unsigned b0 = cvtpk(P[BASE + 4], P[BASE + 5]), b1 = cvtpk(P[BASE + 6], P[BASE + 7]);                              \
    auto r0 = __builtin_amdgcn_permlane32_swap(a0, b0, false, false); auto r1 = __builtin_amdgcn_permlane32_swap(a1, b1, false, false); \
    v4u w_ = {r0[0], r1[0], r0[1], r1[1]}; OUT = __builtin_bit_cast(bf16x8, w_); } while (0)
  AT_PK4(p0, 0, pa0); AT_PK4(p0, 8, pa1); AT_PK4(p1, 0, pa2); AT_PK4(p1, 8, pa3);
#undef AT_PK4
}
__device__ __forceinline__ void qkt(f32x16& p0, f32x16& p1, const char* Ks, const bf16x8* qr, int r32, int hi, const float init = 0.f) {
#pragma unroll
  for (int r = 0; r < 16; ++r) { p0[r] = init; p1[r] = init; }
#pragma unroll
  for (int d0 = 0; d0 < 4; ++d0) { const int ch = d0 * 2 + hi;
    bf16x8 b0 = *reinterpret_cast<const bf16x8*>(Ks + KSWZ64(r32, ch));
    bf16x8 b1 = *reinterpret_cast<const bf16x8*>(Ks + 4096 + KSWZ64(r32, ch));
    p0 = __builtin_amdgcn_mfma_f32_32x32x16_bf16(b0, qr[d0], p0, 0, 0, 0);
    p1 = __builtin_amdgcn_mfma_f32_32x32x16_bf16(b1, qr[d0], p1, 0, 0, 0); }
}
__device__ __forceinline__ int v_st(int k, int c) { const int kk = (k & ~0xC) | ((k & 4) << 1) | ((k & 8) >> 1); return ((kk >> 3) * 4 + (c >> 5)) * 512 + ((kk & 7) * 32 + (c & 31)) * 2; }
__device__ __forceinline__ int v_rd_base(int lane) { return ((lane & 3) << 3) | (((lane >> 2) & 3) << 6) | (((lane >> 4) & 1) << 5) | (((lane >> 5) & 1) << 8); }
constexpr int v_rd_off(int d0, int ks, int half) { return d0 * 512 + ks * 4096 + half * 2048; }
template <int OFF> __device__ __forceinline__ s16x4 tr_read(int vb) {
  s16x4 r; asm volatile("ds_read_b64_tr_b16 %0, %1 offset:%2" : "=&v"(r) : "v"(vb), "i"(OFF) : "memory"); return r;
}
template <int D0> __device__ __forceinline__ void pv_one(f32x16& od, int vb, bf16x8 pa0, bf16x8 pa1, bf16x8 pa2, bf16x8 pa3) {
  const s16x4 l0 = tr_read<v_rd_off(D0, 0, 0)>(vb), h0 = tr_read<v_rd_off(D0, 0, 1)>(vb), l1 = tr_read<v_rd_off(D0, 1, 0)>(vb), h1 = tr_read<v_rd_off(D0, 1, 1)>(vb);
  const s16x4 l2 = tr_read<v_rd_off(D0, 2, 0)>(vb), h2 = tr_read<v_rd_off(D0, 2, 1)>(vb), l3 = tr_read<v_rd_off(D0, 3, 0)>(vb), h3 = tr_read<v_rd_off(D0, 3, 1)>(vb);
  asm volatile("s_waitcnt lgkmcnt(0)" ::: "memory"); AT_SBAR();
#define AT_PK(L, H) (bf16x8){L[0], L[1], L[2], L[3], H[0], H[1], H[2], H[3]}
  od = __builtin_amdgcn_mfma_f32_32x32x16_bf16(pa0, AT_PK(l0, h0), od, 0, 0, 0);
  od = __builtin_amdgcn_mfma_f32_32x32x16_bf16(pa1, AT_PK(l1, h1), od, 0, 0, 0);
  od = __builtin_amdgcn_mfma_f32_32x32x16_bf16(pa2, AT_PK(l2, h2), od, 0, 0, 0);
  od = __builtin_amdgcn_mfma_f32_32x32x16_bf16(pa3, AT_PK(l3, h3), od, 0, 0, 0);
#undef AT_PK
}
__device__ __forceinline__ void pv_d0(f32x16* o, int vb, bf16x8 pa0, bf16x8 pa1, bf16x8 pa2, bf16x8 pa3) {
  pv_one<0>(o[0], vb, pa0, pa1, pa2, pa3); pv_one<1>(o[1], vb, pa0, pa1, pa2, pa3); pv_one<2>(o[2], vb, pa0, pa1, pa2, pa3); pv_one<3>(o[3], vb, pa0, pa1, pa2, pa3);
}
__device__ __forceinline__ void attn_pass(const bf16* __restrict__ Qw, const bf16* __restrict__ Kh, const bf16* __restrict__ Vh, int seq, char* lds, f32x16 (&o)[4]) {
  int tid_ = threadIdx.x; asm volatile("" : "+v"(tid_));
  const int tid = tid_, wid = tid >> 6, lane = tid & 63, r32 = lane & 31, hi = lane >> 5;
  char* V_lds = lds + O_V; char* K_lds = lds + O_K;
  float* ws = (float*)(lds + O_WS) + wid * 64; float* li_l = ws; float* al_l = ws + 32;
  float m_reg = -1e30f, l_reg = 0; bf16x8 qr[4];
#pragma unroll
  for (int d = 0; d < 4; ++d) o[d] = f32x16{};
  const bf16* Ql = Qw + (long)r32 * LDK + hi * 8;
#pragma unroll
  for (int d0 = 0; d0 < 4; ++d0) qr[d0] = *reinterpret_cast<const bf16x8*>(Ql + d0 * 16);
  const int sr = tid >> 4, sc = (tid & 15) * 8, vst0 = v_st(sr, sc), vst1 = v_st(32 + sr, sc);
  const int kr = tid >> 3, kc = tid & 7, kst = KSWZ64(kr, kc);
  const int vb0 = (int)(uintptr_t)V_lds + v_rd_base(lane);
  struct { bf16x8 vs0, vs1, ks0; } sr_[2];
#define AT_SLOAD(i, k0) do { sr_[i].vs0 = *reinterpret_cast<const bf16x8*>(&Vh[(long)((k0) + sr) * LDK + sc]); sr_[i].vs1 = *reinterpret_cast<const bf16x8*>(&Vh[(long)((k0) + 32 + sr) * LDK + sc]); \
    sr_[i].ks0 = *reinterpret_cast<const bf16x8*>(&Kh[(long)((k0) + kr) * LDK + kc * 8]); } while (0)
#define AT_SWRITE(b, i) do { *(bf16x8*)(V_lds + (b) * SHM_V + vst0) = sr_[i].vs0; *(bf16x8*)(V_lds + (b) * SHM_V + vst1) = sr_[i].vs1; \
    *(bf16x8*)(K_lds + (b) * SHM_K + kst) = sr_[i].ks0; } while (0)
#define AT_SWAIT() asm volatile("s_waitcnt vmcnt(3)" ::: "memory")
#define AT_RESC(a) do { if (__any((a) < 1.f)) { if (hi == 0) al_l[r32] = (a); asm volatile("s_waitcnt lgkmcnt(0)" ::: "memory"); \
    _Pragma("unroll") for (int d = 0; d < 4; ++d) _Pragma("unroll") for (int r = 0; r < 16; ++r) o[d][r] *= al_l[crow(r, hi)]; } } while (0)
  f32x16 pA0, pA1, pB0, pB1; float mnA, mnB, alA, alB; bf16x8 pa0, pa1, pa2, pa3; const int NT = seq / 64;
  constexpr int SE = 0, SO = 1;
  AT_SLOAD(SE, 0); asm volatile("s_waitcnt vmcnt(0)" ::: "memory"); AT_SWRITE(0, SE); __syncthreads();
  qkt(pA0, pA1, K_lds, qr, r32, hi); partialSM(pA0, pA1, m_reg, mnA, alA);
  AT_SLOAD(SO, 64); if (2 < NT) AT_SLOAD(SE, 128);
  AT_SWAIT(); AT_SWRITE(1, SO); __syncthreads();
#ifdef AT_PRIO
  if (__builtin_amdgcn_readfirstlane(tid) >= 256) __builtin_amdgcn_s_setprio(1);
#endif
  for (int j = 1; j + 1 < NT; j += 2) {
    AT_SBAR(); qkt(pB0, pB1, K_lds + SHM_K, qr, r32, hi, -m_reg);
    finishSM(pA0, pA1, alA, l_reg, pa0, pa1, pa2, pa3); AT_SBAR();
    AT_SLOAD(SO, (j + 2) * 64); AT_SBAR();
    pv_d0(o, vb0, pa0, pa1, pa2, pa3); partialSM_rel(pB0, pB1, m_reg, alB);
    __syncthreads(); AT_SWAIT(); AT_SWRITE(0, SE);
    AT_RESC(alB); __syncthreads();
    AT_SBAR(); qkt(pA0, pA1, K_lds, qr, r32, hi, -m_reg);
    finishSM(pB0, pB1, alB, l_reg, pa0, pa1, pa2, pa3); AT_SBAR();
    if (j + 3 < NT) AT_SLOAD(SE, (j + 3) * 64); AT_SBAR();
    pv_d0(o, vb0 + SHM_V, pa0, pa1, pa2, pa3); partialSM_rel(pA0, pA1, m_reg, alA);
    __syncthreads(); AT_SWAIT(); AT_SWRITE(1, SO);
    AT_RESC(alA); __syncthreads();
  }
  AT_SBAR(); qkt(pB0, pB1, K_lds + SHM_K, qr, r32, hi, -m_reg);
  finishSM(pA0, pA1, alA, l_reg, pa0, pa1, pa2, pa3); AT_SBAR();
  pv_d0(o, vb0, pa0, pa1, pa2, pa3); partialSM_rel(pB0, pB1, m_reg, alB);
  __syncthreads(); AT_RESC(alB);
  finishSM(pB0, pB1, alB, l_reg, pa0, pa1, pa2, pa3); AT_SBAR();
  pv_d0(o, vb0 + SHM_V, pa0, pa1, pa2, pa3);
#ifdef AT_PRIO
  __builtin_amdgcn_s_setprio(0);
#endif
  if (hi == 0) li_l[r32] = l_reg; asm volatile("s_waitcnt lgkmcnt(0)" ::: "memory");
#pragma unroll
  for (int r = 0; r < 16; ++r) { const float rl = __builtin_amdgcn_rcpf(li_l[crow(r, hi)]);
#pragma unroll
    for (int d = 0; d < 4; ++d) o[d][r] *= rl; }
  __syncthreads();
#undef AT_SLOAD
#undef AT_SWRITE
#undef AT_SWAIT
#undef AT_RESC
}
}

__device__ __forceinline__ void attn_unit(Frame& F, int unit, float lam, const float* subln_g) {
    const int b = unit >> 6, h = (unit >> 3) & 7, qb = unit & 7;
    int tid_ = threadIdx.x; asm volatile("" : "+v"(tid_));
    const int tid = tid_, wid = tid >> 6, lane = tid & 63, r32 = lane & 31, hi = lane >> 5;
    const size_t rowbase = (size_t)b * SEQ;
    const bf16* Qb = (const bf16*)(F.ws + WS_DAQ) + (rowbase + qb * 256 + wid * 32) * 1024 + h * 128;
    const bf16* Kb = (const bf16*)(F.ws + WS_DAK) + rowbase * 1024 + h * 128;
    const bf16* Vb = (const bf16*)(F.ws + WS_DAV) + rowbase * 1024 + h * 128;
    GAS f32x4* stash = (GAS f32x4*)(F.ws + WS_STASH) + (size_t)blockIdx.x * 16 * 512 + tid;
    asm volatile("" : "+v"(stash));
    char* lds = (char*)F.ldsg + RING_OFF;
    f32x16 o[4];
    at::attn_pass(Qb, Kb, Vb, SEQ, lds, o);
#pragma unroll
    for (int d = 0; d < 4; ++d)
#pragma unroll
        for (int g = 0; g < 4; ++g) stash[(d * 4 + g) * 512] = (f32x4){o[d][4 * g], o[d][4 * g + 1], o[d][4 * g + 2], o[d][4 * g + 3]};
    at::attn_pass(Qb + 64, Kb + 64, Vb, SEQ, lds, o);
    float gsc[4];
#pragma unroll
    for (int d = 0; d < 4; ++d) gsc[d] = subln_g[d * 32 + r32] * (1.0f - LAMBDA_INIT);
    bf16* Ob = (bf16*)(F.ws + WS_OA) + (rowbase + qb * 256 + wid * 32) * 1024 + h * 128;
    LAS unsigned char* stg = F.lds + RING_OFF + 51200 + wid * 8704;
#pragma unroll
    for (int g = 0; g < 4; ++g) {
        f32x4 s0[4];
#pragma unroll
        for (int d = 0; d < 4; ++d) s0[d] = stash[(d * 4 + g) * 512];
#pragma unroll
        for (int q = 0; q < 4; ++q) { const int r = 4 * g + q;
            float v[4], ss = 0.f;
#pragma unroll
            for (int d = 0; d < 4; ++d) { v[d] = s0[d][q] - lam * o[d][r]; ss += v[d] * v[d]; }
#pragma unroll
            for (int x = 1; x < 32; x <<= 1) ss += __shfl_xor(ss, x);
            const float rstd = __builtin_amdgcn_rsqf(ss * (1.0f / 128.0f) + EPS);
            const int orow = at::crow(r, hi);
#pragma unroll
            for (int d = 0; d < 4; ++d) *(LAS unsigned short*)(stg + orow * 272 + (d * 32 + r32) * 2) = (unsigned short)(cvtpk(v[d] * rstd * gsc[d], 0.f) & 0xffffu);
        }
    }
    asm volatile("s_waitcnt lgkmcnt(0)" ::: "memory");
#pragma unroll
    for (int i = 0; i < 8; ++i) { const int row = i * 4 + (lane >> 4), ch = lane & 15;
        const v4u w = *(const LAS v4u*)(stg + row * 272 + ch * 16);
        *(v4u*)(Ob + (size_t)row * 1024 + ch * 8) = w; }
}


__device__ __forceinline__ void hgrn_combine(Frame& F, const float* norm_g) {
    const int gw = F.vcu * NWAVES + F.wave, NGW = F.G * NWAVES, lane = F.lane;
    const bf16* OFp = (const bf16*)(F.ws + WS_OF); const bf16* OBp = (const bf16*)(F.ws + WS_OBW);
    const bf16* GG = (const bf16*)(F.ws + WS_HGG); bf16* OB = (bf16*)(F.ws + WS_OB);
    f32x4 ng[4];
#pragma unroll
    for (int j = 0; j < 4; ++j) ng[j] = *(const f32x4*)(norm_g + (16 * lane + 4 * j) % 128);
    v4u fa[2], ba[2], ga[2], fb[2], bb[2], gb[2];
#if I8_AB
    v4u oa_a[2], oa_b[2];
    const bf16* OAp = (const bf16*)(F.ws + WS_OA);
#define HC_LOADA(AV, m_) do { const size_t off_ = (size_t)(m_) * 1024 + 16 * lane; AV[0] = *(const v4u*)(OAp + off_); AV[1] = *(const v4u*)(OAp + off_ + 8); } while (0)
#define HC_Q16(VAL, DST, SC, m_) do { float am_ = 0.f; _Pragma("unroll") for (int j = 0; j < 16; ++j) am_ = fmaxf(am_, __builtin_fabsf(VAL[j])); \
        _Pragma("unroll") for (int o = 1; o < 64; o <<= 1) am_ = fmaxf(am_, __shfl_xor(am_, o)); const float inv_ = am_ > 0.f ? 127.0f / am_ : 0.f; unsigned w_[4]; \
        _Pragma("unroll") for (int q = 0; q < 4; ++q) { const int a0 = __float2int_rn(VAL[4 * q] * inv_), a1 = __float2int_rn(VAL[4 * q + 1] * inv_), a2 = __float2int_rn(VAL[4 * q + 2] * inv_), a3 = __float2int_rn(VAL[4 * q + 3] * inv_); \
            w_[q] = (unsigned)(a0 & 255) | ((unsigned)(a1 & 255) << 8) | ((unsigned)(a2 & 255) << 16) | ((unsigned)a3 << 24); } \
        *(v4u*)((DST) + (size_t)(m_) * 1024 + 16 * lane) = (v4u){w_[0], w_[1], w_[2], w_[3]}; if (lane == 0) (SC)[m_] = am_ * (1.0f / 127.0f); } while (0)
#else
#define HC_LOADA(AV, m_) do { } while (0)
#endif
#define HC_LOAD(FV, BV, GV, m_) do { const size_t off_ = (size_t)(m_) * 1024 + 16 * lane; \
        FV[0] = *(const v4u*)(OFp + off_); FV[1] = *(const v4u*)(OFp + off_ + 8); BV[0] = *(const v4u*)(OBp + off_); BV[1] = *(const v4u*)(OBp + off_ + 8); \
        GV[0] = *(const v4u*)(GG + off_); GV[1] = *(const v4u*)(GG + off_ + 8); } while (0)
#define HC_PROC(FV, BV, GV, AV, m_) do { const size_t off_ = (size_t)(m_) * 1024 + 16 * lane; float v_[16]; float ss_ = 0.f; \
        const unsigned ff_[8] = {FV[0].x, FV[0].y, FV[0].z, FV[0].w, FV[1].x, FV[1].y, FV[1].z, FV[1].w}, bq_[8] = {BV[0].x, BV[0].y, BV[0].z, BV[0].w, BV[1].x, BV[1].y, BV[1].z, BV[1].w}; \
        _Pragma("unroll") for (int j = 0; j < 8; ++j) { v_[2 * j] = bf_lo(ff_[j]) + bf_lo(bq_[j]); v_[2 * j + 1] = bf_hi(ff_[j]) + bf_hi(bq_[j]); ss_ += v_[2 * j] * v_[2 * j] + v_[2 * j + 1] * v_[2 * j + 1]; } \
        ss_ += __shfl_xor(ss_, 1); ss_ += __shfl_xor(ss_, 2); ss_ += __shfl_xor(ss_, 4); \
        const float rstd_ = __builtin_amdgcn_rsqf(ss_ * (1.0f / 128.0f) + EPS); \
        const unsigned gg_[8] = {GV[0].x, GV[0].y, GV[0].z, GV[0].w, GV[1].x, GV[1].y, GV[1].z, GV[1].w}; \
        _Pragma("unroll") for (int j = 0; j < 8; ++j) { v_[2 * j] = v_[2 * j] * rstd_ * ng[j >> 1][(2 * j) & 3] * bf_lo(gg_[j]); v_[2 * j + 1] = v_[2 * j + 1] * rstd_ * ng[j >> 1][(2 * j + 1) & 3] * bf_hi(gg_[j]); } \
        HC_STORE(v_, AV, m_, off_); } while (0)
#if I8_AB
#define HC_STORE(V, AV, m_, off_) do { HC_Q16(V, (unsigned char*)(F.ws + WS_OB), (float*)(F.ws + WS_SAB), m_); \
        const unsigned aa_[8] = {AV[0].x, AV[0].y, AV[0].z, AV[0].w, AV[1].x, AV[1].y, AV[1].z, AV[1].w}; float a_[16]; \
        _Pragma("unroll") for (int j = 0; j < 8; ++j) { a_[2 * j] = bf_lo(aa_[j]); a_[2 * j + 1] = bf_hi(aa_[j]); } \
        HC_Q16(a_, (unsigned char*)(F.ws + WS_OA8), (float*)(F.ws + WS_SAO), m_); } while (0)
#else
#define HC_STORE(V, AV, m_, off_) do { unsigned o_[8]; _Pragma("unroll") for (int j = 0; j < 8; ++j) o_[j] = cvtpk(V[2 * j], V[2 * j + 1]); \
        *(v4u*)(OB + off_) = (v4u){o_[0], o_[1], o_[2], o_[3]}; *(v4u*)(OB + off_ + 8) = (v4u){o_[4], o_[5], o_[6], o_[7]}; } while (0)
    v4u oa_a[2], oa_b[2];
#endif
    int m = gw;
    if (m < T) { HC_LOAD(fa, ba, ga, m); HC_LOADA(oa_a, m); }
    for (; m < T; m += 2 * NGW) {
        if (m + NGW < T) { HC_LOAD(fb, bb, gb, m + NGW); HC_LOADA(oa_b, m + NGW); }
        HC_PROC(fa, ba, ga, oa_a, m);
        if (m + NGW < T) { if (m + 2 * NGW < T) { HC_LOAD(fa, ba, ga, m + 2 * NGW); HC_LOADA(oa_a, m + 2 * NGW); } HC_PROC(fb, bb, gb, oa_b, m + NGW); }
    }
#undef HC_LOAD
#undef HC_LOADA
#undef HC_PROC
#undef HC_STORE
#if I8_AB
#undef HC_Q16
#endif
}
__device__ __forceinline__ void cvt_table(Frame& F, const float* src, bf16* dst, size_t n) {
    const size_t n8 = n / 8, stride = (size_t)F.G * 512;
    for (size_t i = (size_t)F.vcu * 512 + F.tid; i < n8; i += stride) {
        const f32x4 a = *(const f32x4*)(src + i * 8), b = *(const f32x4*)(src + i * 8 + 4);
        *(v4u*)(dst + i * 8) = (v4u){cvtpk(a.x, a.y), cvtpk(a.z, a.w), cvtpk(b.x, b.y), cvtpk(b.z, b.w)};
    }
}

namespace pr {
typedef short bf16x8 __attribute__((ext_vector_type(8)));
constexpr int LK = 272;
#define PR_CE(a, b) do { const unsigned hi_ = (a) > (b) ? (a) : (b); const unsigned lo_ = (a) > (b) ? (b) : (a); (a) = hi_; (b) = lo_; } while (0)
__device__ __forceinline__ void sort16(unsigned (&v)[16]) {
#pragma unroll
    for (int k = 2; k <= 16; k <<= 1)
#pragma unroll
        for (int j = k >> 1; j > 0; j >>= 1)
#pragma unroll
            for (int i = 0; i < 16; ++i) { const int l = i ^ j; if (l > i) { if ((i & k) == 0) PR_CE(v[i], v[l]); else PR_CE(v[l], v[i]); } }
}
__device__ __forceinline__ void merge16(unsigned (&a)[16], const unsigned (&b)[16]) {
#pragma unroll
    for (int i = 0; i < 16; ++i) a[i] = a[i] > b[15 - i] ? a[i] : b[15 - i];
#pragma unroll
    for (int j = 8; j > 0; j >>= 1)
#pragma unroll
        for (int i = 0; i < 16; ++i) { const int l = i ^ j; if (l > i) PR_CE(a[i], a[l]); }
}
__device__ __forceinline__ unsigned ord(float f) { const unsigned u = __float_as_uint(f); return u ^ ((unsigned)((int)u >> 31) | 0x80000000u); }
__device__ __forceinline__ float unord(unsigned u) { return __uint_as_float((u & 0x80000000u) ? (u ^ 0x80000000u) : ~u); }
}
__device__ __forceinline__ void peer_route_unit(Frame& F, int unit, const float* keys1, const float* keys2) {
    using namespace pr;
    const int hp = unit >> 6, tt = unit & 63;
    LAS unsigned char* L = F.lds + RING_OFF;
    const int tid = F.tid, lane = F.lane, w = F.wave, r32 = lane & 31, hi = lane >> 5;
    for (int i = tid; i < 2 * 128 * 16; i += 512) { const int half = i >> 11, rem = i & 2047, kr = rem >> 4, kc = rem & 15;
        const float* src = (half ? keys2 : keys1) + ((size_t)hp * 128 + kr) * 128 + kc * 8;
        const f32x4 a = *(const f32x4*)src, b = *(const f32x4*)(src + 4);
        *(LAS v4u*)(L + half * (128 * LK) + kr * LK + kc * 16) = (v4u){cvtpk(a.x, a.y), cvtpk(a.z, a.w), cvtpk(b.x, b.y), cvtpk(b.z, b.w)}; }
    __syncthreads();
    const int tok = tt * 256 + w * 32 + r32;
    const bf16* qrow = (const bf16*)(F.ws + WS_QP) + (size_t)tok * DM + hp * 256 + hi * 8;
    unsigned top[2][16];
#pragma unroll
    for (int half = 0; half < 2; ++half) {
        bf16x8 qf[8];
#pragma unroll
        for (int ks = 0; ks < 8; ++ks) qf[ks] = *(const bf16x8*)(qrow + half * 128 + ks * 16);
        unsigned res[16];
#pragma unroll
        for (int kb = 0; kb < 4; ++kb) {
            f32x16 acc = f32x16{};
#pragma unroll
            for (int ks = 0; ks < 8; ++ks) acc = __builtin_amdgcn_mfma_f32_32x32x16_bf16(*(const LAS bf16x8*)(L + half * (128 * LK) + (32 * kb + r32) * LK + ks * 32 + hi * 16), qf[ks], acc, 0, 0, 0);
            unsigned kv[16];
#pragma unroll
            for (int r = 0; r < 16; ++r) { const int idx = 32 * kb + (r & 3) + 8 * (r >> 2) + 4 * hi; kv[r] = (ord(acc[r]) & 0xFFFFFF80u) | (unsigned)(127 - idx); }
            sort16(kv);
            if (kb == 0) {
#pragma unroll
                for (int r = 0; r < 16; ++r) res[r] = kv[r];
            } else merge16(res, kv);
        }
        unsigned oth[16];
#pragma unroll
        for (int r = 0; r < 16; ++r) { auto rr = __builtin_amdgcn_permlane32_swap(res[r], res[r], false, false); oth[r] = hi ? rr[0] : rr[1]; }
        merge16(res, oth);
#pragma unroll
        for (int r = 0; r < 16; ++r) top[half][r] = res[r];
    }
    float f1[16], f2[16]; unsigned ip1[4] = {0u, 0u, 0u, 0u}, ip2[4] = {0u, 0u, 0u, 0u};
#pragma unroll
    for (int r = 0; r < 16; ++r) { f1[r] = unord((top[0][r] & 0xFFFFFF80u) | 0x40u); f2[r] = unord((top[1][r] & 0xFFFFFF80u) | 0x40u);
        ip1[r >> 2] |= (127u - (top[0][r] & 127u)) << (8 * (r & 3)); ip2[r >> 2] |= (127u - (top[1][r] & 127u)) << (8 * (r & 3)); }
    unsigned cand[64];
    { int n = 0;
#pragma unroll
      for (int i = 0; i < 16; ++i)
#pragma unroll
          for (int j = 0; j < 16; ++j) if ((i + 1) * (j + 1) <= 16) { cand[n] = (ord(f1[i] + f2[j]) & 0xFFFFFF00u) | (unsigned)(255 - (i * 16 + j)); ++n; }
#pragma unroll
      for (int q = 50; q < 64; ++q) cand[q] = 0u; }
    unsigned res[16];
#pragma unroll
    for (int g = 0; g < 4; ++g) { unsigned kv[16];
#pragma unroll
        for (int r = 0; r < 16; ++r) kv[r] = cand[g * 16 + r];
        sort16(kv);
        if (g == 0) {
#pragma unroll
            for (int r = 0; r < 16; ++r) res[r] = kv[r];
        } else merge16(res, kv); }
    float sc[16]; int ex[16];
#pragma unroll
    for (int r = 0; r < 16; ++r) { sc[r] = unord((res[r] & 0xFFFFFF00u) | 0x80u); const unsigned ci = 255u - (res[r] & 255u), i = ci >> 4, j = ci & 15u;
        unsigned wi = ip1[0]; wi = (i >> 2) == 1 ? ip1[1] : wi; wi = (i >> 2) == 2 ? ip1[2] : wi; wi = (i >> 2) == 3 ? ip1[3] : wi;
        unsigned wj = ip2[0]; wj = (j >> 2) == 1 ? ip2[1] : wj; wj = (j >> 2) == 2 ? ip2[2] : wj; wj = (j >> 2) == 3 ? ip2[3] : wj;
        ex[r] = (int)(((wi >> (8 * (i & 3))) & 255u) * 128u + ((wj >> (8 * (j & 3))) & 255u)); }
    const float mx = sc[0];
    float ev[16], sum = 0.f;
#pragma unroll
    for (int r = 0; r < 16; ++r) { ev[r] = __expf(sc[r] - mx); sum += ev[r]; }
    const float inv = 1.0f / sum;
    int eo[8]; float go[8];
#pragma unroll
    for (int q = 0; q < 8; ++q) { eo[q] = hi ? ex[8 + q] : ex[q]; go[q] = (hi ? ev[8 + q] : ev[q]) * inv; }
    int* EI = (int*)(F.ws + WS_EIDX) + (size_t)tok * 128 + hp * 16 + 8 * hi;
    float* EGp = (float*)(F.ws + WS_EG) + (size_t)tok * 128 + hp * 16 + 8 * hi;
    typedef int i32x4 __attribute__((ext_vector_type(4)));
    *(i32x4*)EI = (i32x4){eo[0], eo[1], eo[2], eo[3]}; *(i32x4*)(EI + 4) = (i32x4){eo[4], eo[5], eo[6], eo[7]};
    *(f32x4*)EGp = (f32x4){go[0], go[1], go[2], go[3]}; *(f32x4*)(EGp + 4) = (f32x4){go[4], go[5], go[6], go[7]};
    __syncthreads();
}

typedef float f32x32 __attribute__((ext_vector_type(32)));
typedef int i32x6 __attribute__((ext_vector_type(6)));
typedef __bf16 bf16x32 __attribute__((ext_vector_type(32)));
typedef unsigned v2u __attribute__((ext_vector_type(2)));
constexpr int ROWB = 1536;
__device__ __forceinline__ void cvt_table_fp6(Frame& F, const float* src, unsigned char* dst, float* scale) {
    const int gw = F.vcu * NWAVES + F.wave, NGW = F.G * NWAVES, lane = F.lane;
    f32x4 va[8], vb[8];
#define CT_LOAD(V, r_) do { const float* rp_ = src + (size_t)(r_) * DM; _Pragma("unroll") for (int q = 0; q < 8; ++q) V[q] = *(const f32x4*)(rp_ + q * 256 + 4 * lane); } while (0)
#define CT_PROC(V, r_) do { float am_ = 0.f; \
        _Pragma("unroll") for (int q = 0; q < 8; ++q) am_ = fmaxf(am_, fmaxf(fmaxf(__builtin_fabsf(V[q].x), __builtin_fabsf(V[q].y)), fmaxf(__builtin_fabsf(V[q].z), __builtin_fabsf(V[q].w)))); \
        _Pragma("unroll") for (int o = 1; o < 64; o <<= 1) am_ = fmaxf(am_, __shfl_xor(am_, o)); \
        const float sc_ = am_ > 0.f ? am_ * (1.0f / 7.5f) : 1.0f, inv_ = 1.0f / sc_; bf16x32 b_; \
        _Pragma("unroll") for (int q = 0; q < 8; ++q) { b_[4 * q] = (__bf16)(V[q].x * inv_); b_[4 * q + 1] = (__bf16)(V[q].y * inv_); b_[4 * q + 2] = (__bf16)(V[q].z * inv_); b_[4 * q + 3] = (__bf16)(V[q].w * inv_); } \
        const i32x6 w_ = __builtin_amdgcn_cvt_scalef32_pk32_fp6_bf16(b_, 1.0f); unsigned char* op_ = dst + (size_t)(r_) * ROWB; \
        *(v4u*)(op_ + lane * 16) = (v4u){(unsigned)w_[0], (unsigned)w_[1], (unsigned)w_[2], (unsigned)w_[3]}; \
        *(v2u*)(op_ + 1024 + lane * 8) = (v2u){(unsigned)w_[4], (unsigned)w_[5]}; \
        if (lane == 0) scale[r_] = sc_; } while (0)
    int row = gw;
    if (row < 16384) CT_LOAD(va, row);
    for (; row < 16384; row += 2 * NGW) {
        if (row + NGW < 16384) CT_LOAD(vb, row + NGW);
        CT_PROC(va, row);
        if (row + NGW < 16384) { if (row + 2 * NGW < 16384) CT_LOAD(va, row + 2 * NGW); CT_PROC(vb, row + NGW); }
    }
#undef CT_LOAD
#undef CT_PROC
}
template <bool F4> __device__ __forceinline__ f32x32 dec_row(const v4u a, const v2u b) {
    if constexpr (F4) { f32x32 d; const unsigned ww[4] = {a.x, a.y, a.z, a.w};
#pragma unroll
        for (int q = 0; q < 4; ++q) { const f32x2v d0 = __builtin_amdgcn_cvt_scalef32_pk_f32_fp4(ww[q], 1.0f, 0), d1 = __builtin_amdgcn_cvt_scalef32_pk_f32_fp4(ww[q], 1.0f, 1), d2 = __builtin_amdgcn_cvt_scalef32_pk_f32_fp4(ww[q], 1.0f, 2), d3 = __builtin_amdgcn_cvt_scalef32_pk_f32_fp4(ww[q], 1.0f, 3);
            d[8 * q] = d0.x; d[8 * q + 1] = d0.y; d[8 * q + 2] = d1.x; d[8 * q + 3] = d1.y; d[8 * q + 4] = d2.x; d[8 * q + 5] = d2.y; d[8 * q + 6] = d3.x; d[8 * q + 7] = d3.y; }
        return d; }
    else { const i32x6 w = {(int)a.x, (int)a.y, (int)a.z, (int)a.w, (int)b.x, (int)b.y}; return __builtin_amdgcn_cvt_scalef32_pk32_f32_fp6(w, 1.0f); }
}
__device__ __forceinline__ f32x32 dec_fp6(const v4u a, const v2u b) { const i32x6 w = {(int)a.x, (int)a.y, (int)a.z, (int)a.w, (int)b.x, (int)b.y}; return __builtin_amdgcn_cvt_scalef32_pk32_f32_fp6(w, 1.0f); }
__device__ __forceinline__ float dot32_fp6(const v4u a, const v2u b, const f32x2v* h2) {
    const f32x32 d = dec_row<PEER_U4 != 0>(a, b); f32x2v p0 = {0.f, 0.f}, p1 = {0.f, 0.f};
#pragma unroll
    for (int q = 0; q < 16; q += 2) { p0 = __builtin_elementwise_fma((f32x2v){d[2 * q], d[2 * q + 1]}, h2[q], p0); p1 = __builtin_elementwise_fma((f32x2v){d[2 * q + 2], d[2 * q + 3]}, h2[q + 1], p1); }
    const f32x2v p = p0 + p1; return p.x + p.y;
}
__device__ __forceinline__ void axpy32_fp6(const v4u a, const v2u b, float c, f32x2v* acc2) {
    const f32x32 d = dec_row<PEER_V4 != 0>(a, b); const f32x2v cc = {c, c};
#pragma unroll
    for (int q = 0; q < 16; ++q) acc2[q] = __builtin_elementwise_fma(cc, (f32x2v){d[2 * q], d[2 * q + 1]}, acc2[q]);
}
#if PEER_UI4
template <int MODE, bool TO_LDS> __device__ __forceinline__ void peer_dots_pass(Frame& F, const int j0, const int ntok, const int gw, const int NGW, LAS unsigned char* dig, LAS unsigned* list, LAS float* apl) {
    int lane_ = F.lane; asm volatile("" : "+v"(lane_)); const int lane = lane_;
    const unsigned char* H2 = F.ws + WS_H2; const unsigned char* U8 = F.ws + WS_U8;
    const int* EI = (const int*)(F.ws + WS_EIDX); float* AP = (float*)(F.ws + WS_AP);
    typedef int i32x4v __attribute__((ext_vector_type(4)));
    {
        int evr[4][2];
#pragma unroll
        for (int tl = 0; tl < 4; ++tl) { evr[tl][0] = -1; evr[tl][1] = -1;
            if (tl < ntok) { const int t = gw + NGW * (j0 + tl);
            evr[tl][0] = EI[(size_t)t * 128 + lane]; evr[tl][1] = EI[(size_t)t * 128 + 64 + lane];
            unsigned hn[8], ln[8];
#pragma unroll
            for (int q = 0; q < 8; ++q) { const unsigned a = *(const unsigned*)(H2 + (size_t)t * DM + q * 256 + 4 * lane);
                ln[q] = a & 0x0F0F0F0Fu; hn[q] = ((((a ^ 0x80808080u) + 0x08080808u) >> 4) & 0x0F0F0F0Fu) ^ 0x08080808u; }
            *(LAS v4u*)(dig + tl * 2048 + lane * 16) = (v4u){hn[0] | (hn[1] << 4), hn[2] | (hn[3] << 4), hn[4] | (hn[5] << 4), hn[6] | (hn[7] << 4)};
            *(LAS v4u*)(dig + tl * 2048 + 1024 + lane * 16) = (v4u){ln[0] | (ln[1] << 4), ln[2] | (ln[3] << 4), ln[4] | (ln[5] << 4), ln[6] | (ln[7] << 4)}; } }
#pragma unroll 1
        for (int s = 0; s < 8; ++s) {
            int n = 0;
#pragma unroll
            for (int tl = 0; tl < 4; ++tl)
#pragma unroll
                for (int h = 0; h < 2; ++h) { const int ev = evr[tl][h]; const bool c = (ev >> 11) == s; const unsigned long long m = __ballot(c);
                    const int pos = n + (int)__builtin_amdgcn_mbcnt_hi((unsigned)(m >> 32), __builtin_amdgcn_mbcnt_lo((unsigned)m, 0u));
                    if (c) list[pos] = (unsigned)ev | ((unsigned)tl << 14) | ((unsigned)(h * 64 + lane) << 16);
                    n += __builtin_popcountll(m); }
            if (lane < 16) list[n + lane] = ((unsigned)s << 11) | 0x80000000u;
            __builtin_amdgcn_fence(__ATOMIC_RELEASE, "wavefront"); __builtin_amdgcn_wave_barrier();
            const int G16 = (n + 15) >> 4;
            v4u bufA[4][4], bufB[4][4]; unsigned entA[4], entB[4];
            const int grp = lane >> 4, li = lane & 15;
#define PS_LOAD(BUF, ENT, g_) do { _Pragma("unroll") for (int j_ = 0; j_ < 4; ++j_) { ENT[j_] = list[16 * (g_) + 4 * j_ + grp]; \
                const unsigned char* rp_ = U8 + (size_t)(ENT[j_] & (MODE == 1 ? 63u : 0x3FFFu)) * 1024 + li * 16; \
                if (!(ENT[j_] >> 31)) { _Pragma("unroll") for (int k_ = 0; k_ < 4; ++k_) BUF[j_][k_] = *(const v4u*)(rp_ + 256 * k_); } } } while (0)
#define PS_DPP(x_, ctrl_) __builtin_bit_cast(float, __builtin_amdgcn_update_dpp(0, __builtin_bit_cast(int, (x_)), (ctrl_), 0xF, 0xF, true))
#define PS_PROC(BUF, ENT, g_) do { float part[4]; \
                _Pragma("unroll") for (int j_ = 0; j_ < 4; ++j_) { const LAS unsigned char* dp_ = dig + ((ENT[j_] >> 14) & 3u) * 2048 + li * 16; int ah = 0, al = 0; \
                    _Pragma("unroll") for (int k_ = 0; k_ < 4; ++k_) { const i32x4v dh = *(const LAS i32x4v*)(dp_ + 256 * k_), dl = *(const LAS i32x4v*)(dp_ + 1024 + 256 * k_); \
                        ah = __builtin_amdgcn_sdot8((int)BUF[j_][k_].x, dh.x, ah, false); al = __builtin_amdgcn_sdot8((int)BUF[j_][k_].x, dl.x, al, false); \
                        ah = __builtin_amdgcn_sdot8((int)BUF[j_][k_].y, dh.y, ah, false); al = __builtin_amdgcn_sdot8((int)BUF[j_][k_].y, dl.y, al, false); \
                        ah = __builtin_amdgcn_sdot8((int)BUF[j_][k_].z, dh.z, ah, false); al = __builtin_amdgcn_sdot8((int)BUF[j_][k_].z, dl.z, al, false); \
                        ah = __builtin_amdgcn_sdot8((int)BUF[j_][k_].w, dh.w, ah, false); al = __builtin_amdgcn_sdot8((int)BUF[j_][k_].w, dl.w, al, false); } \
                    part[j_] = (float)(ah * 16 + al); } \
                { const bool up_ = (lane & 1) != 0; \
                  const float s0 = up_ ? part[0] : part[2], k0 = up_ ? part[2] : part[0], s1 = up_ ? part[1] : part[3], k1 = up_ ? part[3] : part[1]; \
                  part[0] = k0 + PS_DPP(s0, 0xB1); part[1] = k1 + PS_DPP(s1, 0xB1); } \
                { const bool up_ = (lane & 2) != 0; const float s0 = up_ ? part[0] : part[1], k0 = up_ ? part[1] : part[0]; part[0] = k0 + PS_DPP(s0, 0x4E); } \
                float tot = part[0]; tot = (tot + PS_DPP(tot, 0x124)) + (PS_DPP(tot, 0x128) + PS_DPP(tot, 0x12C));              \
                if ((lane & 12) == 0) { const unsigned en_ = list[16 * (g_) + 4 * (2 * (lane & 1) + ((lane >> 1) & 1)) + grp]; \
                    if (!(en_ >> 31)) { if (TO_LDS) apl[((en_ >> 14) & 3u) * 128u + ((en_ >> 16) & 127u)] = tot; \
                        else { const int t_ = gw + NGW * (j0 + (int)((en_ >> 14) & 3u)); AP[(size_t)t_ * 128 + ((en_ >> 16) & 127u)] = tot; } } } } while (0)
            if (G16 > 0) PS_LOAD(bufA, entA, 0);
#pragma unroll 1
            for (int g = 0; g < G16; g += 2) {
                if (g + 1 < G16) PS_LOAD(bufB, entB, g + 1);
                PS_PROC(bufA, entA, g);
                if (g + 1 < G16) { if (g + 2 < G16) PS_LOAD(bufA, entA, g + 2); PS_PROC(bufB, entB, g + 1); }
            }
#undef PS_LOAD
#undef PS_PROC
#undef PS_DPP
            __builtin_amdgcn_fence(__ATOMIC_RELEASE, "wavefront"); __builtin_amdgcn_wave_barrier();
        }
    }
}
template <int MODE> __device__ __forceinline__ void peer_dots_sweep(Frame& F) {
    const int gw = F.vcu * NWAVES + F.wave, NGW = F.G * NWAVES;
    LAS unsigned char* dig = F.lds + RING_OFF + F.wave * 8192;
    LAS unsigned* list = (LAS unsigned*)(F.lds + RING_OFF + 65536 + F.wave * 2176);
#pragma unroll 1
    for (int half = 0; half < 2; ++half) peer_dots_pass<MODE, false>(F, 4 * half, 4, gw, NGW, dig, list, nullptr);
}
#endif
#ifndef PEER_VSWEEP
#define PEER_VSWEEP 0
#endif
#ifndef PEER_ROLES
#define PEER_ROLES 1
#endif
#ifndef PEER_VDEEP
#define PEER_VDEEP 0
#endif
#ifndef PEER_VSORT
#define PEER_VSORT 1
#endif
#ifndef PEER_VBAR
#define PEER_VBAR 1
#endif
#if PEER_UI4 && PEER_VSWEEP
#ifndef VS_SHIFT
#define VS_SHIFT 11
#endif
template <int MODE> __device__ __forceinline__ void peer_vsweep_pass(Frame& F, const float* ada, const float* final_g_, const int pass) {
    const float* final_g = final_g_; asm volatile("" : "+s"(final_g));
    const int gw = F.vcu * NWAVES + F.wave, NGW = F.G * NWAVES;
    int lane_ = F.lane; asm volatile("" : "+v"(lane_)); const int lane = lane_;
    const unsigned char* V8 = F.ws + WS_V8;
    const float* SU = (const float*)(F.ws + WS_SCU); const float* SV = (const float*)(F.ws + WS_SCV);
    const int* EI = (const int*)(F.ws + WS_EIDX); const float* EGp = (const float*)(F.ws + WS_EG); const float* AP = (const float*)(F.ws + WS_AP);
    LAS unsigned* le = (LAS unsigned*)(F.lds + RING_OFF + F.wave * 8192);
    LAS float* lc = (LAS float*)(le + 384);
    int evr[2][2]; float cfr[2][2];
#pragma unroll
    for (int tl = 0; tl < 2; ++tl) { const int t = gw + NGW * (2 * pass + tl);
        const float sa2 = ((const float*)(F.ws + WS_SA2))[t];
        const int ev0 = EI[(size_t)t * 128 + lane], ev1 = EI[(size_t)t * 128 + 64 + lane];
        const float gv0 = EGp[(size_t)t * 128 + lane], gv1 = EGp[(size_t)t * 128 + 64 + lane];
        const float at0 = AP[(size_t)t * 128 + lane], at1 = AP[(size_t)t * 128 + 64 + lane];
        const float su0 = SU[ev0], su1 = SU[ev1], sv0 = SV[ev0], sv1 = SV[ev1];
        const pg8::f32x2 gl = pg8::gelu_pk((pg8::f32x2){at0 * su0 * sa2, at1 * su1 * sa2});
        evr[tl][0] = ev0; evr[tl][1] = ev1; cfr[tl][0] = gl.x * gv0 * sv0; cfr[tl][1] = gl.y * gv1 * sv1; }
    int n = 0;
#pragma unroll 1
    for (int s = 0; s < (16384 >> VS_SHIFT); ++s) {
#pragma unroll
        for (int tl = 0; tl < 2; ++tl) { const int n0 = n;
#pragma unroll
            for (int h = 0; h < 2; ++h) { const int ev = evr[tl][h]; const bool c = (ev >> VS_SHIFT) == s; const unsigned long long m = __ballot(c);
                const int pos = n + (int)__builtin_amdgcn_mbcnt_hi((unsigned)(m >> 32), __builtin_amdgcn_mbcnt_lo((unsigned)m, 0u));
                if (c) { le[pos] = (unsigned)ev | ((unsigned)tl << 14); lc[pos] = cfr[tl][h]; }
                n += __builtin_popcountll(m); }
            const int padn = (n0 - n) & 3;
            if (lane < padn) { le[n + lane] = ((unsigned)s << VS_SHIFT) | ((unsigned)tl << 14); lc[n + lane] = 0.f; }
            n += padn; }
    }
    if (lane < 4) { le[n + lane] = (7u << 11); lc[n + lane] = 0.f; }
    __builtin_amdgcn_fence(__ATOMIC_RELEASE, "wavefront"); __builtin_amdgcn_wave_barrier();
    const int G4 = ((n + 7) & ~7) >> 2;
    f32x2v acc0[16], acc1[16];
#pragma unroll
    for (int i = 0; i < 16; ++i) { acc0[i] = (f32x2v){0.f, 0.f}; acc1[i] = (f32x2v){0.f, 0.f}; }
    v4u bufA[4], bufB[4]; unsigned entA = 0u, entB = 0u; float cfA = 0.f, cfB = 0.f;
#pragma unroll
    for (int i = 0; i < 4; ++i) { bufA[i] = (v4u){0u, 0u, 0u, 0u}; bufB[i] = (v4u){0u, 0u, 0u, 0u}; }
    v2u bufA2[4], bufB2[4];
#pragma unroll
    for (int i = 0; i < 4; ++i) { bufA2[i] = (v2u){0u, 0u}; bufB2[i] = (v2u){0u, 0u}; }
#define PV_LOAD(BUF, ENT, CF, g_) do { ENT = le[4 * (g_) + (lane & 3)]; CF = lc[4 * (g_) + (lane & 3)]; \
        _Pragma("unroll") for (int i_ = 0; i_ < 4; ++i_) { const unsigned e_ = (unsigned)__builtin_amdgcn_readlane((int)ENT, i_) & (MODE == 2 ? 63u : 0x3FFFu); const unsigned char* p_ = V8 + (size_t)e_ * pg8::PEER_ROWB_V; BUF[i_] = *(const v4u*)(p_ + lane * 16); if (!(PEER_V4)) BUF##2[i_] = *(const v2u*)(p_ + 1024 + lane * 8); } } while (0)
#define PV_PROC(BUF, ENT, CF) do { const unsigned tg_ = ((unsigned)__builtin_amdgcn_readlane((int)ENT, 0) >> 14) & 1u; \
        if (tg_ != curtl) { curtl = tg_; _Pragma("unroll") for (int i_ = 0; i_ < 16; ++i_) { const f32x2v t_ = acc0[i_]; acc0[i_] = acc1[i_]; acc1[i_] = t_; } }     \
        _Pragma("unroll") for (int i_ = 0; i_ < 4; ++i_) axpy32_fp6(BUF[i_], BUF##2[i_], __builtin_bit_cast(float, __builtin_amdgcn_readlane(__builtin_bit_cast(int, CF), i_)), acc0); } while (0)
    unsigned curtl = 0u;
    PV_LOAD(bufA, entA, cfA, 0);
#pragma unroll 1
    for (int g = 0; g < G4; g += 2) {
        PV_LOAD(bufB, entB, cfB, g + 1);
        PV_PROC(bufA, entA, cfA);
        if (g + 2 < G4) PV_LOAD(bufA, entA, cfA, g + 2);
        PV_PROC(bufB, entB, cfB);
    }
#undef PV_LOAD
#undef PV_PROC
    __builtin_amdgcn_fence(__ATOMIC_RELEASE, "wavefront"); __builtin_amdgcn_wave_barrier();
#pragma unroll 1
    for (int tl = 0; tl < 2; ++tl) { const int t = gw + NGW * (2 * pass + tl);
        const int b = t / SEQ; float* xo = F.out + (size_t)t * DM; float ss = 0.f; f32x4 x2[8];
#pragma unroll
        for (int q = 0; q < 8; ++q) { const int col = q * 256 + 4 * lane;
            const f32x4 x1 = *(const f32x4*)(xo + col), g2 = *(const f32x4*)(ada + (size_t)b * ADA_W + 5 * DM + col);
            const f32x4 pe = ((unsigned)tl != curtl) ? (f32x4){acc1[2 * q].x, acc1[2 * q].y, acc1[2 * q + 1].x, acc1[2 * q + 1].y} : (f32x4){acc0[2 * q].x, acc0[2 * q].y, acc0[2 * q + 1].x, acc0[2 * q + 1].y};
            x2[q] = x1 + g2 * pe;
            ss += (x2[q].x * x2[q].x + x2[q].y * x2[q].y) + (x2[q].z * x2[q].z + x2[q].w * x2[q].w); }
        const float rstd = __builtin_amdgcn_rsqf(wave_sum(ss) * (1.0f / DM) + EPS);
#pragma unroll
        for (int q = 0; q < 8; ++q) { const int col = q * 256 + 4 * lane; const f32x4 fg = *(const f32x4*)(final_g + col);
            if (MODE == 0) *(f32x4*)(xo + col) = x2[q] * rstd * fg; else asm volatile("" :: "v"(x2[q] * rstd * fg)); } }
}
#endif
__device__ __forceinline__ void peer_main(Frame& F, const float* ada, const float* final_g, const XcdBarrier* barp) {
    const int gw = F.vcu * NWAVES + F.wave, NGW = F.G * NWAVES;
    int lane_ = F.lane; asm volatile("" : "+v"(lane_)); const int lane = lane_;
    const bf16* H2 = (const bf16*)(F.ws + WS_H2); const unsigned char* U8 = F.ws + WS_U8; const unsigned char* V8 = F.ws + WS_V8;
    const float* SU = (const float*)(F.ws + WS_SCU); const float* SV = (const float*)(F.ws + WS_SCV);
    const int* EI = (const int*)(F.ws + WS_EIDX); const float* EGp = (const float*)(F.ws + WS_EG);
#if PEER_UI4 && PEER_ROLES
    const int pw = F.wave & 3; const bool is_s = F.wave < 4;
    const int gw2 = F.vcu * 4 + pw, NGW2 = F.G * 4;
    LAS float* apl = (LAS float*)(F.lds + RING_OFF + 81920 + pw * 4096);
    volatile LAS unsigned* flg = (volatile LAS unsigned*)(F.lds + RING_OFF + 98304) + pw * 2;
    if (F.tid < 8) ((volatile LAS unsigned*)(F.lds + RING_OFF + 98304))[F.tid] = 0u;
    __syncthreads();
#define PR_START(p_) ((p_) == 0 ? 0 : ((p_) == 1 ? 1 : 4 * ((p_) - 1)))
    if (is_s) {
        LAS unsigned char* dig = F.lds + RING_OFF + pw * 8192; LAS unsigned* list = (LAS unsigned*)(F.lds + RING_OFF + 65536 + pw * 2176);
#pragma unroll 1
        for (int p = 0; p < 5; ++p) {
            while (p >= 2 && flg[1] + 1u < (unsigned)p) __builtin_amdgcn_s_sleep(8);
            peer_dots_pass<0, true>(F, PR_START(p), PR_START(p + 1) - PR_START(p), gw2, NGW2, dig, list, apl + (p & 1) * 512);
            asm volatile("s_waitcnt lgkmcnt(0)" ::: "memory");
            if (lane == 0) flg[0] = (unsigned)(p + 1);
        }
    }
#pragma unroll 1
    for (int p = is_s ? 4 : 0; p < 5; ++p) {
    while (flg[0] < (unsigned)(p + 1)) __builtin_amdgcn_s_sleep(8);
    asm volatile("" ::: "memory");
    const int tqa = (p == 4 && is_s) ? 14 : PR_START(p), tqb = (p == 4 && !is_s) ? 14 : PR_START(p + 1);
    for (int tq = tqa; tq < tqb; ++tq) { const int t = gw2 + NGW2 * tq; const LAS float* apsrc = apl + (p & 1) * 512 + (tq - PR_START(p)) * 128;
        int lane_t = lane_; asm volatile("" : "+v"(lane_t)); const int lane = lane_t;
        const float sa2 = ((const float*)(F.ws + WS_SA2))[t];
#elif PEER_UI4
#ifdef PROBE_SWEEP_DUP
    peer_dots_sweep<PROBE_SWEEP_DUP>(F);
#endif
    peer_dots_sweep<0>(F);
    __threadfence();
#if PEER_VSWEEP
#pragma unroll 1
    for (int pass = 0; pass < 4; ++pass) {
#if PEER_VBAR
        if (barp) xcd_barrier(*barp);
#endif
#ifdef PROBE_VSWEEP_DUP
        peer_vsweep_pass<PROBE_VSWEEP_DUP>(F, ada, final_g, pass);
#endif
        peer_vsweep_pass<0>(F, ada, final_g, pass);
    }
    return;
#endif
#endif
#if !(PEER_UI4 && PEER_ROLES)
    for (int t = gw; t < T; t += NGW) {
#endif
#if PEER_UI4 && PEER_ROLES
#elif PEER_UI4
#ifdef PROBE_TOKBAR
        if (barp && (((t - gw) / NGW) % PROBE_TOKBAR) == 0) xcd_barrier(*barp);
#endif
        const float sa2 = ((const float*)(F.ws + WS_SA2))[t];
#elif I8_Q
        f32x2v hf[16];
#pragma unroll
        for (int q = 0; q < 8; ++q) { const int a = *(const int*)((const unsigned char*)H2 + (size_t)t * DM + q * 256 + 4 * lane);
            hf[2 * q] = (f32x2v){(float)((a << 24) >> 24), (float)((a << 16) >> 24)}; hf[2 * q + 1] = (f32x2v){(float)((a << 8) >> 24), (float)(a >> 24)}; }
        const float sa2 = ((const float*)(F.ws + WS_SA2))[t];
#else
        f32x2v hf[16];
#pragma unroll
        for (int q = 0; q < 8; ++q) { const v2u a = *(const v2u*)(H2 + (size_t)t * DM + q * 256 + 4 * lane);
            hf[2 * q] = (f32x2v){bf_lo(a.x), bf_hi(a.x)}; hf[2 * q + 1] = (f32x2v){bf_lo(a.y), bf_hi(a.y)}; }
        const float sa2 = 1.0f;
#endif
        int ev0 = EI[(size_t)t * 128 + lane], ev1 = EI[(size_t)t * 128 + 64 + lane];
        const float gv0 = EGp[(size_t)t * 128 + lane], gv1 = EGp[(size_t)t * 128 + 64 + lane];
        const float su0 = SU[ev0], su1 = SU[ev1], sv0 = SV[ev0], sv1 = SV[ev1];
        v4u bufA[4], bufB[4]; v2u bufA2[4], bufB2[4];
#define PM_EMASK 0x7FFFFFFF
#define PM_LOAD(BUF, BUF2, TAB, RB, F4, g) do { const int evs_ = ((g) >= 16) ? ev1 : ev0; _Pragma("unroll") for (int i_ = 0; i_ < 4; ++i_) { const int e_ = __builtin_amdgcn_readlane(evs_, (4 * (g) + i_) & 63) & PM_EMASK; \
            const unsigned char* p_ = (TAB) + (size_t)e_ * (RB); BUF[i_] = *(const v4u*)(p_ + lane * 16); if (!(F4)) BUF2[i_] = *(const v2u*)(p_ + 1024 + lane * 8); else BUF2[i_] = (v2u){0u, 0u}; } } while (0)
#if PEER_UI4
#if PEER_ROLES
        float at0 = apsrc[lane], at1 = apsrc[64 + lane];
#else
        float at0 = ((const float*)(F.ws + WS_AP))[(size_t)t * 128 + lane], at1 = ((const float*)(F.ws + WS_AP))[(size_t)t * 128 + 64 + lane];
#endif
#else
        float at0 = 0.f, at1 = 0.f;
#ifdef PROBE_PEER_LOADL2
#undef PM_EMASK
#define PM_EMASK 2047
#define PROBE_PEER_LOADONLY 1
#endif
#ifdef PROBE_PEER_LOADDEEP
        { unsigned dz = 0u; v4u bufC[4], bufD[4]; v2u bufC2[4], bufD2[4];
#define PM_EAT(B) _Pragma("unroll") for (int i = 0; i < 4; ++i) dz ^= (B[i].x ^ B[i].y) ^ (B[i].z ^ B[i].w);
          PM_LOAD(bufA, bufA2, V8, pg8::PEER_ROWB_V, PEER_V4, 0); PM_LOAD(bufB, bufB2, V8, pg8::PEER_ROWB_V, PEER_V4, 1); PM_LOAD(bufC, bufC2, V8, pg8::PEER_ROWB_V, PEER_V4, 2);
#pragma unroll 1
          for (int g4 = 0; g4 < 32; g4 += 4) {
              PM_LOAD(bufD, bufD2, V8, pg8::PEER_ROWB_V, PEER_V4, g4 + 3); PM_EAT(bufA)
              if (g4 + 4 < 32) PM_LOAD(bufA, bufA2, V8, pg8::PEER_ROWB_V, PEER_V4, g4 + 4); PM_EAT(bufB)
              if (g4 + 4 < 32) PM_LOAD(bufB, bufB2, V8, pg8::PEER_ROWB_V, PEER_V4, g4 + 5); PM_EAT(bufC)
              if (g4 + 4 < 32) PM_LOAD(bufC, bufC2, V8, pg8::PEER_ROWB_V, PEER_V4, g4 + 6); PM_EAT(bufD)
          }
#undef PM_EAT
          asm volatile("" :: "v"(dz)); }
#endif
#ifdef PROBE_PEER_LOADONLY
        { unsigned dz = 0u;
          PM_LOAD(bufA, bufA2, V8, pg8::PEER_ROWB_V, PEER_V4, 0);
#pragma unroll 1
          for (int g2 = 0; g2 < 32; g2 += 2) {
              PM_LOAD(bufB, bufB2, V8, pg8::PEER_ROWB_V, PEER_V4, g2 + 1);
#pragma unroll
              for (int i = 0; i < 4; ++i) dz ^= (bufA[i].x ^ bufA[i].y) ^ (bufA[i].z ^ bufA[i].w);
              if (g2 + 2 < 32) PM_LOAD(bufA, bufA2, V8, pg8::PEER_ROWB_V, PEER_V4, g2 + 2);
#pragma unroll
              for (int i = 0; i < 4; ++i) dz ^= (bufB[i].x ^ bufB[i].y) ^ (bufB[i].z ^ bufB[i].w);
          }
          asm volatile("" :: "v"(dz)); }
#endif
#undef PM_EMASK
#define PM_EMASK 0x7FFFFFFF
#ifdef PROBE_PEER_A2
#pragma unroll 1
        for (int rep_ = 0; rep_ < 2; ++rep_) {
#else
        {
#endif
        PM_LOAD(bufA, bufA2, U8, pg8::PEER_ROWB_U, PEER_U4, 0);
#pragma unroll 1
        for (int sg = 0; sg < 8; ++sg) {
            float part[16]; const int g0 = 4 * sg;
            PM_LOAD(bufB, bufB2, U8, pg8::PEER_ROWB_U, PEER_U4, g0 + 1);
#pragma unroll
            for (int i = 0; i < 4; ++i) part[i] = dot32_fp6(bufA[i], bufA2[i], hf);
            PM_LOAD(bufA, bufA2, U8, pg8::PEER_ROWB_U, PEER_U4, g0 + 2);
#pragma unroll
            for (int i = 0; i < 4; ++i) part[4 + i] = dot32_fp6(bufB[i], bufB2[i], hf);
            PM_LOAD(bufB, bufB2, U8, pg8::PEER_ROWB_U, PEER_U4, g0 + 3);
#pragma unroll
            for (int i = 0; i < 4; ++i) part[8 + i] = dot32_fp6(bufA[i], bufA2[i], hf);
            if (sg < 7) PM_LOAD(bufA, bufA2, U8, pg8::PEER_ROWB_U, PEER_U4, g0 + 4);
#pragma unroll
            for (int i = 0; i < 4; ++i) part[12 + i] = dot32_fp6(bufB[i], bufB2[i], hf);
#define PM_STAGE(N, OFF) _Pragma("unroll") for (int i = 0; i < (N); ++i) { const bool up_ = (lane & (OFF)) != 0; const float send = up_ ? part[i] : part[i + (N)]; const float keep = up_ ? part[i + (N)] : part[i]; part[i] = keep + __shfl_xor(send, (OFF)); }
            PM_STAGE(8, 8) PM_STAGE(4, 4) PM_STAGE(2, 2) PM_STAGE(1, 1)
#undef PM_STAGE
            float tot = part[0]; tot += __shfl_xor(tot, 16); tot += __shfl_xor(tot, 32);
            const bool mine = (lane >> 4) == (sg & 3);
            if (sg < 4) at0 = mine ? tot : at0; else at1 = mine ? tot : at1;
        }
        }
#endif
        float cf0, cf1;
        { const pg8::f32x2 gl = pg8::gelu_pk((pg8::f32x2){at0 * su0 * sa2, at1 * su1 * sa2}); cf0 = gl.x * gv0 * sv0; cf1 = gl.y * gv1 * sv1; }
#if PEER_UI4 && PEER_VSORT
        { LAS unsigned* le = (LAS unsigned*)(F.lds + RING_OFF + F.wave * 8192); LAS float* lc = (LAS float*)(le + 128); int n = 0;
#pragma unroll 1
          for (int s = 0; s < 8; ++s) {
#pragma unroll
              for (int h = 0; h < 2; ++h) { const int ev = h ? ev1 : ev0; const bool c = (ev >> 11) == s; const unsigned long long m = __ballot(c);
                  const int pos = n + (int)__builtin_amdgcn_mbcnt_hi((unsigned)(m >> 32), __builtin_amdgcn_mbcnt_lo((unsigned)m, 0u));
                  if (c) { le[pos] = (unsigned)ev; lc[pos] = h ? cf1 : cf0; }
                  n += __builtin_popcountll(m); } }
          __builtin_amdgcn_fence(__ATOMIC_RELEASE, "wavefront"); __builtin_amdgcn_wave_barrier();
          ev0 = (int)le[lane]; ev1 = (int)le[64 + lane]; cf0 = lc[lane]; cf1 = lc[64 + lane];
          __builtin_amdgcn_fence(__ATOMIC_RELEASE, "wavefront"); __builtin_amdgcn_wave_barrier(); }
#endif
        f32x2v acc[16];
#pragma unroll
        for (int i = 0; i < 16; ++i) acc[i] = (f32x2v){0.f, 0.f};
#ifdef PROBE_PEER_VALU
        f32x2v accd[16];
#pragma unroll
        for (int i = 0; i < 16; ++i) accd[i] = (f32x2v){0.f, 0.f};
#endif
#if PEER_UI4 && PEER_ROLES && PEER_VDEEP
        {
          v4u bufC[4]; v2u bufC2[4];
#define PM_AXPY(BUF, BUF2, g_) do { const int cfs_ = __builtin_bit_cast(int, ((g_) >= 16) ? cf1 : cf0); \
            _Pragma("unroll") for (int i = 0; i < 4; ++i) { axpy32_fp6(BUF[i], BUF2[i], __builtin_bit_cast(float, __builtin_amdgcn_readlane(cfs_, (4 * (g_) + i) & 63)), acc); __builtin_amdgcn_sched_barrier(0); } } while (0)
          PM_LOAD(bufA, bufA2, V8, pg8::PEER_ROWB_V, PEER_V4, 0); PM_LOAD(bufB, bufB2, V8, pg8::PEER_ROWB_V, PEER_V4, 1);
#pragma unroll 1
          for (int g3 = 0; g3 < 30; g3 += 3) {
              PM_LOAD(bufC, bufC2, V8, pg8::PEER_ROWB_V, PEER_V4, g3 + 2); PM_AXPY(bufA, bufA2, g3);
              PM_LOAD(bufA, bufA2, V8, pg8::PEER_ROWB_V, PEER_V4, g3 + 3); PM_AXPY(bufB, bufB2, g3 + 1);
              PM_LOAD(bufB, bufB2, V8, pg8::PEER_ROWB_V, PEER_V4, (g3 + 4) & 31); PM_AXPY(bufC, bufC2, g3 + 2);
          }
          PM_AXPY(bufA, bufA2, 30); PM_AXPY(bufB, bufB2, 31);
#undef PM_AXPY
        }
#else
        PM_LOAD(bufA, bufA2, V8, pg8::PEER_ROWB_V, PEER_V4, 0);
#pragma unroll 1
        for (int g2 = 0; g2 < 32; g2 += 2) {
            PM_LOAD(bufB, bufB2, V8, pg8::PEER_ROWB_V, PEER_V4, g2 + 1);
            { const int cfs = __builtin_bit_cast(int, (g2 >= 16) ? cf1 : cf0);
#pragma unroll
              for (int i = 0; i < 4; ++i) { const float c = __builtin_bit_cast(float, __builtin_amdgcn_readlane(cfs, (4 * g2 + i) & 63)); axpy32_fp6(bufA[i], bufA2[i], c, acc);
#ifdef PROBE_PEER_VALU
                axpy32_fp6(bufA[i], bufA2[i], c * 0.5f, accd);
#endif
              } }
            if (g2 + 2 < 32) PM_LOAD(bufA, bufA2, V8, pg8::PEER_ROWB_V, PEER_V4, g2 + 2);
            { const int cfs = __builtin_bit_cast(int, (g2 + 1 >= 16) ? cf1 : cf0);
#pragma unroll
              for (int i = 0; i < 4; ++i) { const float c = __builtin_bit_cast(float, __builtin_amdgcn_readlane(cfs, (4 * (g2 + 1) + i) & 63)); axpy32_fp6(bufB[i], bufB2[i], c, acc);
#ifdef PROBE_PEER_VALU
                axpy32_fp6(bufB[i], bufB2[i], c * 0.5f, accd);
#endif
              } }
        }
#endif
#undef PM_LOAD
#ifdef PROBE_PEER_VALU
#pragma unroll
        for (int i = 0; i < 16; ++i) asm volatile("" :: "v"(accd[i]));
#endif
        const int b = t / SEQ; float* xo = F.out + (size_t)t * DM; float ss = 0.f; f32x4 x2[8];
#pragma unroll
        for (int q = 0; q < 8; ++q) { const int col = q * 256 + 4 * lane;
            const f32x4 x1 = *(const f32x4*)(xo + col), g2 = *(const f32x4*)(ada + (size_t)b * ADA_W + 5 * DM + col);
            const f32x4 pe = {acc[2 * q].x, acc[2 * q].y, acc[2 * q + 1].x, acc[2 * q + 1].y};
            x2[q] = x1 + g2 * pe;
            ss += (x2[q].x * x2[q].x + x2[q].y * x2[q].y) + (x2[q].z * x2[q].z + x2[q].w * x2[q].w); }
        const float rstd = __builtin_amdgcn_rsqf(wave_sum(ss) * (1.0f / DM) + EPS);
#pragma unroll
        for (int q = 0; q < 8; ++q) { const int col = q * 256 + 4 * lane; const f32x4 fg = *(const f32x4*)(final_g + col);
            *(f32x4*)(xo + col) = x2[q] * rstd * fg; }
    }
#if PEER_UI4 && PEER_ROLES
    asm volatile("s_waitcnt lgkmcnt(0)" ::: "memory");
    if (lane == 0) flg[1] = (unsigned)(p + 1);
    }
#undef PR_START
#endif
}


struct Args { const void* in[25]; float* out; unsigned char* ws; int ph_lo, ph_hi; };
__global__ void __launch_bounds__(NWAVES * 64, 2) mk_fwd(Args args) {
    extern __shared__ __attribute__((aligned(16))) unsigned char lds[];
    Frame F;
    F.lds = (LAS unsigned char*)lds; F.ldsg = lds;
    F.MISC = (volatile LAS unsigned*)(F.lds + MISC_OFF);
    F.tid = threadIdx.x; F.lane = F.tid & 63; F.wave = __builtin_amdgcn_readfirstlane(F.tid >> 6);
    F.G = gridDim.x; { const int bx = blockIdx.x; F.vcu = (F.G % 8 == 0) ? (bx % 8) * (F.G / 8) + bx / 8 : bx; }
    F.ws = args.ws; F.out = args.out; F.ctl = (gu32*)(args.ws + WS_CTL);
    for (int u = F.tid; u < (LDS_BYTES - LDSCTL_OFF) / 4; u += NWAVES * 64) ((LAS unsigned*)(F.lds + LDSCTL_OFF))[u] = 0u;
    __syncthreads();
    XcdBarrier bar; bar.bar = (unsigned*)(F.ctl + CW_BAR); bar.x = 0; bar.st = nullptr;
    if (N_LAUNCHES == 1) bar = xcd_barrier_post((unsigned*)(F.ctl + CW_BAR), F.MISC + 8);
#ifdef DOUBLE_BAR
#define GRID_BAR() do { if (N_LAUNCHES == 1) { xcd_barrier(bar); xcd_barrier(bar); } } while (0)
#else
#define GRID_BAR() do { if (N_LAUNCHES == 1) xcd_barrier(bar); } while (0)
#endif
    const int lo = args.ph_lo, hi = args.ph_hi;
#ifndef G1_SP2
#define G1_SP2 true
#endif
#ifndef G1_ALIGN
#define G1_ALIGN true
#endif
#ifndef PH_MASK
#define PH_MASK 0xFFFF
#endif
#define IN(k) ((((PH_MASK) >> (k)) & 1) && lo <= (k) && (k) < hi)
#define BOTH(k) (IN(k) && IN((k) + 1))
#ifndef DUP_MASK
#define DUP_MASK 0
#endif
#define REPS(k) for (int rep_ = 0; rep_ < ((((DUP_MASK) >> (k)) & 1) ? 2 : 1); ++rep_)
    const float* x = IN_F(0); const float* ada = (const float*)(F.ws + WS_ADA);

    if (IN(0)) REPS(0) { p0_prologue<0>(F, IN_F(1), (const int*)args.in[2], IN_F(3), IN_F(4), IN_F(6), IN_F(15), IN_F(16), IN_F(17), IN_F(19)); if (BOTH(0)) GRID_BAR(); }
    if (IN(1)) REPS(1) { p0_prologue<1>(F, IN_F(1), (const int*)args.in[2], IN_F(3), IN_F(4), IN_F(6), IN_F(15), IN_F(16), IN_F(17), IN_F(19)); mod_rows_i8(F, x, IN_F(5), ada + 0 * DM, ada + 1 * DM, F.ws + WS_H, (float*)(F.ws + WS_SA)); if (BOTH(1)) GRID_BAR(); }
    if (IN(2)) REPS(2) {
        pg8::Gemm g{(const bf16*)(F.ws + WS_H), (const bf16*)(F.ws + WS_WIN), T, IN_W, DM / 2}; pg8::StaticOrder S; S.init(T, IN_W, F.G, (int)blockIdx.x);
        pg8::EpiG1 E; E.ws = F.ws; E.positions = (const int*)args.in[2]; E.sa = (const float*)(F.ws + WS_SA); E.sb = (const float*)(F.ws + WS_SB) + CM_IN / 256;
        E.tsrc_u = IN_F(22); E.tsrc_v = IN_F(23); E.tdst_u = F.ws + WS_U8; E.tdst_v = F.ws + WS_V8; E.tsc_u = (float*)(F.ws + WS_SCU); E.tsc_v = (float*)(F.ws + WS_SCV); E.cnt = 0;
#ifndef G1_STAGGER_MASK
#define G1_STAGGER_MASK 3
#endif
#ifdef G1_STAGGER_TICKS
        { const unsigned long long t0_ = rt(); const unsigned long long d_ = (unsigned long long)(blockIdx.x & G1_STAGGER_MASK) * G1_STAGGER_TICKS; while (rt() - t0_ < d_) __builtin_amdgcn_s_sleep(8); }
#endif
#ifdef PROBE_G1_VAR
        { pg8::EpiG1T<PROBE_G1_VAR> EV; EV.ws = F.ws; EV.positions = E.positions; EV.sa = E.sa; EV.sb = E.sb; EV.cnt = 8; pg8::gemm_phase<pg8::EpiG1T<PROBE_G1_VAR>, pg8::StaticOrder, true, true, true>(F.lds + RING_OFF, g, S, EV); }
#endif
        pg8::gemm_phase<pg8::EpiG1, pg8::StaticOrder, G1_ALIGN, G1_SP2, true>(F.lds + RING_OFF, g, S, E);
#ifdef PROBE_G1_NULL
        { pg8::EpiNull EN; pg8::gemm_phase<pg8::EpiNull, pg8::StaticOrder, true, true, true>(F.lds + RING_OFF, g, S, EN); }
#endif
        if (BOTH(2)) GRID_BAR();
    }
    if (IN(3)) REPS(3) {
        for (int r2_ = 0; r2_ < ((((DUP_MASK) >> 11) & 1) ? 2 : 1); ++r2_) if ((PH_MASK >> 11) & 1) for (int it = F.vcu; it < 256; it += F.G) hgrn_item(F, it, IN_F(12), IN_F(13));
        float lam;
        { float s1 = 0.f, s2 = 0.f; const float* q1 = IN_F(7); const float* k1 = IN_F(8); const float* q2 = IN_F(9); const float* k2 = IN_F(10);
          for (int i = 0; i < 64; ++i) { s1 += q1[i] * k1[i]; s2 += q2[i] * k2[i]; }
          lam = __expf(s1) - __expf(s2) + LAMBDA_INIT; }
        for (int r2_ = 0; r2_ < ((((DUP_MASK) >> 12) & 1) ? 2 : 1); ++r2_) if ((PH_MASK >> 12) & 1) for (int u = F.vcu; u < 512; u += F.G) attn_unit(F, u, lam, IN_F(11));
        if (BOTH(3)) GRID_BAR();
    }
    if (IN(4)) REPS(4) { hgrn_combine(F, IN_F(14)); if (BOTH(4)) GRID_BAR(); }
    if (IN(5)) REPS(5) {
#if I8_AB
        { pg8::Gemm g{(const bf16*)(F.ws + WS_OA8), (const bf16*)(F.ws + WS_WA), T, DM, 512}; pg8::StaticOrder S; S.init(T, DM, F.G, (int)blockIdx.x);
          pg8::EpiGate<false> E{(bf16*)(F.ws + WS_Y), (const bf16*)(F.ws + WS_GA), DM, (const float*)(F.ws + WS_SAO), (const float*)(F.ws + WS_SB) + CM_A / 256};
          pg8::gemm_phase<pg8::EpiGate<false>, pg8::StaticOrder, true, true, true>(F.lds + RING_OFF, g, S, E); }
        { pg8::Gemm g{(const bf16*)(F.ws + WS_OB), (const bf16*)(F.ws + WS_WB), T, DM, 512}; pg8::StaticOrder S; S.init(T, DM, F.G, (int)blockIdx.x);
          pg8::EpiGate<true> E{(bf16*)(F.ws + WS_Y), (const bf16*)(F.ws + WS_GB), DM, (const float*)(F.ws + WS_SAB), (const float*)(F.ws + WS_SB) + CM_B / 256};
          pg8::gemm_phase<pg8::EpiGate<true>, pg8::StaticOrder, true, true, true>(F.lds + RING_OFF, g, S, E); }
#else
        { pg8::Gemm g{(const bf16*)(F.ws + WS_OA), (const bf16*)(F.ws + WS_WA), T, DM, 1024}; pg8::StaticOrder S; S.init(T, DM, F.G, (int)blockIdx.x);
          pg8::EpiGate<false> E{(bf16*)(F.ws + WS_Y), (const bf16*)(F.ws + WS_GA), DM, nullptr, nullptr};
          pg8::gemm_phase<pg8::EpiGate<false>, pg8::StaticOrder, true, true>(F.lds + RING_OFF, g, S, E); }
        { pg8::Gemm g{(const bf16*)(F.ws + WS_OB), (const bf16*)(F.ws + WS_WB), T, DM, 1024}; pg8::StaticOrder S; S.init(T, DM, F.G, (int)blockIdx.x);
          pg8::EpiGate<true> E{(bf16*)(F.ws + WS_Y), (const bf16*)(F.ws + WS_GB), DM, nullptr, nullptr};
          pg8::gemm_phase<pg8::EpiGate<true>, pg8::StaticOrder, true, true>(F.lds + RING_OFF, g, S, E); }
#endif
#if I8_O
        GRID_BAR();
        quant_rows_bf16(F, (const bf16*)(F.ws + WS_Y), F.ws + WS_Y8, (float*)(F.ws + WS_SAY));
#endif
        if (BOTH(5)) GRID_BAR();
    }
    if (IN(6)) REPS(6) {
#if I8_O
        pg8::Gemm g{(const bf16*)(F.ws + WS_Y8), (const bf16*)(F.ws + WS_WOUT), T, DM, DM / 2}; pg8::StaticOrder S; S.init(T, DM, F.G, (int)blockIdx.x);
        pg8::EpiResGate E{x, F.out, ada + 2 * DM, DM, ADA_W, SEQ, (const float*)(F.ws + WS_SAY), (const float*)(F.ws + WS_SB) + CM_O / 256};
        pg8::gemm_phase<pg8::EpiResGate, pg8::StaticOrder, true, true, true>(F.lds + RING_OFF, g, S, E);
#else
        pg8::Gemm g{(const bf16*)(F.ws + WS_Y), (const bf16*)(F.ws + WS_WOUT), T, DM, DM}; pg8::StaticOrder S; S.init(T, DM, F.G, (int)blockIdx.x);
        pg8::EpiResGate E{x, F.out, ada + 2 * DM, DM, ADA_W, SEQ, nullptr, nullptr};
        pg8::gemm_phase<pg8::EpiResGate, pg8::StaticOrder, true, true>(F.lds + RING_OFF, g, S, E);
#endif
        if (BOTH(6)) GRID_BAR();
    }
    if (IN(7)) REPS(7) {
#if I8_Q
        mod_rows_i8<(PEER_UI4 != 0) ? 119 : 127>(F, F.out, IN_F(18), ada + 3 * DM, ada + 4 * DM, F.ws + WS_H2, (float*)(F.ws + WS_SA2));
#else
        mod_rows(F, F.out, IN_F(18), ada + 3 * DM, ada + 4 * DM, (bf16*)(F.ws + WS_H2));
#endif
        if (BOTH(7)) GRID_BAR();
    }
    if (IN(8)) REPS(8) {
#if I8_Q
        pg8::Gemm g{(const bf16*)(F.ws + WS_H2), (const bf16*)(F.ws + WS_WQ), T, DM, DM / 2}; pg8::StaticOrder S; S.init(T, DM, F.G, (int)blockIdx.x);
        pg8::EpiPlainS E{(bf16*)(F.ws + WS_QP), DM, (const float*)(F.ws + WS_SA2), (const float*)(F.ws + WS_SBC)};
        pg8::gemm_phase<pg8::EpiPlainS, pg8::StaticOrder, true, true, true>(F.lds + RING_OFF, g, S, E);
#else
        pg8::Gemm g{(const bf16*)(F.ws + WS_H2), (const bf16*)(F.ws + WS_WQ), T, DM, DM}; pg8::StaticOrder S; S.init(T, DM, F.G, (int)blockIdx.x);
        pg8::EpiPlain E{(bf16*)(F.ws + WS_QP), DM};
        pg8::gemm_phase<pg8::EpiPlain, pg8::StaticOrder, true, true>(F.lds + RING_OFF, g, S, E);
#endif
        if (BOTH(8)) GRID_BAR();
    }
    if (IN(9)) REPS(9) { for (int u = F.vcu; u < 512; u += F.G) peer_route_unit(F, u, IN_F(20), IN_F(21)); if (BOTH(9)) GRID_BAR(); }
    if (IN(10)) REPS(10) { peer_main(F, ada, IN_F(24), (N_LAUNCHES == 1) ? &bar : nullptr); }
#undef IN
#undef BOTH
#undef GRID_BAR
}

extern "C" void kernel_launch(void* const* d_in, const int* in_sizes, int n_in, void* d_out, int out_size, void* d_ws, size_t ws_size, hipStream_t stream) {
    static int grid = 0;
    if (grid == 0) {
        if (n_in != 25 || in_sizes[0] != T * DM || out_size != T * DM || ws_size < WS_END) {
            fprintf(stderr, "kernel_launch: shape/workspace mismatch: n_in %d in0 %d out %d ws %zu (need >= %zu)\n", n_in, n_in > 0 ? in_sizes[0] : -1, out_size, ws_size, (size_t)WS_END); grid = -1; return; }
        int dev = 0, cus = 0, per_cu = 0;
        if (hipGetDevice(&dev) != hipSuccess || hipDeviceGetAttribute(&cus, hipDeviceAttributeMultiprocessorCount, dev) != hipSuccess) { fprintf(stderr, "kernel_launch: device query failed\n"); grid = -1; return; }
        if (hipFuncSetAttribute((const void*)mk_fwd, hipFuncAttributeMaxDynamicSharedMemorySize, LDS_BYTES) != hipSuccess) { fprintf(stderr, "kernel_launch: hipFuncSetAttribute failed\n"); grid = -1; return; }
        if (hipOccupancyMaxActiveBlocksPerMultiprocessor(&per_cu, (const void*)mk_fwd, NWAVES * 64, LDS_BYTES) != hipSuccess || per_cu < 1) {
            fprintf(stderr, "kernel_launch: occupancy query reports %d workgroups per CU\n", per_cu); (void)hipGetLastError(); per_cu = 1; }
        grid = cus;
        if (grid != 256) { fprintf(stderr, "kernel_launch: built for a 256-CU device (got %d)\n", cus); grid = -1; return; }
    }
    if (grid < 0) return;
    if (hipMemsetAsync((char*)d_ws + WS_CTL, 0, CTL_ZERO_BYTES, stream) != hipSuccess) { fprintf(stderr, "kernel_launch: memset failed\n"); return; }
    Args a{};
    for (int i = 0; i < 25; ++i) a.in[i] = d_in[i];
    a.out = (float*)d_out; a.ws = (unsigned char*)d_ws;
    for (int li = 0; li < N_LAUNCHES; ++li) {
        a.ph_lo = (N_LAUNCHES == 1) ? 0 : li; a.ph_hi = (N_LAUNCHES == 1) ? N_PHASES : li + 1;
        hipLaunchKernelGGL(mk_fwd, dim3(grid), dim3(NWAVES * 64), LDS_BYTES, stream, a);
        const hipError_t le = hipPeekAtLastError();
        if (le != hipSuccess) { fprintf(stderr, "kernel_launch: launch %d failed: %s\n", li, hipGetErrorName(le)); break; }
    }
}
```

```cpp
#include <hip/hip_runtime.h>
#include <cstdio>
#include <cstdint>
namespace pg8 {
#define PG8_LAS __attribute__((address_space(3)))
typedef unsigned short bf16_t;
typedef short bf16x8 __attribute__((ext_vector_type(8)));
typedef float f32x4 __attribute__((ext_vector_type(4)));
typedef unsigned u32x4 __attribute__((ext_vector_type(4)));
constexpr int BM = 256, BK = 64, HALF = 128, HTB = HALF * BK * 2  , STAGE_BYTES = 8 * HTB, NXCD = 8, WGM = 8;

__host__ __device__ __forceinline__ int lds_byte(int r, int c) { const int st = (r >> 4) * 2 + (c >> 5), rr = r & 15, cc = c & 31, ob = rr * 64 + cc * 2; return st * 1024 + (ob ^ (((ob >> 9) & 1) << 5)); }
__host__ __device__ __forceinline__ void stage_rc(int b, int& R, int& C) { const int st = b / 1024, sb = b % 1024, swz = sb ^ (((sb >> 9) & 1) << 5); R = (st >> 1) * 16 + swz / 64; C = (st & 1) * 32 + (swz % 64) / 2; }
__host__ __device__ __forceinline__ int perm32(int rho) { const int n = rho >> 4, i = rho & 15; return 8 * (i >> 2) + 4 * n + (i & 3); }

struct Unit { int pm, pn; };
struct Gemm { const bf16_t* A; const bf16_t* Bt; int M, N, K; };

struct StaticOrder {
    int nM, nN, nwg, G, c;
    __host__ __device__ void init(int M, int N, int G_, int c_) { nM = M / BM; nN = N / BM; nwg = nM * nN; G = G_; c = c_; }
    __host__ __device__ bool next(int i, Unit& u) const {
        const long L = (long)i * G + c; if (L >= nwg) return false;
        int wgid = (int)L; { const int q = nwg / NXCD, r = nwg % NXCD, xcd = wgid % NXCD, off = wgid / NXCD; wgid = (xcd < r ? xcd * (q + 1) : r * (q + 1) + (xcd - r) * q) + off; }
        const int nig = WGM * nN, gid = wgid / nig, fm = gid * WGM, gsz = (nM - fm) < WGM ? (nM - fm) : WGM;
        u.pm = fm + ((wgid % nig) % gsz); u.pn = (wgid % nig) / gsz; return true;
    }
    __device__ __forceinline__ bool next_inl(int i, int& pm, int& pn) const {
        const long L = (long)i * G + c; if (L >= nwg) return false;
        int wgid = (int)L; { const int q = nwg / NXCD, r = nwg % NXCD, xcd = wgid % NXCD, off = wgid / NXCD; wgid = (xcd < r ? xcd * (q + 1) : r * (q + 1) + (xcd - r) * q) + off; }
        const int nig = WGM * nN, gid = wgid / nig, fm = gid * WGM, gsz = (nM - fm) < WGM ? (nM - fm) : WGM;
        pm = fm + ((wgid % nig) % gsz); pn = (wgid % nig) / gsz; return true;
    }
    __device__ __forceinline__ void a_ready(const Unit&) const {}
    __device__ __forceinline__ void done(const Unit&) const {}
};

__device__ __forceinline__ unsigned cvt_pk_bf16(float lo, float hi) { unsigned r; asm volatile("v_cvt_pk_bf16_f32 %0, %1, %2" : "=v"(r) : "v"(lo), "v"(hi)); return r; }
typedef float f32x2 __attribute__((ext_vector_type(2)));
__device__ __forceinline__ f32x2 gelu_pk(f32x2 v) {
    const f32x2 av = __builtin_elementwise_abs(v), d = av * 0.2316418882f + 1.0f;
    f32x2 t; t.x = __builtin_amdgcn_rcpf(d.x); t.y = __builtin_amdgcn_rcpf(d.y);
    f32x2 q = t * 0.5307027145f + (-0.7265760135f); q = q * t + 0.7107068705f; q = q * t + (-0.142248368f); q = q * t + 0.127414796f; q = q * t;
    const f32x2 s = (v * v) * (-0.72134752044f);
    f32x2 e; e.x = __builtin_amdgcn_exp2f(s.x); e.y = __builtin_amdgcn_exp2f(s.y);
    const f32x2 m = v * (q * e), r = v - m;
    f32x2 o; o.x = v.x < 0.f ? m.x : r.x; o.y = v.y < 0.f ? m.y : r.y; return o;
}


__device__ __forceinline__ float fsigmoid(float x) { return __builtin_amdgcn_rcpf(1.0f + __expf(-x)); }
__device__ __forceinline__ float bflo(unsigned u) { return __builtin_bit_cast(float, u << 16); }
__device__ __forceinline__ float bfhi(unsigned u) { return __builtin_bit_cast(float, u & 0xffff0000u); }
#ifndef FP4_CLIP
#define FP4_CLIP 1.0f
#endif
#ifndef TJOB_NT
#define TJOB_NT 0
#endif
#ifndef TJOB_LATE
#define TJOB_LATE 1
#endif
#ifndef X1_BF16
#define X1_BF16 1
#endif
#ifndef G1_NT
#define G1_NT 0
#endif
#ifndef PEER_U4
#define PEER_U4 1
#endif
#ifndef PEER_V4
#define PEER_V4 1
#endif
#ifndef F6_ORDER
#define F6_ORDER 0
#endif
#ifndef PEER_UI4
#define PEER_UI4 1
#endif
#ifndef UI4_STEP
#define UI4_STEP 0.35f
#endif
constexpr int PEER_ROWB_U = PEER_U4 ? 1024 : 1536, PEER_ROWB_V = PEER_V4 ? 1024 : 1536;
constexpr float QSCALE = 0.18033688011112042f;

struct EpiPlain {
    static constexpr bool PERM = true, AFTER_DRAIN = false;
    bf16_t* O; int ldc;
    __device__ __forceinline__ void operator()(const f32x4 (&acc)[2][2][4][2], const Unit& u, int wr, int wc, int fr, int fq) const {
        const int row0 = u.pm * BM + wr * 64 + fr, col0 = u.pn * BM + wc * 32 + 8 * fq;
#pragma unroll
        for (int ai = 0; ai < 2; ++ai)
#pragma unroll
            for (int m = 0; m < 4; ++m) { bf16_t* rowp = O + (size_t)(row0 + ai * HALF + m * 16) * ldc + col0;
#pragma unroll
                for (int bj = 0; bj < 2; ++bj) { const f32x4 v0 = acc[ai][bj][m][0], v1 = acc[ai][bj][m][1];
                    u32x4 w; w.x = cvt_pk_bf16(v0[0], v0[1]); w.y = cvt_pk_bf16(v0[2], v0[3]); w.z = cvt_pk_bf16(v1[0], v1[1]); w.w = cvt_pk_bf16(v1[2], v1[3]);
                    *(u32x4*)(rowp + bj * HALF) = w; } }
    }
};

constexpr size_t G1_MiB = 1u << 20, G1_O0 = 140 * G1_MiB, G1_O1 = 172 * G1_MiB, G1_O2 = 204 * G1_MiB, G1_O3 = 236 * G1_MiB, G1_O4 = 332 * G1_MiB, G1_O5 = 364 * G1_MiB, G1_O6 = 268 * G1_MiB, G1_O7 = 300 * G1_MiB, G1_O8 = 396 * G1_MiB, G1_O9 = 460 * G1_MiB;
struct EpiPlainS {
    static constexpr bool PERM = true, AFTER_DRAIN = false;
    bf16_t* O; int ldc; const float* sa; const float* sb;
    __device__ __forceinline__ void operator()(const f32x4 (&acc)[2][2][4][2], const Unit& u, int wr, int wc, int fr, int fq) const {
        const int row0 = u.pm * BM + wr * 64 + fr, col0 = u.pn * BM + wc * 32 + 8 * fq;
        float rsc[8]; f32x4 csc[2][2];
#pragma unroll
        for (int ai = 0; ai < 2; ++ai)
#pragma unroll
            for (int m = 0; m < 4; ++m) rsc[ai * 4 + m] = sa[row0 + ai * HALF + m * 16];
#pragma unroll
        for (int bj = 0; bj < 2; ++bj) { csc[bj][0] = *(const f32x4*)(sb + col0 + bj * HALF); csc[bj][1] = *(const f32x4*)(sb + col0 + bj * HALF + 4); }
#pragma unroll
        for (int ai = 0; ai < 2; ++ai)
#pragma unroll
            for (int m = 0; m < 4; ++m) { bf16_t* rowp = O + (size_t)(row0 + ai * HALF + m * 16) * ldc + col0;
#pragma unroll
                for (int bj = 0; bj < 2; ++bj) { const f32x4 v0 = acc[ai][bj][m][0] * csc[bj][0] * rsc[ai * 4 + m], v1 = acc[ai][bj][m][1] * csc[bj][1] * rsc[ai * 4 + m];
                    u32x4 w; w.x = cvt_pk_bf16(v0[0], v0[1]); w.y = cvt_pk_bf16(v0[2], v0[3]); w.z = cvt_pk_bf16(v1[0], v1[1]); w.w = cvt_pk_bf16(v1[2], v1[3]);
                    *(u32x4*)(rowp + bj * HALF) = w; } }
    }
};

template <int VAR  > struct EpiG1T {
    static constexpr bool PERM = true, AFTER_DRAIN = false;
    unsigned char* ws; const int* positions; const float* sa; const float* sb;
    const float* tsrc_u; const float* tsrc_v; unsigned char* tdst_u; unsigned char* tdst_v; float* tsc_u; float* tsc_v; mutable int cnt;
    __device__ __forceinline__ void operator()(const f32x4 (&acc)[2][2][4][2], const Unit& u, int wr, int wc, int fr, int fq) const {
#ifndef TJOB_POST
#define TJOB_POST 1
#endif
#if TJOB_POST
        const int tpar = (int)blockIdx.x & 1, thalf = (int)blockIdx.x >> 1;
        const bool tjob = (VAR == 0) && (cnt < (tpar ? 6 : 8));
        const int tlane = fq * 16 + fr, trow0 = (tpar ? 16384 : 0) + cnt * 2048 + 2 * (thalf * 8 + wr * 4 + wc);
#else
        const bool tjob = (VAR == 0) && (cnt < 8);
        const int tlane = fq * 16 + fr, trow0 = cnt * 4096 + 2 * ((int)blockIdx.x * 8 + wr * 4 + wc);
#endif
        f32x4 tv[8];
#define G1_TLOAD(j_) do { const int r_ = trow0 + (j_); const float* rp_ = (r_ < 16384 ? tsrc_u + (size_t)r_ * 2048 : tsrc_v + (size_t)(r_ - 16384) * 2048); \
            int tl_ = tlane; asm volatile("" : "+v"(tl_));     \
            _Pragma("unroll") for (int q = 0; q < 8; ++q) tv[q] = *(const f32x4*)(rp_ + q * 256 + 4 * tl_); } while (0)
#define G1_TPROC(j_) do { const int r = trow0 + (j_); float am = 0.f; const bool isu = r < 16384; const bool f4 = isu ? (PEER_U4 != 0) : (PEER_V4 != 0); \
            _Pragma("unroll") for (int q = 0; q < 8; ++q) am = fmaxf(am, fmaxf(fmaxf(__builtin_fabsf(tv[q][0]), __builtin_fabsf(tv[q][1])), fmaxf(__builtin_fabsf(tv[q][2]), __builtin_fabsf(tv[q][3])))); \
            _Pragma("unroll") for (int o = 1; o < 64; o <<= 1) am = fmaxf(am, __shfl_xor(am, o)); \
            float sc = am > 0.f ? am * (f4 ? (FP4_CLIP / 6.0f) : (1.0f / 7.5f)) : 1.0f; \
            if (isu && (PEER_UI4 != 0)) { float ss = 0.f; \
                _Pragma("unroll") for (int q = 0; q < 8; ++q) ss += (tv[q][0] * tv[q][0] + tv[q][1] * tv[q][1]) + (tv[q][2] * tv[q][2] + tv[q][3] * tv[q][3]); \
                _Pragma("unroll") for (int o = 1; o < 64; o <<= 1) ss += __shfl_xor(ss, o); \
                sc = am > 0.f ? fminf(am * (1.0f / 7.0f), UI4_STEP * __builtin_sqrtf(ss * (1.0f / 2048.0f))) : 1.0f; } \
            const float inv = 1.0f / sc; \
            unsigned char* op = isu ? tdst_u + (size_t)r * PEER_ROWB_U : tdst_v + (size_t)(r - 16384) * PEER_ROWB_V; \
            int tlane_s = tlane; asm volatile("" : "+v"(tlane_s));     \
            if (isu && (PEER_UI4 != 0)) { unsigned w4[4];        \
                _Pragma("unroll") for (int d = 0; d < 4; ++d) { unsigned w = 0u; \
                    _Pragma("unroll") for (int c = 0; c < 4; ++c) { \
                        const unsigned n0 = __builtin_bit_cast(unsigned, __builtin_amdgcn_fmed3f(tv[2 * d][c] * inv, -7.0f, 7.0f) + 12582912.0f) & 15u; \
                        const unsigned n1 = __builtin_bit_cast(unsigned, __builtin_amdgcn_fmed3f(tv[2 * d + 1][c] * inv, -7.0f, 7.0f) + 12582912.0f) & 15u; \
                        w |= (n0 << (8 * c)) | (n1 << (8 * c + 4)); } \
                    w4[d] = w; } \
                *(u32x4*)(op + tlane_s * 16) = (u32x4){w4[0], w4[1], w4[2], w4[3]}; \
            } else if (f4) { unsigned w4[4]; \
                _Pragma("unroll") for (int d = 0; d < 4; ++d) { unsigned w = 0u; \
                    w = __builtin_amdgcn_cvt_scalef32_pk_fp4_f32(w, tv[2 * d][0] * inv, tv[2 * d][1] * inv, 1.0f, 0); w = __builtin_amdgcn_cvt_scalef32_pk_fp4_f32(w, tv[2 * d][2] * inv, tv[2 * d][3] * inv, 1.0f, 1); \
                    w = __builtin_amdgcn_cvt_scalef32_pk_fp4_f32(w, tv[2 * d + 1][0] * inv, tv[2 * d + 1][1] * inv, 1.0f, 2); w = __builtin_amdgcn_cvt_scalef32_pk_fp4_f32(w, tv[2 * d + 1][2] * inv, tv[2 * d + 1][3] * inv, 1.0f, 3); \
                    w4[d] = w; } \
                *(u32x4*)(op + tlane_s * 16) = (u32x4){w4[0], w4[1], w4[2], w4[3]}; \
            } else { typedef __bf16 bf16x32 __attribute__((ext_vector_type(32))); typedef int i32x6 __attribute__((ext_vector_type(6))); typedef unsigned u32x2 __attribute__((ext_vector_type(2))); bf16x32 b; \
                typedef float f32x16 __attribute__((ext_vector_type(16))); f32x16 x16, y16; i32x6 w6; \
                if (F6_ORDER == 2) { _Pragma("unroll") for (int q = 0; q < 8; ++q) { b[4 * q] = (__bf16)(tv[q][0] * inv); b[4 * q + 1] = (__bf16)(tv[q][1] * inv); b[4 * q + 2] = (__bf16)(tv[q][2] * inv); b[4 * q + 3] = (__bf16)(tv[q][3] * inv); } \
                    w6 = __builtin_amdgcn_cvt_scalef32_pk32_fp6_bf16(b, 1.0f); } else { \
                _Pragma("unroll") for (int q = 0; q < 4; ++q) { _Pragma("unroll") for (int c = 0; c < 4; ++c) { \
                    if (F6_ORDER == 0) { x16[4 * q + c] = tv[q][c] * inv; y16[4 * q + c] = tv[q + 4][c] * inv; } \
                    else { const int i0 = 4 * q + c, i1 = 16 + 4 * q + c;     \
                        if (i0 & 1) y16[i0 >> 1] = tv[q][c] * inv; else x16[i0 >> 1] = tv[q][c] * inv; \
                        if (i1 & 1) y16[i1 >> 1] = tv[q + 4][c] * inv; else x16[i1 >> 1] = tv[q + 4][c] * inv; } } } \
                w6 = __builtin_amdgcn_cvt_scalef32_2xpk16_fp6_f32(x16, y16, 1.0f); } \
                *(u32x4*)(op + tlane_s * 16) = (u32x4){(unsigned)w6[0], (unsigned)w6[1], (unsigned)w6[2], (unsigned)w6[3]}; \
                *(u32x2*)(op + 1024 + tlane_s * 8) = (u32x2){(unsigned)w6[4], (unsigned)w6[5]}; } \
            if (tlane == 0) { if (isu) tsc_u[r] = sc; else tsc_v[r - 16384] = sc; } } while (0)
        const int pn = u.pn; int part, colt, ldc;
        if (pn < 32) { part = pn >> 2; colt = (pn & 3) * 256; ldc = 1024; } else { part = 8 + ((pn - 32) >> 3); colt = ((pn - 32) & 7) * 256; ldc = 2048; }
        const size_t off = part == 0 ? G1_O0 : part == 1 ? G1_O1 : part == 2 ? G1_O2 : part == 3 ? G1_O3 : part == 4 ? G1_O4 : part == 5 ? G1_O5 : part == 6 ? G1_O6 : part == 7 ? G1_O7 : part == 8 ? G1_O8 : G1_O9;
        bf16_t* base = (bf16_t*)(ws + off);
        const int row0 = u.pm * BM + wr * 64 + fr, col0 = colt + wc * 32 + 8 * fq;
        const int mode = (VAR == 1 || VAR == 3) ? 0 : ((part <= 1) ? 1 : ((part == 3 || part == 7) ? 2 : (part >= 8 ? 3 : 0)));
        const bool do_rope = (mode == 1) && ((wc & 1) == 0);
        const float qs = (part == 0) ? QSCALE : 1.0f;
        float rsc[8]; const float cs = sb[u.pn];
#pragma unroll
        for (int ai = 0; ai < 2; ++ai)
#pragma unroll
            for (int m = 0; m < 4; ++m) rsc[ai * 4 + m] = sa[row0 + ai * HALF + m * 16] * cs;
#if TJOB_LATE
#pragma unroll
        for (int i = 0; i < 8; ++i) asm volatile("" :: "v"(rsc[i]));
        __builtin_amdgcn_sched_barrier(0);
#endif
        if (tjob) G1_TLOAD(0);
        const float fr8[8] = {0.15915494309189535f, 0.03086376340470123f, 0.005985185712713705f, 0.001160663641240061f, 0.00022507907903927653f, 4.364795279280289e-05f, 8.464330808241401e-06f, 1.6414262627950345e-06f};
#pragma unroll
        for (int ai = 0; ai < 2; ++ai) {
            if (ai == 1 && tjob) { G1_TPROC(0); G1_TLOAD(1); }
#pragma unroll
            for (int m = 0; m < 4; ++m) {
                const int row = row0 + ai * HALF + m * 16;
                bf16_t* rowp = base + (size_t)row * ldc + col0;
                const float posf = do_rope ? (float)positions[row] : 0.f;
#pragma unroll
                for (int bj = 0; bj < 2; ++bj) {
                    f32x4 v[2] = {acc[ai][bj][m][0] * rsc[ai * 4 + m], acc[ai][bj][m][1] * rsc[ai * 4 + m]};
                    if (mode == 1) {
                        if (do_rope) {
#pragma unroll
                            for (int n = 0; n < 2; ++n)
#pragma unroll
                                for (int i = 0; i < 4; ++i) { const float val = v[n][i]; const float p = __shfl_xor(val, 16);
                                    float rv = posf * fr8[4 * n + i]; rv = rv - __builtin_floorf(rv); const float c = __builtin_amdgcn_cosf(rv), s = __builtin_amdgcn_sinf(rv);
                                    v[n][i] = (fq == 0) ? (val * c - p * s) : ((fq == 1) ? (val * c + p * s) : val); }
                        }
                        v[0] = v[0] * qs; v[1] = v[1] * qs;
                    } else if (mode == 2) {
#pragma unroll
                        for (int n = 0; n < 2; ++n)
#pragma unroll
                            for (int i = 0; i < 4; ++i) v[n][i] = v[n][i] * fsigmoid(v[n][i]);
                    } else if (mode == 3) {
#pragma unroll
                        for (int n = 0; n < 2; ++n)
#pragma unroll
                            for (int i = 0; i < 4; ++i) v[n][i] = fsigmoid(v[n][i]);
                    }
                    u32x4 w; w.x = cvt_pk_bf16(v[0][0], v[0][1]); w.y = cvt_pk_bf16(v[0][2], v[0][3]); w.z = cvt_pk_bf16(v[1][0], v[1][1]); w.w = cvt_pk_bf16(v[1][2], v[1][3]);
                    if (VAR == 2) asm volatile("" :: "v"(w), "v"(rowp)); else if (VAR == 3) { const int l3 = fq * 16 + fr; *(u32x4*)(base + (size_t)(u.pm * BM + (wr * 4 + wc) * 32 + ((ai * 4 + m) * 2 + bj) * 2 + (l3 >> 5)) * ldc + colt + (l3 & 31) * 8) = w; } else *(u32x4*)(rowp + bj * HALF) = w;
                }
            }
        }
        if (tjob) G1_TPROC(1);
#ifdef PROBE_EPI_DRAIN
        asm volatile("s_waitcnt vmcnt(0)" ::: "memory");
#endif
#ifdef PROBE_TJOB2
        if (tjob) { G1_TLOAD(0); G1_TPROC(0); G1_TLOAD(1); G1_TPROC(1); }
#endif
        ++cnt;
    }
    __device__ __forceinline__ void tjob_post(const int half, const int wave, const int lane) const {
        const int tlane = lane; f32x4 tv[8];
#pragma unroll 1
        for (int i = 0; i < 4; ++i) { const int trow0 = 28672 + (half * 8 + wave) * 4 + i; G1_TLOAD(0); G1_TPROC(0); }
    }
#undef G1_TLOAD
#undef G1_TPROC
};
typedef EpiG1T<0> EpiG1;
template <bool ADD> struct EpiGate {
    static constexpr bool PERM = true, AFTER_DRAIN = false;
    bf16_t* Y; const bf16_t* G; int ldc; const float* sa; const float* sb;
    __device__ __forceinline__ void operator()(const f32x4 (&acc)[2][2][4][2], const Unit& u, int wr, int wc, int fr, int fq) const {
        const int row0 = u.pm * BM + wr * 64 + fr, col0 = u.pn * BM + wc * 32 + 8 * fq;
        const float cs = sa ? sb[u.pn] : 1.0f;
#pragma unroll
        for (int ai = 0; ai < 2; ++ai) {
            u32x4 gq[4][2], yq[4][2]; float rsc[4];
#pragma unroll
            for (int m = 0; m < 4; ++m) { rsc[m] = sa ? sa[row0 + ai * HALF + m * 16] * cs : 1.0f;
#pragma unroll
                for (int bj = 0; bj < 2; ++bj) { const size_t ro = (size_t)(row0 + ai * HALF + m * 16) * ldc + col0 + bj * HALF;
                    gq[m][bj] = *(const u32x4*)(G + ro); if (ADD) yq[m][bj] = *(const u32x4*)(Y + ro); } }
#pragma unroll
            for (int m = 0; m < 4; ++m)
#pragma unroll
                for (int bj = 0; bj < 2; ++bj) { const size_t ro = (size_t)(row0 + ai * HALF + m * 16) * ldc + col0 + bj * HALF;
                    const f32x4 v0 = acc[ai][bj][m][0] * rsc[m], v1 = acc[ai][bj][m][1] * rsc[m]; const u32x4 g = gq[m][bj];
                    float r[8] = {v0[0] * bflo(g.x), v0[1] * bfhi(g.x), v0[2] * bflo(g.y), v0[3] * bfhi(g.y), v1[0] * bflo(g.z), v1[1] * bfhi(g.z), v1[2] * bflo(g.w), v1[3] * bfhi(g.w)};
                    if (ADD) { const u32x4 y = yq[m][bj];
                        r[0] += bflo(y.x); r[1] += bfhi(y.x); r[2] += bflo(y.y); r[3] += bfhi(y.y); r[4] += bflo(y.z); r[5] += bfhi(y.z); r[6] += bflo(y.w); r[7] += bfhi(y.w); }
                    u32x4 w; w.x = cvt_pk_bf16(r[0], r[1]); w.y = cvt_pk_bf16(r[2], r[3]); w.z = cvt_pk_bf16(r[4], r[5]); w.w = cvt_pk_bf16(r[6], r[7]);
                    *(u32x4*)(Y + ro) = w; }
        }
    }
};

struct EpiResGate {
    static constexpr bool PERM = false, AFTER_DRAIN = false;
    const float* base; float* out; const float* gate; int ldc; int gate_ld; int rows_per_batch; const float* sa; const float* sb;
    bf16_t* outb = nullptr;
    __device__ __forceinline__ void operator()(const f32x4 (&acc)[2][2][4][2], const Unit& u, int wr, int wc, int fr, int fq) const {
        const int row0 = u.pm * BM + wr * 64 + fr, col0 = u.pn * BM + wc * 32 + 4 * fq;
        const float* gp = gate + (size_t)((u.pm * BM) / rows_per_batch) * gate_ld + col0;
        const float cs = sa ? sb[u.pn] : 1.0f;
        f32x4 gv[2][2];
#pragma unroll
        for (int bj = 0; bj < 2; ++bj)
#pragma unroll
            for (int n = 0; n < 2; ++n) gv[bj][n] = *(const f32x4*)(gp + bj * HALF + n * 16) * cs;
#pragma unroll
        for (int ai = 0; ai < 2; ++ai)
#pragma unroll
            for (int mh = 0; mh < 2; ++mh) {
                f32x4 xb[2][2][2]; float rs[2];
#pragma unroll
                for (int ml = 0; ml < 2; ++ml) rs[ml] = sa ? sa[row0 + ai * HALF + (2 * mh + ml) * 16] : 1.0f;
#pragma unroll
                for (int ml = 0; ml < 2; ++ml)
#pragma unroll
                    for (int bj = 0; bj < 2; ++bj)
#pragma unroll
                        for (int n = 0; n < 2; ++n) xb[ml][bj][n] = *(const f32x4*)(base + (size_t)(row0 + ai * HALF + (2 * mh + ml) * 16) * ldc + col0 + bj * HALF + n * 16);
#pragma unroll
                for (int ml = 0; ml < 2; ++ml)
#pragma unroll
                    for (int bj = 0; bj < 2; ++bj)
#pragma unroll
                        for (int n = 0; n < 2; ++n) { const f32x4 r_ = xb[ml][bj][n] + gv[bj][n] * (acc[ai][bj][2 * mh + ml][n] * rs[ml]); const size_t ix_ = (size_t)(row0 + ai * HALF + (2 * mh + ml) * 16) * ldc + col0 + bj * HALF + n * 16;
                            if (outb) { typedef unsigned u32x2e __attribute__((ext_vector_type(2))); *(u32x2e*)(outb + ix_) = (u32x2e){cvt_pk_bf16(r_[0], r_[1]), cvt_pk_bf16(r_[2], r_[3])}; } else *(f32x4*)(out + ix_) = r_; }
            }
    }
};

struct EpiNull {
    static constexpr bool PERM = true, AFTER_DRAIN = false;
    __device__ __forceinline__ void operator()(const f32x4 (&acc)[2][2][4][2], const Unit& u, int wr, int wc, int fr, int fq) const {
#pragma unroll
        for (int ai = 0; ai < 2; ++ai)
#pragma unroll
            for (int bj = 0; bj < 2; ++bj)
#pragma unroll
                for (int m = 0; m < 4; ++m)
#pragma unroll
                    for (int n = 0; n < 2; ++n) asm volatile("" :: "v"(acc[ai][bj][m][n]));
    }
};
template <class Epi, class Sched, bool ALIGN_EPI = false, bool SP2 = false, bool I8 = false>
__device__ __forceinline__ void gemm_phase(PG8_LAS unsigned char* lds, const Gemm g, const Sched& S, const Epi& E, const int wave_id = -1) {
    int tid_ = wave_id < 0 ? (int)threadIdx.x : wave_id * 64 + (int)__builtin_amdgcn_mbcnt_hi(~0u, __builtin_amdgcn_mbcnt_lo(~0u, 0u));
    asm volatile("" : "+v"(tid_));
    const int tid = tid_, wid = __builtin_amdgcn_readfirstlane(tid >> 6), lane = tid & 63, wr = wid >> 2, wc = wid & 3, fr = lane & 15, fq = lane >> 4;
    const int K = g.K, nt = K / BK;
    unsigned voffA[2], voffB[2];
#pragma unroll
    for (int i = 0; i < 2; ++i) { int R, C; stage_rc(tid * 16 + i * 8192, R, C); const int Rb = Epi::PERM ? ((R & ~31) + perm32(R & 31)) : R;
        voffA[i] = (unsigned)(R * K + C) * 2u; voffB[i] = (unsigned)(Rb * K + C) * 2u; }
    const size_t kstep = (size_t)(BK * 2);
    const size_t hstep = (size_t)HALF * K * 2;
    const size_t tstep = 2 * hstep;
    const unsigned ldsw = (unsigned)wid * 1024u;
    const int aoff = lds_byte(wr * 64 + fr, fq * 8), boff = lds_byte(wc * 32 + fr, fq * 8);
#define PG8_SA(b, h) (((b) * 2 + (h)) * HTB)
#define PG8_SB(b, h) ((4 + (b) * 2 + (h)) * HTB)
#define PG8_STAGE(bufoff, gbase, voff) do { _Pragma("unroll") for (int _i = 0; _i < 2; ++_i) \
        __builtin_amdgcn_global_load_lds((const unsigned*)((const char*)(gbase) + (voff)[_i]), (PG8_LAS unsigned*)(lds + (bufoff) + ldsw + _i * 8192), 16, 0, 0); } while (0)
#define PG8_LDA(dst, b, h) do { _Pragma("unroll") for (int m = 0; m < 4; ++m) _Pragma("unroll") for (int k = 0; k < 2; ++k) dst[m][k] = *(const PG8_LAS bf16x8*)(lds + PG8_SA(b, h) + aoff + m * 2048 + k * 1024); } while (0)
#define PG8_LDB(dst, b, h) do { _Pragma("unroll") for (int n = 0; n < 2; ++n) _Pragma("unroll") for (int k = 0; k < 2; ++k) dst[n][k] = *(const PG8_LAS bf16x8*)(lds + PG8_SB(b, h) + boff + n * 2048 + k * 1024); } while (0)
#define PG8_MMA(ai, bj, At, Bt) do { __builtin_amdgcn_s_setprio(1); _Pragma("unroll") for (int m = 0; m < 4; ++m) _Pragma("unroll") for (int n = 0; n < 2; ++n) _Pragma("unroll") for (int k = 0; k < 2; ++k) \
        { if constexpr (I8) acc[ai][bj][m][n] = __builtin_bit_cast(acc_t, __builtin_amdgcn_mfma_i32_16x16x64_i8(__builtin_bit_cast(i32x4_t, Bt[n][k]), __builtin_bit_cast(i32x4_t, At[m][k]), __builtin_bit_cast(i32x4_t, acc[ai][bj][m][n]), 0, 0, 0)); \
          else acc[ai][bj][m][n] = __builtin_bit_cast(acc_t, __builtin_amdgcn_mfma_f32_16x16x32_bf16(Bt[n][k], At[m][k], __builtin_bit_cast(f32x4, acc[ai][bj][m][n]), 0, 0, 0)); } __builtin_amdgcn_s_setprio(0); } while (0)
#define PG8_WAIT_V(n) asm volatile("s_waitcnt vmcnt(" #n ")" ::: "memory")
#define PG8_WAIT_L(n) asm volatile("s_waitcnt lgkmcnt(" #n ")" ::: "memory")
#define PG8_BAR __builtin_amdgcn_s_barrier()
#define PG8_SCHED __builtin_amdgcn_sched_barrier(0)
    Unit cur, nxt; int ui = 0;
    if (!S.next(0, cur)) return;
    typedef int i32x4_t __attribute__((ext_vector_type(4)));
    typedef f32x4 acc_t;
    acc_t acc[2][2][4][2];
#pragma unroll
    for (int a = 0; a < 2; ++a)
#pragma unroll
        for (int b = 0; b < 2; ++b)
#pragma unroll
            for (int m = 0; m < 4; ++m)
#pragma unroll
                for (int n = 0; n < 2; ++n) acc[a][b][m][n] = (f32x4){0.f, 0.f, 0.f, 0.f};
    bf16x8 At[4][2], B0[2][2], B1[2][2];
    const char* cA = (const char*)g.A + (size_t)cur.pm * tstep; const char* cB = (const char*)g.Bt + (size_t)cur.pn * tstep;
    S.a_ready(cur);
    if constexpr (SP2) {
        PG8_STAGE(PG8_SB(0, 0), cB, voffB); PG8_STAGE(PG8_SB(0, 1), cB + hstep, voffB); PG8_STAGE(PG8_SA(0, 0), cA, voffA); PG8_STAGE(PG8_SA(0, 1), cA + hstep, voffA);
        if (wr == 1) PG8_BAR;
        PG8_WAIT_V(2); PG8_BAR;
        PG8_STAGE(PG8_SB(1, 0), cB + kstep, voffB); PG8_STAGE(PG8_SA(1, 0), cA + kstep, voffA); PG8_STAGE(PG8_SB(1, 1), cB + hstep + kstep, voffB);
        PG8_WAIT_V(6); PG8_BAR;
    } else {
        PG8_STAGE(PG8_SB(0, 0), cB, voffB); PG8_STAGE(PG8_SA(0, 0), cA, voffA); PG8_STAGE(PG8_SB(0, 1), cB + hstep, voffB); PG8_STAGE(PG8_SA(0, 1), cA + hstep, voffA);
        if (wr == 1) PG8_BAR;
        PG8_WAIT_V(4); PG8_BAR;
        PG8_STAGE(PG8_SB(1, 0), cB + kstep, voffB); PG8_STAGE(PG8_SA(1, 0), cA + kstep, voffA); PG8_STAGE(PG8_SB(1, 1), cB + hstep + kstep, voffB);
        PG8_WAIT_V(6); PG8_BAR;
    }
    for (;;) {
        const bool has_next = S.next(ui + 1, nxt);
        const char* nA = has_next ? (const char*)g.A + (size_t)nxt.pm * tstep : cA; const char* nB = has_next ? (const char*)g.Bt + (size_t)nxt.pn * tstep : cB;
        for (int t = 0; t < nt; t += 2) {
            const bool last = (t == nt - 2);
            const char* a1 = cA + (size_t)(t + 1) * kstep;
            const char* a2 = last ? nA : cA + (size_t)(t + 2) * kstep; const char* b2 = last ? nB : cB + (size_t)(t + 2) * kstep;
            const char* a3 = a2 + kstep; const char* b3 = b2 + kstep;
            if (last && has_next) S.a_ready(nxt);
            if constexpr (SP2) {
            PG8_LDB(B0, 0, 0); PG8_LDB(B1, 0, 1); PG8_SCHED; PG8_LDA(At, 0, 0); PG8_STAGE(PG8_SA(1, 1), a1 + hstep, voffA);
            PG8_WAIT_V(8); PG8_WAIT_L(0); PG8_BAR; PG8_MMA(0, 0, At, B0); PG8_MMA(0, 1, At, B1); PG8_BAR; PG8_SCHED;
            PG8_LDA(At, 0, 1); PG8_STAGE(PG8_SB(0, 0), b2, voffB); PG8_STAGE(PG8_SB(0, 1), b2 + hstep, voffB); PG8_STAGE(PG8_SA(0, 0), a2, voffA);
            PG8_WAIT_V(8); PG8_WAIT_L(0); PG8_BAR; PG8_MMA(1, 0, At, B0); PG8_MMA(1, 1, At, B1); PG8_BAR; PG8_SCHED;
            PG8_LDB(B0, 1, 0); PG8_LDB(B1, 1, 1); PG8_SCHED; PG8_LDA(At, 1, 0); PG8_STAGE(PG8_SA(0, 1), a2 + hstep, voffA);
            PG8_WAIT_V(8); PG8_WAIT_L(0); PG8_BAR; PG8_MMA(0, 0, At, B0); PG8_MMA(0, 1, At, B1); PG8_BAR; PG8_SCHED;
            PG8_LDA(At, 1, 1); PG8_STAGE(PG8_SB(1, 0), b3, voffB); PG8_STAGE(PG8_SB(1, 1), b3 + hstep, voffB); PG8_STAGE(PG8_SA(1, 0), a3, voffA);
            PG8_WAIT_V(8); PG8_WAIT_L(0); PG8_BAR; PG8_MMA(1, 0, At, B0); PG8_MMA(1, 1, At, B1); PG8_BAR; PG8_SCHED;
            } else {
            PG8_LDB(B0, 0, 0); PG8_SCHED; PG8_LDA(At, 0, 0); PG8_STAGE(PG8_SA(1, 1), a1 + hstep, voffA);
            PG8_WAIT_L(8); PG8_BAR; PG8_WAIT_L(0); PG8_MMA(0, 0, At, B0); PG8_BAR; PG8_SCHED;
            PG8_LDB(B1, 0, 1); PG8_STAGE(PG8_SB(0, 0), b2, voffB);
            PG8_BAR; PG8_WAIT_L(0); PG8_MMA(0, 1, At, B1); PG8_BAR;
            PG8_LDA(At, 0, 1); PG8_STAGE(PG8_SA(0, 0), a2, voffA);
            PG8_BAR; PG8_WAIT_L(0); PG8_MMA(1, 0, At, B0); PG8_BAR; PG8_SCHED;
            PG8_STAGE(PG8_SB(0, 1), b2 + hstep, voffB);
            PG8_WAIT_V(6); PG8_BAR; PG8_MMA(1, 1, At, B1); PG8_BAR;
            PG8_LDB(B0, 1, 0); PG8_SCHED; PG8_LDA(At, 1, 0); PG8_STAGE(PG8_SA(0, 1), a2 + hstep, voffA);
            PG8_WAIT_L(8); PG8_BAR; PG8_WAIT_L(0); PG8_MMA(0, 0, At, B0); PG8_BAR; PG8_SCHED;
            PG8_LDB(B1, 1, 1); PG8_STAGE(PG8_SB(1, 0), b3, voffB);
            PG8_BAR; PG8_WAIT_L(0); PG8_MMA(0, 1, At, B1); PG8_BAR;
            PG8_LDA(At, 1, 1); PG8_STAGE(PG8_SA(1, 0), a3, voffA);
            PG8_BAR; PG8_WAIT_L(0); PG8_MMA(1, 0, At, B0); PG8_BAR; PG8_SCHED;
            PG8_STAGE(PG8_SB(1, 1), b3 + hstep, voffB);
            PG8_WAIT_V(6); PG8_BAR; PG8_MMA(1, 1, At, B1); PG8_BAR;
            }
        }
        if constexpr (ALIGN_EPI) { if (wr == 0) PG8_BAR; }
        if constexpr (I8) {
#pragma unroll
            for (int a = 0; a < 2; ++a)
#pragma unroll
                for (int b = 0; b < 2; ++b)
#pragma unroll
                    for (int m = 0; m < 4; ++m)
#pragma unroll
                        for (int n = 0; n < 2; ++n) acc[a][b][m][n] = __builtin_convertvector(__builtin_bit_cast(i32x4_t, acc[a][b][m][n]), f32x4);
        }
        if constexpr (!Epi::AFTER_DRAIN) { E(acc, cur, wr, wc, fr, fq); S.done(cur); }
        if (!has_next) break;
#pragma unroll
        for (int a = 0; a < 2; ++a)
#pragma unroll
            for (int b = 0; b < 2; ++b)
#pragma unroll
                for (int m = 0; m < 4; ++m)
#pragma unroll
                    for (int n = 0; n < 2; ++n) acc[a][b][m][n] = (f32x4){0.f, 0.f, 0.f, 0.f};
        cur = nxt; cA = nA; cB = nB; ++ui;
        if constexpr (ALIGN_EPI) { if (wr == 1) PG8_BAR; }
    }
    PG8_WAIT_V(0);
    if constexpr (!ALIGN_EPI) { if (wr == 0) PG8_BAR; }
    PG8_BAR;
    if constexpr (Epi::AFTER_DRAIN) { E.fused(acc, cur, wr, wc, fr, fq, lds, wid, lane); S.done(cur); }
#undef PG8_SA
#undef PG8_SB
#undef PG8_STAGE
#undef PG8_LDA
#undef PG8_LDB
#undef PG8_MMA
#undef PG8_WAIT_V
#undef PG8_WAIT_L
#undef PG8_BAR
#undef PG8_SCHED
}
}

#ifndef DUP_MASK
#define DUP_MASK 0
#endif
constexpr int NWAVES = 8;
#ifndef MK_N_LAUNCHES
#define MK_N_LAUNCHES 1
#endif
constexpr int N_PHASES = 11;
constexpr int N_LAUNCHES = MK_N_LAUNCHES;

constexpr int BATCH = 8, SEQ = 2048, DM = 2048, T = BATCH * SEQ;
constexpr int IN_W = 12288, ADA_W = 6 * DM;
constexpr float EPS = 1e-6f;
constexpr float LAMBDA_INIT = 0.2f;
constexpr float THRL = 11.541560327111707f;

constexpr size_t MiB = 1u << 20;
constexpr size_t WS_CTL = 0, CTL_ZERO_BYTES = 192 * 1024;
constexpr size_t WS_COLMAX = 64 * 1024;
constexpr int CM_IN = 0, CM_Q = 12288, CM_A = 14336, CM_B = 16384, CM_O = 18432, CM_END = 20480;
constexpr size_t WS_ADA = 256 * 1024;
constexpr size_t WS_SA = 1 * MiB, WS_SB = 1 * MiB + 128 * 1024;
constexpr size_t WS_SBC = 1 * MiB + 448 * 1024;
constexpr size_t WS_SA2 = 1 * MiB + 64 * 1024;
constexpr size_t WS_SAO = 1 * MiB + 256 * 1024, WS_SAB = 1 * MiB + 320 * 1024, WS_SAY = 1 * MiB + 384 * 1024;
constexpr size_t WS_WIN = 4 * MiB;
constexpr size_t WS_OA = WS_WIN, WS_OA8 = 36 * MiB;
constexpr size_t WS_WA = 52 * MiB, WS_WB = 56 * MiB, WS_WOUT = 60 * MiB, WS_WQ = 68 * MiB;
constexpr size_t WS_H = 76 * MiB;
constexpr size_t WS_OF = WS_H, WS_OBW = WS_H + 32 * MiB, WS_H2 = WS_H;
constexpr size_t WS_DAQ = 140 * MiB, WS_DAK = 172 * MiB, WS_DAV = 204 * MiB;
constexpr size_t WS_Y = WS_DAQ;
constexpr size_t WS_X1B = WS_DAQ;
constexpr size_t WS_Y8 = WS_DAV;
constexpr size_t WS_OB = WS_DAV;
constexpr size_t WS_HGQ = 236 * MiB, WS_HGI = 268 * MiB, WS_HGG = 300 * MiB, WS_HFF = 332 * MiB, WS_HFB = 364 * MiB;
constexpr size_t WS_GA = 396 * MiB, WS_GB = 460 * MiB;
constexpr size_t WS_QP = WS_GA;
constexpr size_t WS_EIDX = WS_GB, WS_EG = WS_GB + 8 * MiB, WS_AP = WS_GB + 16 * MiB;
constexpr size_t WS_U8 = 524 * MiB, WS_V8 = 548 * MiB, WS_SCU = 572 * MiB, WS_SCV = 572 * MiB + 65536;
constexpr size_t WS_STASH = 588 * MiB;
constexpr size_t WS_END = 620 * MiB;

constexpr int CW_TMO = 0, CW_CODE = 1, CW_CHK = 2;
constexpr int CW_BAR = 1024;

constexpr int RING_OFF = 0, RING_BYTES = 131072;
constexpr int LDSCTL_OFF = RING_BYTES, MISC_OFF = LDSCTL_OFF + 320;
constexpr int LDS_BYTES = 147456;
static_assert(pg8::G1_O0 == WS_DAQ && pg8::G1_O1 == WS_DAK && pg8::G1_O2 == WS_DAV && pg8::G1_O3 == WS_HGQ && pg8::G1_O4 == WS_HFF && pg8::G1_O5 == WS_HFB && pg8::G1_O6 == WS_HGI && pg8::G1_O7 == WS_HGG && pg8::G1_O8 == WS_GA && pg8::G1_O9 == WS_GB, "G1 part offsets");
#define GAS __attribute__((address_space(1)))
#define LAS __attribute__((address_space(3)))
typedef unsigned short bf16;
typedef unsigned v4u __attribute__((ext_vector_type(4)));
typedef float f32x4 __attribute__((ext_vector_type(4)));
typedef short bf16x8 __attribute__((ext_vector_type(8)));
typedef GAS unsigned gu32;
typedef GAS unsigned long long gu64;
#define RLX_AGENT __ATOMIC_RELAXED, __HIP_MEMORY_SCOPE_AGENT
#define LDS_WAIT() asm volatile("s_waitcnt lgkmcnt(0)" ::: "memory")
#define VM_WAIT() asm volatile("s_waitcnt vmcnt(0)" ::: "memory")
__device__ __forceinline__ unsigned long long rt() { return __builtin_amdgcn_s_memrealtime(); }
__device__ __forceinline__ unsigned f2bf(float f) { unsigned u = __builtin_bit_cast(unsigned, f); return (u + 0x7fffu + ((u >> 16) & 1u)) >> 16; }
__device__ __forceinline__ unsigned pk2(float lo, float hi) { return f2bf(lo) | (f2bf(hi) << 16); }

#define XB_TMO      128
#define XB_XCNT(j)  (256  + 64 * (j))
#define XB_XSUB(j)  (1280 + 64 * (j))
#define XB_XGEN(j)  (2304 + 64 * (j))
#define XB_TOP      3328
#define XB_TOPGEN   3392
#define XCD_BAR_WORDS 3456
#define XB_SPIN_CAP (1u << 18)

__device__ __forceinline__ unsigned xb_ld(unsigned* p)              { return __hip_atomic_load(p, __ATOMIC_RELAXED, __HIP_MEMORY_SCOPE_AGENT); }
__device__ __forceinline__ unsigned xb_add(unsigned* p, unsigned v) { return __hip_atomic_fetch_add(p, v, __ATOMIC_RELAXED, __HIP_MEMORY_SCOPE_AGENT); }
__device__ __forceinline__ unsigned xb_xcc_id() { return (unsigned)__builtin_amdgcn_s_getreg((3 << 11) | 20) & 0xFu; }
#define XB_SPIN(cond, bar) do { unsigned _sp = 0; while (cond) { __builtin_amdgcn_s_sleep(1); \
    if ((++_sp & 255u) == 0u) { if (xb_ld(&(bar)[XB_TMO])) break; if (_sp > XB_SPIN_CAP) { atomicAdd(&(bar)[XB_TMO], 1u); break; } } } } while (0)

struct XcdBarrier {
    int wv;
    unsigned* bar; unsigned x;
    volatile LAS unsigned* st;
};

__device__ __forceinline__ XcdBarrier xcd_barrier_post(unsigned* bar, volatile LAS unsigned* st) {
    XcdBarrier b; b.bar = bar; b.x = xb_xcc_id(); b.st = st; b.wv = __builtin_amdgcn_readfirstlane((int)threadIdx.x >> 6);
    if (threadIdx.x == 0) (void)xb_add(&bar[XB_XCNT(b.x)], 1u);
    return b;
}
__device__ __forceinline__ void xcd_barrier_complete(unsigned* bar, unsigned x, unsigned& nloc, unsigned& nx) {
    const unsigned G = gridDim.x * gridDim.y * gridDim.z;
    unsigned sum, cnt, mine, sp = 0u;
    for (;;) {
        sum = 0u; cnt = 0u; mine = 0u;
#pragma unroll
        for (unsigned j = 0; j < 16; ++j) { const unsigned c = xb_ld(&bar[XB_XCNT(j)]); sum += c; cnt += (c > 0u) ? 1u : 0u; mine = (j == x) ? c : mine; }
        if (sum == G) break;
        __builtin_amdgcn_s_sleep(1);
        if ((++sp & 255u) == 0u) { if (xb_ld(&bar[XB_TMO])) break; if (sp > XB_SPIN_CAP) { atomicAdd(&bar[XB_TMO], 1u); break; } }
    }
    nloc = mine > 0u ? mine : 1u; nx = cnt > 0u ? cnt : 1u;
}

__device__ __forceinline__ void xcd_barrier(const XcdBarrier& b) {
    asm volatile("s_waitcnt vmcnt(0)" ::: "memory");
    __syncthreads();
    if (b.wv == 0 && __builtin_amdgcn_mbcnt_hi(~0u, __builtin_amdgcn_mbcnt_lo(~0u, 0u)) == 0u) {
        unsigned* bar = b.bar;
        __builtin_amdgcn_s_waitcnt(0);
        unsigned nloc = b.st[0], nx = b.st[1];
        if (nloc == 0u) { xcd_barrier_complete(bar, b.x, nloc, nx); b.st[0] = nloc; b.st[1] = nx; }
        const unsigned old = xb_add(&bar[XB_XSUB(b.x)], 1u);
        const unsigned gen = old / nloc;
        if (old + 1u == (gen + 1u) * nloc) {
            __builtin_amdgcn_fence(__ATOMIC_RELEASE, "agent");
            asm volatile("s_waitcnt vmcnt(0)" ::: "memory");
            const unsigned og = xb_add(&bar[XB_TOP], 1u);
            const unsigned tg = og / nx;
            if (og + 1u == (tg + 1u) * nx) xb_add(&bar[XB_TOPGEN], 1u);
            else XB_SPIN(xb_ld(&bar[XB_TOPGEN]) == tg, bar);
            __builtin_amdgcn_fence(__ATOMIC_ACQUIRE, "agent");
            xb_add(&bar[XB_XGEN(b.x)], 1u);
            asm volatile("s_waitcnt vmcnt(0)" ::: "memory");
        } else {
            XB_SPIN(xb_ld(&bar[XB_XGEN(b.x)]) == gen, bar);
            __builtin_amdgcn_fence(__ATOMIC_ACQUIRE, "agent");
            asm volatile("s_waitcnt vmcnt(0)" ::: "memory");
        }
    }
    __syncthreads();
}

typedef float f32x16 __attribute__((ext_vector_type(16)));
typedef short s16x4 __attribute__((ext_vector_type(4)));
typedef __bf16 bf16x2v __attribute__((ext_vector_type(2)));
typedef float f32x2v __attribute__((ext_vector_type(2)));

struct Frame {
    LAS unsigned char* lds;
    unsigned char* ldsg;
    volatile LAS unsigned* MISC;
    gu32* ctl;
    int tid, lane, wave;
    int vcu, G;
    unsigned char* ws;
    float* out;
};
#define IN_F(k) ((const float*)args.in[k])
__device__ __forceinline__ bool frame_refresh(Frame& F) { int l_ = (int)__builtin_amdgcn_mbcnt_hi(~0u, __builtin_amdgcn_mbcnt_lo(~0u, 0u)); asm volatile("" : "+v"(l_)); F.lane = l_; F.tid = F.wave * 64 + l_; return true; }

__device__ __forceinline__ float wave_sum(float v) {
#pragma unroll
    for (int o = 1; o < 64; o <<= 1) v += __shfl_xor(v, o);
    return v;
}
__device__ __forceinline__ float fsig(float x) { return __builtin_amdgcn_rcpf(1.0f + __expf(-x)); }
__device__ __forceinline__ float bf_lo(unsigned u) { return __builtin_bit_cast(float, u << 16); }
__device__ __forceinline__ float bf_hi(unsigned u) { return __builtin_bit_cast(float, u & 0xffff0000u); }
__device__ __forceinline__ unsigned cvtpk(float lo, float hi) { f32x2v v = {lo, hi}; bf16x2v b = __builtin_convertvector(v, bf16x2v); return __builtin_bit_cast(unsigned, b); }
__device__ __forceinline__ float dot2bf(unsigned a, unsigned b, float acc) { return __builtin_amdgcn_fdot2_f32_bf16(__builtin_bit_cast(bf16x2v, a), __builtin_bit_cast(bf16x2v, b), acc, false); }

#ifndef TR_BLK
#define TR_BLK 1
#endif
#ifndef TR_PIPE
#define TR_PIPE 1
#endif
struct TrItem { const float* W; bf16* WT; int K, N, k0, n0; int cm; int pc; };
__device__ __forceinline__ void tr_load(const TrItem& t, float (&r)[32], int lane) {
#pragma unroll
    for (int i = 0; i < 32; ++i) { const int kk = 2 * i + (lane >> 5); r[i] = t.W[(size_t)(t.k0 + kk) * t.N + t.n0 + (lane & 31)]; }
}
__device__ __forceinline__ void tr_proc(const TrItem& t, const float (&r)[32], LAS float* scr, int lane) {
#pragma unroll
    for (int i = 0; i < 32; ++i) { const int kk = 2 * i + (lane >> 5); scr[kk * 33 + (lane & 31)] = r[i]; }
    LDS_WAIT(); asm volatile("" ::: "memory");
    const int c = lane & 7;
#pragma unroll
    for (int j = 0; j < 4; ++j) { const int n = (lane >> 3) + 8 * j; const LAS float* s = scr + (8 * c) * 33 + n;
        v4u o; o.x = pk2(s[0 * 33], s[1 * 33]); o.y = pk2(s[2 * 33], s[3 * 33]); o.z = pk2(s[4 * 33], s[5 * 33]); o.w = pk2(s[6 * 33], s[7 * 33]);
        *(GAS v4u*)(t.WT + (size_t)(t.n0 + n) * t.K + t.k0 + 8 * c) = o; }
    LDS_WAIT(); asm volatile("" ::: "memory");
}
#define SAT8(v_) ((v_) < -127 ? -127 : ((v_) > 127 ? 127 : (v_)))
__device__ __forceinline__ void tr_proc_i8(const TrItem& t, const float (&r)[32], LAS float* scr, int lane, const unsigned* colmax, float* sb, float* sbc) {
#pragma unroll
    for (int i = 0; i < 32; ++i) { const int kk = 2 * i + (lane >> 5); scr[kk * 33 + (lane & 31)] = r[i]; }
    LDS_WAIT(); asm volatile("" ::: "memory");
    const int c = lane & 3;
    float tile_am;
    { const unsigned* cp = colmax + t.cm + (t.n0 & ~255) + 4 * lane; unsigned mx = cp[0] > cp[1] ? cp[0] : cp[1]; const unsigned m2 = cp[2] > cp[3] ? cp[2] : cp[3]; mx = mx > m2 ? mx : m2;
#pragma unroll
      for (int o = 1; o < 64; o <<= 1) { const unsigned ot = (unsigned)__shfl_xor((int)mx, o); mx = mx > ot ? mx : ot; }
      tile_am = __uint_as_float(mx); }
#pragma unroll
    for (int j = 0; j < 2; ++j) { const int n = (lane >> 2) + 16 * j; const LAS float* s = scr + (16 * c) * 33 + n;
        const float am = t.pc ? __uint_as_float(colmax[t.cm + t.n0 + n]) * 1.35f : tile_am; const float inv = am > 0.f ? 127.0f / am : 0.f;
        unsigned w[4];
#pragma unroll
        for (int q = 0; q < 4; ++q) { const int a0 = SAT8(__float2int_rn(s[(4 * q) * 33] * inv)), a1 = SAT8(__float2int_rn(s[(4 * q + 1) * 33] * inv)), a2 = SAT8(__float2int_rn(s[(4 * q + 2) * 33] * inv)), a3 = SAT8(__float2int_rn(s[(4 * q + 3) * 33] * inv));
            w[q] = (unsigned)(a0 & 255) | ((unsigned)(a1 & 255) << 8) | ((unsigned)(a2 & 255) << 16) | ((unsigned)a3 << 24); }
        *(GAS v4u*)((unsigned char*)t.WT + (size_t)(t.n0 + n) * t.K + t.k0 + 16 * c) = (v4u){w[0], w[1], w[2], w[3]};
        if (t.pc) { if (t.k0 == 0 && c == 0) sbc[t.n0 + n] = am * (1.0f / 127.0f); }
        else if (t.k0 == 0 && (t.n0 & 255) == 0 && lane == 0 && j == 0) sb[(t.cm + t.n0) >> 8] = am * (1.0f / 127.0f); }
    LDS_WAIT(); asm volatile("" ::: "memory");
}
__device__ __forceinline__ void tr_load_i8(const TrItem& t, float (&r)[32], v4u& cpv, unsigned (&pcv)[2], int lane, const unsigned* colmax) {
    cpv = *(const v4u*)(colmax + t.cm + (t.n0 & ~255) + 4 * lane);
    pcv[0] = colmax[t.cm + t.n0 + (lane >> 2)]; pcv[1] = colmax[t.cm + t.n0 + (lane >> 2) + 16];
#pragma unroll
    for (int i = 0; i < 32; ++i) { const int kk = 2 * i + (lane >> 5); r[i] = t.W[(size_t)(t.k0 + kk) * t.N + t.n0 + (lane & 31)]; }
}
__device__ __forceinline__ void tr_proc_i8_nb(const TrItem& t, const float (&r)[32], const v4u cpv, const unsigned (&pcv)[2], LAS float* scr, int lane) {
#pragma unroll
    for (int i = 0; i < 32; ++i) { const int kk = 2 * i + (lane >> 5); scr[kk * 33 + (lane & 31)] = r[i]; }
    LDS_WAIT(); asm volatile("" ::: "memory");
    const int c = lane & 3;
    float tile_am;
    { unsigned mx = cpv.x > cpv.y ? cpv.x : cpv.y; const unsigned m2 = cpv.z > cpv.w ? cpv.z : cpv.w; mx = mx > m2 ? mx : m2;
#pragma unroll
      for (int o = 1; o < 64; o <<= 1) { const unsigned ot = (unsigned)__shfl_xor((int)mx, o); mx = mx > ot ? mx : ot; }
      tile_am = __uint_as_float(mx); }
#pragma unroll
    for (int j = 0; j < 2; ++j) { const int n = (lane >> 2) + 16 * j; const LAS float* s = scr + (16 * c) * 33 + n;
        const float am = t.pc ? __uint_as_float(pcv[j]) * 1.35f : tile_am; const float inv = am > 0.f ? 127.0f / am : 0.f;
        unsigned w[4];
#pragma unroll
        for (int q = 0; q < 4; ++q) { const int a0 = SAT8(__float2int_rn(s[(4 * q) * 33] * inv)), a1 = SAT8(__float2int_rn(s[(4 * q + 1) * 33] * inv)), a2 = SAT8(__float2int_rn(s[(4 * q + 2) * 33] * inv)), a3 = SAT8(__float2int_rn(s[(4 * q + 3) * 33] * inv));
            w[q] = (unsigned)(a0 & 255) | ((unsigned)(a1 & 255) << 8) | ((unsigned)(a2 & 255) << 16) | ((unsigned)a3 << 24); }
        *(GAS v4u*)((unsigned char*)t.WT + (size_t)(t.n0 + n) * t.K + t.k0 + 16 * c) = (v4u){w[0], w[1], w[2], w[3]}; }
    LDS_WAIT(); asm volatile("" ::: "memory");
}
#ifndef CM_STRIDE
#define CM_STRIDE 8
#endif
__device__ __forceinline__ void colmax_item(const float* W, int N, int item, int lane, unsigned* colmax) {
    const int nblk = N / 256, kb = item / nblk, nb = item % nblk;
    const float* p = W + (size_t)(64 * kb) * N + 256 * nb + 4 * lane;
    f32x4 mx = {0.f, 0.f, 0.f, 0.f};
#pragma unroll
    for (int i = 0; i < 64; i += CM_STRIDE) { const f32x4 v = *(const f32x4*)(p + (size_t)i * N); mx = __builtin_elementwise_max(mx, __builtin_elementwise_abs(v)); }
    unsigned* c = colmax + 256 * nb + 4 * lane;
    atomicMax(c, __float_as_uint(mx[0])); atomicMax(c + 1, __float_as_uint(mx[1])); atomicMax(c + 2, __float_as_uint(mx[2])); atomicMax(c + 3, __float_as_uint(mx[3]));
}
__device__ __forceinline__ void p0_ada_item(Frame& F, const float* c, const float* W, const float* bias, float* ada, int item) {
    const int n0 = item * 64, lane = F.lane, w = F.wave;
    float acc[8];
#pragma unroll
    for (int b = 0; b < 8; ++b) acc[b] = 0.f;
    float wa[16], wb[16];
    const float* Wp = W + (size_t)(256 * w) * ADA_W + n0 + lane;
#define ADA_LOAD(V, g_) do { _Pragma("unroll") for (int i = 0; i < 16; ++i) V[i] = Wp[(size_t)((g_) * 16 + i) * ADA_W]; } while (0)
#define ADA_FMA(V, gi_) do { _Pragma("unroll") for (int i = 0; i < 16; ++i) _Pragma("unroll") for (int b = 0; b < 8; ++b) { \
        const float s_ = __builtin_bit_cast(float, __builtin_amdgcn_readlane(__builtin_bit_cast(int, sc[b]), (gi_) * 16 + i)); acc[b] += s_ * V[i]; } } while (0)
    ADA_LOAD(wa, 0);
    for (int kb = 0; kb < 4; ++kb) {
        const int k0 = 256 * w + 64 * kb;
        float sc[8];
#pragma unroll
        for (int b = 0; b < 8; ++b) { const float cv = c[b * DM + k0 + lane]; sc[b] = cv * fsig(cv); }
        ADA_LOAD(wb, 4 * kb + 1); ADA_FMA(wa, 0);
        ADA_LOAD(wa, 4 * kb + 2); ADA_FMA(wb, 1);
        ADA_LOAD(wb, 4 * kb + 3); ADA_FMA(wa, 2);
        if (kb < 3) ADA_LOAD(wa, 4 * kb + 4);
        ADA_FMA(wb, 3);
    }
#undef ADA_LOAD
#undef ADA_FMA
    LAS float* red = (LAS float*)(F.lds + RING_OFF);
#pragma unroll
    for (int b = 0; b < 8; ++b) red[(w * 8 + b) * 64 + lane] = acc[b];
    __syncthreads();
    { const int b = F.tid >> 6, col = F.tid & 63; float s = 0.f;
#pragma unroll
      for (int ww = 0; ww < 8; ++ww) s += red[(ww * 8 + b) * 64 + col];
      ada[b * ADA_W + n0 + col] = s + bias[n0 + col]; }
    __syncthreads();
}
#ifndef I8_Q
#define I8_Q 1
#endif
#ifndef I8_AB
#define I8_AB 1
#endif
#ifndef I8_O
#define I8_O 1
#endif
template <int PART> __device__ __forceinline__ void p0_prologue(Frame& F, const float* c, const int* positions, const float* w_ada, const float* b_ada,
                                            const float* w_in, const float* w_ba, const float* w_bh, const float* w_out, const float* w_q) {
    float* ada = (float*)(F.ws + WS_ADA);
    unsigned* colmax = (unsigned*)(F.ws + WS_COLMAX); float* sb = (float*)(F.ws + WS_SB);
    const int gw = F.vcu * NWAVES + F.wave, NGW = F.G * NWAVES, lane = F.lane;
    if (PART == 0) {
        constexpr int C_IN = (DM / 64) * (IN_W / 256), C_Q = I8_Q ? (DM / 64) * (DM / 256) : 0, C_A = I8_AB ? (1024 / 64) * (DM / 256) : 0, C_O = I8_O ? (DM / 64) * (DM / 256) : 0;
        for (int it = gw; it < C_IN + C_Q + 2 * C_A + C_O; it += NGW) { int r = it;
            if (r < C_IN) { colmax_item(w_in, IN_W, r, lane, colmax + CM_IN); continue; } r -= C_IN;
            if (r < C_Q) { colmax_item(w_q, DM, r, lane, colmax + CM_Q); continue; } r -= C_Q;
            if (r < C_A) { colmax_item(w_ba, DM, r, lane, colmax + CM_A); continue; } r -= C_A;
            if (r < C_A) { colmax_item(w_bh, DM, r, lane, colmax + CM_B); continue; } r -= C_A;
            colmax_item(w_out, DM, r, lane, colmax + CM_O); }
        for (int it = F.vcu; it < ADA_W / 64; it += F.G) p0_ada_item(F, c, w_ada, b_ada, ada, it);
    }
    LAS float* scr = (LAS float*)(F.lds + RING_OFF + 16384 + F.wave * 12288);
    constexpr int I_IN = (DM / 64) * (IN_W / 32), I_B = (1024 / 64) * (DM / 32), I_O = (DM / 64) * (DM / 32);
    constexpr int I_BF = 2 * I_B + 2 * I_O, NITEMS = I_BF + I_IN;
    constexpr int N_EARLY_OK = (I8_AB ? 0 : 2 * I_B) + ((I8_AB || I8_O) ? 0 : I_O);
    constexpr int TR_EARLY = N_EARLY_OK < 64 * NWAVES * 4 ? N_EARLY_OK : 64 * NWAVES * 4;
    auto mk = [&](int it) { TrItem t; int r = it;
        if (r < I_B) { t.W = w_ba; t.WT = (bf16*)(F.ws + WS_WA); t.K = 1024; t.N = DM; t.cm = I8_AB ? CM_A : -1; t.pc = 0; }
        else if ((r -= I_B) < I_B) { t.W = w_bh; t.WT = (bf16*)(F.ws + WS_WB); t.K = 1024; t.N = DM; t.cm = I8_AB ? CM_B : -1; t.pc = 0; }
        else if ((r -= I_B) < I_O) { t.W = w_out; t.WT = (bf16*)(F.ws + WS_WOUT); t.K = DM; t.N = DM; t.cm = I8_O ? CM_O : -1; t.pc = 0; }
        else if ((r -= I_O) < I_O) { t.W = w_q; t.WT = (bf16*)(F.ws + WS_WQ); t.K = DM; t.N = DM; t.cm = I8_Q ? CM_Q : -1; t.pc = 1; }
        else { r -= I_O; t.W = w_in; t.WT = (bf16*)(F.ws + WS_WIN); t.K = DM; t.N = IN_W; t.cm = CM_IN; t.pc = 0; }
        const int nblk = t.N / 32;
#if TR_BLK == 0
        t.k0 = 64 * (r / nblk); t.n0 = 32 * (r % nblk);
#else
        { constexpr int TR_BK = (TR_BLK == 1) ? 2 : 4, TR_BN = 8 / TR_BK; const int g8 = r >> 3, w8 = r & 7, nsb = nblk / TR_BN;
          t.k0 = 64 * (TR_BK * (g8 / nsb) + w8 / TR_BN); t.n0 = 32 * (TR_BN * (g8 % nsb) + w8 % TR_BN); }
#endif
        return t; };
#ifndef TR_LATE
#define TR_LATE 1
#endif
    if ((PART == 1 || PART == 5) && TR_PIPE && I8_Q && I8_AB && I8_O) {
        float ra[32], rb[32]; v4u cpa, cpb; unsigned pca[2], pcb[2];
        const int first = PART == 5 ? ((int)blockIdx.x >> 1) * NWAVES + F.wave : (TR_LATE ? I_BF + gw : gw);
        const int stride = PART == 5 ? (F.G >> 1) * NWAVES : NGW, endi = PART == 5 ? I_BF : NITEMS;
        const int nit = (endi - first + stride - 1) / stride;
        if (nit > 0) {
            { const TrItem t0 = mk(first); tr_load_i8(t0, ra, cpa, pca, lane, colmax); }
#pragma unroll 1
            for (int j = 0; j < nit; j += 2) {
                const TrItem ta = mk(first + j * stride), tb = mk(first + (j + 1 < nit ? j + 1 : nit - 1) * stride), tc = mk(first + (j + 2 < nit ? j + 2 : nit - 1) * stride);
                tr_load_i8(tb, rb, cpb, pcb, lane, colmax); __builtin_amdgcn_sched_barrier(0);
                tr_proc_i8_nb(ta, ra, cpa, pca, scr, lane); __builtin_amdgcn_sched_barrier(0);
                tr_load_i8(tc, ra, cpa, pca, lane, colmax); __builtin_amdgcn_sched_barrier(0);
                tr_proc_i8_nb(tb, rb, cpb, pcb, scr, lane); __builtin_amdgcn_sched_barrier(0);
            }
        }
        if (PART == 5) return;
        for (int tix = gw; tix < CM_END / 256; tix += NGW) { const v4u cv = *(const v4u*)(colmax + 256 * tix + 4 * lane);
            unsigned mx = cv.x > cv.y ? cv.x : cv.y; const unsigned m2 = cv.z > cv.w ? cv.z : cv.w; mx = mx > m2 ? mx : m2;
#pragma unroll
            for (int o = 1; o < 64; o <<= 1) { const unsigned ot = (unsigned)__shfl_xor((int)mx, o); mx = mx > ot ? mx : ot; }
            if (lane == 0) sb[tix] = __uint_as_float(mx) * (1.0f / 127.0f); }
        for (int n = gw * 64 + lane; n < DM; n += NGW * 64) ((float*)(F.ws + WS_SBC))[n] = __uint_as_float(colmax[CM_Q + n]) * 1.35f * (1.0f / 127.0f);
        return;
    }
    float ra[32], rb[32];
    int it, step, end;
    if (PART == 0) { if (F.vcu < ADA_W / 64) return; it = (F.vcu - ADA_W / 64) * NWAVES + F.wave; step = (F.G - ADA_W / 64) * NWAVES; end = TR_EARLY; }
    else { it = TR_EARLY + gw; step = NGW; end = NITEMS; }
#define TR_PROC(T_, R_, IT_) do { if ((T_).cm >= 0) tr_proc_i8(T_, R_, scr, lane, colmax, sb, (float*)(F.ws + WS_SBC)); else tr_proc(T_, R_, scr, lane); } while (0)
    if (it < end) { const TrItem t = mk(it); tr_load(t, ra, lane); }
    for (; it < end; it += 2 * step) {
        const TrItem ta = mk(it);
        if (it + step < end) { const TrItem tb = mk(it + step); tr_load(tb, rb, lane); }
        TR_PROC(ta, ra, it);
        if (it + step < end) { const TrItem tb = mk(it + step);
            if (it + 2 * step < end) { const TrItem tc = mk(it + 2 * step); tr_load(tc, ra, lane); }
            TR_PROC(tb, rb, it + step); }
    }
#undef TR_PROC
}

__device__ __forceinline__ void mod_rows(Frame& F, const float* X, const float* g, const float* shift, const float* scale, bf16* O) {
    const int gw = F.vcu * NWAVES + F.wave, NGW = F.G * NWAVES, lane = F.lane;
    f32x4 va[8], vb[8];
#define MR_LOAD(V, m_) do { const GAS f32x4* xr_ = (const GAS f32x4*)(X + (size_t)(m_) * DM) + lane; _Pragma("unroll") for (int j = 0; j < 8; ++j) V[j] = xr_[64 * j]; } while (0)
#define MR_PROC(V, m_) do { const int b_ = (m_) / SEQ; float s_ = 0.f; \
        _Pragma("unroll") for (int j = 0; j < 8; ++j) s_ += (V[j].x * V[j].x + V[j].y * V[j].y) + (V[j].z * V[j].z + V[j].w * V[j].w); \
        const float rstd_ = __builtin_amdgcn_rsqf(wave_sum(s_) * (1.0f / DM) + EPS); \
        GAS unsigned long long* o8_ = (GAS unsigned long long*)(O + (size_t)(m_) * DM) + lane; \
        _Pragma("unroll") for (int j = 0; j < 8; ++j) { const int col_ = (64 * j + lane) * 4; \
            const f32x4 gg_ = *(const f32x4*)(g + col_), sc_ = *(const f32x4*)(scale + (size_t)b_ * ADA_W + col_), sh_ = *(const f32x4*)(shift + (size_t)b_ * ADA_W + col_); \
            const f32x4 h_ = V[j] * rstd_ * gg_ * (sc_ + 1.0f) + sh_; \
            o8_[64 * j] = (unsigned long long)cvtpk(h_.x, h_.y) | ((unsigned long long)cvtpk(h_.z, h_.w) << 32); } } while (0)
    int m = gw;
    if (m < T) MR_LOAD(va, m);
    for (; m < T; m += 2 * NGW) {
        if (m + NGW < T) MR_LOAD(vb, m + NGW);
        MR_PROC(va, m);
        if (m + NGW < T) { if (m + 2 * NGW < T) MR_LOAD(va, m + 2 * NGW); MR_PROC(vb, m + NGW); }
    }
#undef MR_LOAD
#undef MR_PROC
}

typedef unsigned v2u_mr __attribute__((ext_vector_type(2)));
template <int QMAX = 127, bool XB = false> __device__ __forceinline__ void mod_rows_i8(Frame& F, const float* X, const float* g, const float* shift, const float* scale, unsigned char* O, float* sa) {
    const int gw = F.vcu * NWAVES + F.wave, NGW = F.G * NWAVES, lane = F.lane;
    const int WPB = NGW / BATCH, RPW = SEQ / WPB, b_ = gw / WPB, mb = b_ * SEQ + (gw % WPB);
    f32x4 va[8], vb[8], gs[8], sh[8];
#pragma unroll
    for (int j = 0; j < 8; ++j) { const int col_ = (64 * j + lane) * 4;
        gs[j] = *(const f32x4*)(g + col_) * (*(const f32x4*)(scale + (size_t)b_ * ADA_W + col_) + 1.0f); sh[j] = *(const f32x4*)(shift + (size_t)b_ * ADA_W + col_); }
#define MR_LOAD(V, m_) do { if (XB) { const GAS v2u_mr* xr_ = (const GAS v2u_mr*)((const bf16*)X + (size_t)(m_) * DM) + lane;     \
            _Pragma("unroll") for (int j = 0; j < 8; ++j) { const v2u_mr w_ = xr_[64 * j]; V[j] = (f32x4){bf_lo(w_.x), bf_hi(w_.x), bf_lo(w_.y), bf_hi(w_.y)}; } } \
        else { const GAS f32x4* xr_ = (const GAS f32x4*)(X + (size_t)(m_) * DM) + lane; _Pragma("unroll") for (int j = 0; j < 8; ++j) V[j] = xr_[64 * j]; } } while (0)
#define MR_PROC(V, m_) do { float s_ = 0.f; \
        _Pragma("unroll") for (int j = 0; j < 8; ++j) s_ += (V[j].x * V[j].x + V[j].y * V[j].y) + (V[j].z * V[j].z + V[j].w * V[j].w); \
        const float rstd_ = __builtin_amdgcn_rsqf(wave_sum(s_) * (1.0f / DM) + EPS); float am_ = 0.f; \
        _Pragma("unroll") for (int j = 0; j < 8; ++j) { \
            V[j] = V[j] * rstd_ * gs[j] + sh[j]; \
            am_ = fmaxf(am_, fmaxf(fmaxf(__builtin_fabsf(V[j].x), __builtin_fabsf(V[j].y)), fmaxf(__builtin_fabsf(V[j].z), __builtin_fabsf(V[j].w)))); } \
        _Pragma("unroll") for (int o = 1; o < 64; o <<= 1) am_ = fmaxf(am_, __shfl_xor(am_, o)); \
        const float inv_ = am_ > 0.f ? (float)QMAX / am_ : 0.f; \
        GAS unsigned* o4_ = (GAS unsigned*)(O + (size_t)(m_) * DM) + lane; \
        _Pragma("unroll") for (int j = 0; j < 8; ++j) { const int a0 = __float2int_rn(V[j].x * inv_), a1 = __float2int_rn(V[j].y * inv_), a2 = __float2int_rn(V[j].z * inv_), a3 = __float2int_rn(V[j].w * inv_); \
            o4_[64 * j] = (unsigned)(a0 & 255) | ((unsigned)(a1 & 255) << 8) | ((unsigned)(a2 & 255) << 16) | ((unsigned)a3 << 24); } \
        sa[m_] = am_ * (1.0f / (float)QMAX); } while (0)
    MR_LOAD(va, mb);
#pragma unroll 1
    for (int j = 0; j < RPW; j += 2) {
        const int m0_ = mb + j * WPB, m1_ = mb + (j + 1 < RPW ? j + 1 : RPW - 1) * WPB, m2_ = mb + (j + 2 < RPW ? j + 2 : RPW - 1) * WPB;
        MR_LOAD(vb, m1_); __builtin_amdgcn_sched_barrier(0); MR_PROC(va, m0_); __builtin_amdgcn_sched_barrier(0);
        MR_LOAD(va, m2_); __builtin_amdgcn_sched_barrier(0); MR_PROC(vb, m1_); __builtin_amdgcn_sched_barrier(0);
    }
#undef MR_LOAD
#undef MR_PROC
}

__device__ __forceinline__ void quant_rows_bf16(Frame& F, const bf16* X, unsigned char* O, float* sa) {
    const int gw = F.vcu * NWAVES + F.wave, NGW = F.G * NWAVES, lane = F.lane;
    v4u va[4], vb[4];
#define QR_LOAD(V, m_) do { _Pragma("unroll") for (int j = 0; j < 4; ++j) V[j] = *(const v4u*)(X + (size_t)(m_) * DM + (j * 64 + lane) * 8); } while (0)
#define QR_PROC(V, m_) do { float f_[32]; float am_ = 0.f; \
        _Pragma("unroll") for (int j = 0; j < 4; ++j) { const unsigned w_[4] = {V[j].x, V[j].y, V[j].z, V[j].w}; \
            _Pragma("unroll") for (int q = 0; q < 4; ++q) { f_[8 * j + 2 * q] = bf_lo(w_[q]); f_[8 * j + 2 * q + 1] = bf_hi(w_[q]); am_ = fmaxf(am_, fmaxf(__builtin_fabsf(f_[8 * j + 2 * q]), __builtin_fabsf(f_[8 * j + 2 * q + 1]))); } } \
        _Pragma("unroll") for (int o = 1; o < 64; o <<= 1) am_ = fmaxf(am_, __shfl_xor(am_, o)); \
        const float inv_ = am_ > 0.f ? 127.0f / am_ : 0.f; \
        _Pragma("unroll") for (int j = 0; j < 4; ++j) { unsigned o_[2]; \
            _Pragma("unroll") for (int h = 0; h < 2; ++h) { const int a0 = __float2int_rn(f_[8 * j + 4 * h] * inv_), a1 = __float2int_rn(f_[8 * j + 4 * h + 1] * inv_), a2 = __float2int_rn(f_[8 * j + 4 * h + 2] * inv_), a3 = __float2int_rn(f_[8 * j + 4 * h + 3] * inv_); \
                o_[h] = (unsigned)(a0 & 255) | ((unsigned)(a1 & 255) << 8) | ((unsigned)(a2 & 255) << 16) | ((unsigned)a3 << 24); } \
            *(unsigned long long*)(O + (size_t)(m_) * DM + (j * 64 + lane) * 8) = (unsigned long long)o_[0] | ((unsigned long long)o_[1] << 32); } \
        if (lane == 0) sa[m_] = am_ * (1.0f / 127.0f); } while (0)
    int m = gw;
    if (m < T) QR_LOAD(va, m);
    for (; m < T; m += 2 * NGW) {
        if (m + NGW < T) QR_LOAD(vb, m + NGW);
        QR_PROC(va, m);
        if (m + NGW < T) { if (m + 2 * NGW < T) QR_LOAD(va, m + 2 * NGW); QR_PROC(vb, m + NGW); }
    }
#undef QR_LOAD
#undef QR_PROC
}

namespace hg {
constexpr int LQ = 272, LV = 144;
constexpr int O_QI = 0, O_KI = 17408, O_QB = 34816, O_KDT = 52224, O_VT = 70656, O_AM = 79872, O_ST = 89088, O_PART = 106496, O_A = 110592, O_END = 111104;
typedef short bf16x8 __attribute__((ext_vector_type(8)));
typedef float f32x4 __attribute__((ext_vector_type(4)));
__device__ __forceinline__ bf16x8 ldfrag(const LAS unsigned char* p) { return *(const LAS bf16x8*)p; }
}
__device__ __forceinline__ void hgrn_item(Frame& F, int item, const float* lb_fwd, const float* lb_bwd) {
    using namespace hg;
    const int b = item >> 5, h = (item >> 2) & 7, dir = (item >> 1) & 1, vh = item & 1;
    LAS unsigned char* L = F.lds + RING_OFF;
    const int tid = F.tid, lane = F.lane, w = F.wave;
    const int d0 = 2 * lane;
    float lb[2];
    { const float* tbl = dir ? lb_bwd : lb_fwd;
#pragma unroll
      for (int i = 0; i < 2; ++i) { const float t0 = tbl[h * 128 + d0 + i], t1 = tbl[1024 + h * 128 + d0 + i]; lb[i] = 1.0f / (1.0f + __expf(t0 - t1)); } }
    f32x4 st[4];
#pragma unroll
    for (int i = 0; i < 4; ++i) st[i] = (f32x4){0.f, 0.f, 0.f, 0.f};
    for (int i = tid; i < 17408 / 4; i += 512) ((LAS unsigned*)(L + O_ST))[i] = 0u;
    const size_t rowbase = (size_t)b * SEQ;
    const bf16* Qg = (const bf16*)(F.ws + WS_HGQ) + rowbase * 1024 + h * 128 + d0;
    const bf16* Fg = (const bf16*)(F.ws + (dir ? WS_HFB : WS_HFF)) + rowbase * 1024 + h * 128 + d0;
    const int vp = tid & 31, pg = (tid >> 5) & 7;
    const bf16* Vg = (const bf16*)(F.ws + WS_HGI) + rowbase * 1024 + h * 128 + vh * 64 + 2 * vp;
    bf16* Og = (bf16*)(F.ws + (dir ? WS_OBW : WS_OF)) + rowbase * 1024 + h * 128 + vh * 64;
    unsigned qrawA[8], frawA[8], vrawA[8], qrawB[8], frawB[8], vrawB[8];
#define HG_LOAD(QR, FR, VR, ch) do { const size_t t0_ = (size_t)(ch) * 64; \
        _Pragma("unroll") for (int p = 0; p < 8; ++p) { QR[p] = *(const unsigned*)(Qg + (t0_ + 8 * w + p) * 1024); FR[p] = *(const unsigned*)(Fg + (t0_ + 8 * w + p) * 1024); } \
        if (tid < 256) { _Pragma("unroll") for (int p = 0; p < 8; ++p) VR[p] = *(const unsigned*)(Vg + (t0_ + 8 * pg + p) * 1024); } } while (0)
    HG_LOAD(qrawA, frawA, vrawA, dir ? 31 : 0);
    HG_LOAD(qrawB, frawB, vrawB, dir ? 30 : 1);
    __syncthreads();
    const int tb = w >> 1, hf = w & 1, l15 = lane & 15, l4 = lane >> 4;
    auto step = [&](const int c, unsigned (&qraw)[8], unsigned (&fraw)[8], unsigned (&vraw)[8]) __attribute__((always_inline)) {
        const int ch = dir ? 31 - c : c;
        float cp[8][2], kk[8][2], qq[8][2];
#pragma unroll
        for (int p = 0; p < 8; ++p) {
#pragma unroll
            for (int i = 0; i < 2; ++i) { const float x = i ? bf_hi(fraw[p]) : bf_lo(fraw[p]); const float sg = __builtin_amdgcn_rcpf(1.0f + __builtin_amdgcn_exp2f(x * -1.4426950408889634f)); const float f = lb[i] + (1.0f - lb[i]) * sg;
                cp[p][i] = f; kk[p][i] = 1.0f - f; qq[p][i] = i ? bf_hi(qraw[p]) : bf_lo(qraw[p]); } }
        float tot[2];
#pragma unroll
        for (int i = 0; i < 2; ++i) { float run = 1.0f;
            if (!dir) {
#pragma unroll
                for (int p = 0; p < 8; ++p) { run *= cp[p][i]; cp[p][i] = run; }
            } else {
#pragma unroll
                for (int p = 7; p >= 0; --p) { run *= cp[p][i]; cp[p][i] = run; }
            }
            tot[i] = __builtin_amdgcn_logf(run); }
        { LAS float* part = (LAS float*)(L + O_PART); *(LAS f32x2v*)(part + w * 128 + d0) = (f32x2v){tot[0], tot[1]}; }
        __syncthreads();
        float offs[2] = {0.f, 0.f}, rr[2] = {0.f, 0.f}, bt[2] = {0.f, 0.f};
        { const LAS float* part = (const LAS float*)(L + O_PART);
#pragma unroll
          for (int w2 = 0; w2 < 8; ++w2) { const f32x2v pv = *(const LAS f32x2v*)(part + w2 * 128 + d0);
              const bool before = dir ? (w2 > w) : (w2 < w); const bool inr = dir ? (w2 >= 4) : (w2 < 4);
#pragma unroll
              for (int i = 0; i < 2; ++i) { bt[i] += pv[i]; offs[i] += before ? pv[i] : 0.f; rr[i] += inr ? pv[i] : 0.f; } } }
        float er[2], el[2];
#pragma unroll
        for (int i = 0; i < 2; ++i) { er[i] = __builtin_amdgcn_exp2f(rr[i]); el[i] = __builtin_amdgcn_exp2f(bt[i] - rr[i]); }
        if (w == 0) { LAS float* aa = (LAS float*)(L + O_A); *(LAS f32x2v*)(aa + d0) = (f32x2v){__builtin_amdgcn_exp2f(bt[0]), __builtin_amdgcn_exp2f(bt[1])}; }
        unsigned kdp[2][4];
        const float b1[2] = {__builtin_amdgcn_exp2f(offs[0] - rr[0]), __builtin_amdgcn_exp2f(offs[1] - rr[1])};
#pragma unroll
        for (int p = 0; p < 8; ++p) {
            float qi[2], ki[2], qb[2], kd[2];
#pragma unroll
            for (int i = 0; i < 2; ++i) { const float e1 = b1[i] * cp[p][i], e2 = __builtin_amdgcn_rcpf(e1);
                qi[i] = qq[p][i] * e1; ki[i] = kk[p][i] * e2; qb[i] = qi[i] * er[i]; kd[i] = ki[i] * el[i]; }
            const int pos = 8 * w + p;
            *(LAS unsigned*)(L + O_QI + pos * LQ + d0 * 2) = cvtpk(qi[0], qi[1]);
            *(LAS unsigned*)(L + O_KI + pos * LQ + d0 * 2) = cvtpk(ki[0], ki[1]);
            *(LAS unsigned*)(L + O_QB + pos * LQ + d0 * 2) = cvtpk(qb[0], qb[1]);
            if (p & 1) { kdp[0][p >> 1] = (kdp[0][p >> 1] & 0xffffu) | (cvtpk(0.f, kd[0]) & 0xffff0000u); kdp[1][p >> 1] = (kdp[1][p >> 1] & 0xffffu) | (cvtpk(0.f, kd[1]) & 0xffff0000u); }
            else { kdp[0][p >> 1] = cvtpk(kd[0], 0.f) & 0xffffu; kdp[1][p >> 1] = cvtpk(kd[1], 0.f) & 0xffffu; }
        }
#pragma unroll
        for (int i = 0; i < 2; ++i) *(LAS v4u*)(L + O_KDT + (d0 + i) * LV + (8 * w) * 2) = (v4u){kdp[i][0], kdp[i][1], kdp[i][2], kdp[i][3]};
        if (tid < 256) {
            unsigned v0[4], v1[4];
#pragma unroll
            for (int p = 0; p < 8; p += 2) { v0[p >> 1] = (vraw[p] & 0xffffu) | (vraw[p + 1] << 16); v1[p >> 1] = (vraw[p] >> 16) | (vraw[p + 1] & 0xffff0000u); }
            *(LAS v4u*)(L + O_VT + (2 * vp) * LV + (8 * pg) * 2) = (v4u){v0[0], v0[1], v0[2], v0[3]};
            *(LAS v4u*)(L + O_VT + (2 * vp + 1) * LV + (8 * pg) * 2) = (v4u){v1[0], v1[1], v1[2], v1[3]};
        }
        if (c + 2 < 32) HG_LOAD(qraw, fraw, vraw, dir ? 29 - c : c + 2);
        __syncthreads();
        f32x4 ao[2], au[4];
#pragma unroll
        for (int sbi = 0; sbi < 2; ++sbi) {
            const int sb = 2 * hf + sbi; f32x4 a = (f32x4){0.f, 0.f, 0.f, 0.f};
#pragma unroll
            for (int ks = 0; ks < 4; ++ks) a = __builtin_amdgcn_mfma_f32_16x16x32_bf16(ldfrag(L + O_KI + (16 * sb + l15) * LQ + ks * 64 + l4 * 16), ldfrag(L + O_QI + (16 * tb + l15) * LQ + ks * 64 + l4 * 16), a, 0, 0, 0);
            const int tt = 16 * tb + l15, s0 = 16 * sb + 4 * l4;
            float m[4];
#pragma unroll
            for (int r = 0; r < 4; ++r) { const int ss = s0 + r; const bool keep = dir ? (ss >= tt) : (ss <= tt); m[r] = keep ? a[r] : 0.f; }
            *(LAS unsigned long long*)(L + O_AM + tt * LV + s0 * 2) = (unsigned long long)cvtpk(m[0], m[1]) | ((unsigned long long)cvtpk(m[2], m[3]) << 32);
        }
#pragma unroll
        for (int vbi = 0; vbi < 2; ++vbi) {
            const int vb = 2 * hf + vbi; f32x4 a = (f32x4){0.f, 0.f, 0.f, 0.f};
#pragma unroll
            for (int ks = 0; ks < 4; ++ks) a = __builtin_amdgcn_mfma_f32_16x16x32_bf16(ldfrag(L + O_ST + (16 * vb + l15) * LQ + ks * 64 + l4 * 16), ldfrag(L + O_QB + (16 * tb + l15) * LQ + ks * 64 + l4 * 16), a, 0, 0, 0);
            ao[vbi] = a;
        }
#pragma unroll
        for (int vb = 0; vb < 4; ++vb) {
            f32x4 a = (f32x4){0.f, 0.f, 0.f, 0.f};
#pragma unroll
            for (int ks = 0; ks < 2; ++ks) a = __builtin_amdgcn_mfma_f32_16x16x32_bf16(ldfrag(L + O_KDT + (16 * w + l15) * LV + ks * 64 + l4 * 16), ldfrag(L + O_VT + (16 * vb + l15) * LV + ks * 64 + l4 * 16), a, 0, 0, 0);
            au[vb] = a;
        }
        __syncthreads();
#pragma unroll
        for (int vbi = 0; vbi < 2; ++vbi) {
            const int vb = 2 * hf + vbi; f32x4 a = ao[vbi];
#pragma unroll
            for (int ks = 0; ks < 2; ++ks) a = __builtin_amdgcn_mfma_f32_16x16x32_bf16(ldfrag(L + O_VT + (16 * vb + l15) * LV + ks * 64 + l4 * 16), ldfrag(L + O_AM + (16 * tb + l15) * LV + ks * 64 + l4 * 16), a, 0, 0, 0);
            *(unsigned long long*)(Og + ((size_t)ch * 64 + 16 * tb + l15) * 1024 + 16 * vb + 4 * l4) = (unsigned long long)cvtpk(a[0], a[1]) | ((unsigned long long)cvtpk(a[2], a[3]) << 32);
        }
        { const f32x4 av = *(const LAS f32x4*)(L + O_A + (16 * w + 4 * l4) * 4);
#pragma unroll
          for (int vb = 0; vb < 4; ++vb) { st[vb] = av * st[vb] + au[vb];
              *(LAS unsigned long long*)(L + O_ST + (16 * vb + l15) * LQ + (16 * w + 4 * l4) * 2) = (unsigned long long)cvtpk(st[vb][0], st[vb][1]) | ((unsigned long long)cvtpk(st[vb][2], st[vb][3]) << 32); } }
    };
#pragma unroll 1
    for (int c = 0; c < 32; c += 2) { step(c, qrawA, frawA, vrawA); step(c + 1, qrawB, frawB, vrawB); }
    __syncthreads();
#undef HG_LOAD
}


namespace at {
typedef short bf16x8 __attribute__((ext_vector_type(8)));
constexpr int SHM_V = 16384, SHM_K = 8192, O_V = 0, O_K = 32768, O_WS = 49152, LDK = 1024;
#define AT_SBAR() __builtin_amdgcn_sched_barrier(0)
#define KSWZ64(row, ch) ((row) * 128 + ((((ch) ^ (((row) >> 1) & 7))) << 4))
__device__ __forceinline__ int crow(int r, int hi) { return (r & 3) + 8 * (r >> 2) + 4 * hi; }
__device__ __forceinline__ void partialSM(f32x16& p0, f32x16& p1, float& m_reg, float& mn, float& alpha) {
  float pmax = p0[0];
#pragma unroll
  for (int r = 1; r < 16; ++r) pmax = fmaxf(pmax, p0[r]);
#pragma unroll
  for (int r = 0; r < 16; ++r) pmax = fmaxf(pmax, p1[r]);
  { auto rr = __builtin_amdgcn_permlane32_swap(__float_as_uint(pmax), __float_as_uint(pmax), false, false);
    pmax = fmaxf(__uint_as_float(rr[0]), __uint_as_float(rr[1])); }
  if (__builtin_expect(__all(pmax - m_reg <= THRL), 1)) { mn = m_reg; alpha = 1.f; }
  else { mn = fmaxf(m_reg, pmax); alpha = __builtin_amdgcn_exp2f(m_reg - mn); m_reg = mn; }
#pragma unroll
  for (int r = 0; r < 16; ++r) p0[r] = p0[r] - mn;
#pragma unroll
  for (int r = 0; r < 16; ++r) p1[r] = p1[r] - mn;
#pragma unroll
  for (int r = 0; r < 16; ++r) p0[r] = __builtin_amdgcn_exp2f(p0[r]);
}
__device__ __forceinline__ void partialSM_rel(f32x16& p0, f32x16& p1, float& m_reg, float& alpha) {
  float pmax = p0[0];
#pragma unroll
  for (int r = 1; r < 16; ++r) pmax = fmaxf(pmax, p0[r]);
#pragma unroll
  for (int r = 0; r < 16; ++r) pmax = fmaxf(pmax, p1[r]);
  { auto rr = __builtin_amdgcn_permlane32_swap(__float_as_uint(pmax), __float_as_uint(pmax), false, false);
    pmax = fmaxf(__uint_as_float(rr[0]), __uint_as_float(rr[1])); }
  if (__builtin_expect(__all(pmax <= THRL), 1)) { alpha = 1.f; }
  else { const float d = fmaxf(pmax, 0.f); alpha = __builtin_amdgcn_exp2f(-d); m_reg += d;
#pragma unroll
    for (int r = 0; r < 16; ++r) { p0[r] -= d; p1[r] -= d; } }
#pragma unroll
  for (int r = 0; r < 16; ++r) p0[r] = __builtin_amdgcn_exp2f(p0[r]);
}
__device__ __forceinline__ void finishSM(f32x16& p0, f32x16& p1, float alpha, float& l_reg, bf16x8& pa0, bf16x8& pa1, bf16x8& pa2, bf16x8& pa3) {
#pragma unroll
  for (int r = 0; r < 16; ++r) p1[r] = __builtin_amdgcn_exp2f(p1[r]);
  f32x2v ps2 = {0.f, 0.f};
#pragma unroll
  for (int r = 0; r < 8; ++r) ps2 += (f32x2v){p0[2 * r], p0[2 * r + 1]};
#pragma unroll
  for (int r = 0; r < 8; ++r) ps2 += (f32x2v){p1[2 * r], p1[2 * r + 1]};
  float ps = ps2.x + ps2.y;
  { auto rr = __builtin_amdgcn_permlane32_swap(__float_as_uint(ps), __float_as_uint(ps), false, false);
    ps = __uint_as_float(rr[0]) + __uint_as_float(rr[1]); }
  l_reg = l_reg * alpha + ps;
#define AT_PK4(P, BASE, OUT) do { unsigned a0 = cvtpk(P[BASE + 0], P[BASE + 1]), a1 = cvtpk(P[BASE + 2], P[BASE + 3]);   \
    unsigned b0 = cvtpk(P[BASE + 4], P[BASE + 5]), b1 = cvtpk(P[BASE + 6], P[BASE + 7]);                              \
    auto r0 = __builtin_amdgcn_permlane32_swap(a0, b0, false, false); auto r1 = __builtin_amdgcn_permlane32_swap(a1, b1, false, false); \
    v4u w_ = {r0[0], r1[0], r0[1], r1[1]}; OUT = __builtin_bit_cast(bf16x8, w_); } while (0)
  AT_PK4(p0, 0, pa0); AT_PK4(p0, 8, pa1); AT_PK4(p1, 0, pa2); AT_PK4(p1, 8, pa3);
#undef AT_PK4
}
__device__ __forceinline__ void qkt(f32x16& p0, f32x16& p1, const char* Ks, const bf16x8* qr, int r32, int hi, const float init = 0.f) {
#pragma unroll
  for (int r = 0; r < 16; ++r) { p0[r] = init; p1[r] = init; }
#pragma unroll
  for (int d0 = 0; d0 < 4; ++d0) { const int ch = d0 * 2 + hi;
    bf16x8 b0 = *reinterpret_cast<const bf16x8*>(Ks + KSWZ64(r32, ch));
    bf16x8 b1 = *reinterpret_cast<const bf16x8*>(Ks + 4096 + KSWZ64(r32, ch));
    p0 = __builtin_amdgcn_mfma_f32_32x32x16_bf16(b0, qr[d0], p0, 0, 0, 0);
    p1 = __builtin_amdgcn_mfma_f32_32x32x16_bf16(b1, qr[d0], p1, 0, 0, 0); }
}
__device__ __forceinline__ int v_st(int k, int c) { const int kk = (k & ~0xC) | ((k & 4) << 1) | ((k & 8) >> 1); return ((kk >> 3) * 4 + (c >> 5)) * 512 + ((kk & 7) * 32 + (c & 31)) * 2; }
__device__ __forceinline__ int v_rd_base(int lane) { return ((lane & 3) << 3) | (((lane >> 2) & 3) << 6) | (((lane >> 4) & 1) << 5) | (((lane >> 5) & 1) << 8); }
constexpr int v_rd_off(int d0, int ks, int half) { return d0 * 512 + ks * 4096 + half * 2048; }
template <int OFF> __device__ __forceinline__ s16x4 tr_read(int vb) {
  s16x4 r; asm volatile("ds_read_b64_tr_b16 %0, %1 offset:%2" : "=&v"(r) : "v"(vb), "i"(OFF) : "memory"); return r;
}
template <int D0> __device__ __forceinline__ void pv_one(f32x16& od, int vb, bf16x8 pa0, bf16x8 pa1, bf16x8 pa2, bf16x8 pa3) {
  const s16x4 l0 = tr_read<v_rd_off(D0, 0, 0)>(vb), h0 = tr_read<v_rd_off(D0, 0, 1)>(vb), l1 = tr_read<v_rd_off(D0, 1, 0)>(vb), h1 = tr_read<v_rd_off(D0, 1, 1)>(vb);
  const s16x4 l2 = tr_read<v_rd_off(D0, 2, 0)>(vb), h2 = tr_read<v_rd_off(D0, 2, 1)>(vb), l3 = tr_read<v_rd_off(D0, 3, 0)>(vb), h3 = tr_read<v_rd_off(D0, 3, 1)>(vb);
  asm volatile("s_waitcnt lgkmcnt(0)" ::: "memory"); AT_SBAR();
#define AT_PK(L, H) (bf16x8){L[0], L[1], L[2], L[3], H[0], H[1], H[2], H[3]}
  od = __builtin_amdgcn_mfma_f32_32x32x16_bf16(pa0, AT_PK(l0, h0), od, 0, 0, 0);
  od = __builtin_amdgcn_mfma_f32_32x32x16_bf16(pa1, AT_PK(l1, h1), od, 0, 0, 0);
  od = __builtin_amdgcn_mfma_f32_32x32x16_bf16(pa2, AT_PK(l2, h2), od, 0, 0, 0);
  od = __builtin_amdgcn_mfma_f32_32x32x16_bf16(pa3, AT_PK(l3, h3), od, 0, 0, 0);
#undef AT_PK
}
__device__ __forceinline__ void pv_d0(f32x16* o, int vb, bf16x8 pa0, bf16x8 pa1, bf16x8 pa2, bf16x8 pa3) {
  pv_one<0>(o[0], vb, pa0, pa1, pa2, pa3); pv_one<1>(o[1], vb, pa0, pa1, pa2, pa3); pv_one<2>(o[2], vb, pa0, pa1, pa2, pa3); pv_one<3>(o[3], vb, pa0, pa1, pa2, pa3);
}
__device__ __forceinline__ void attn_pass(const bf16* __restrict__ Qw, const bf16* __restrict__ Kh, const bf16* __restrict__ Vh, int seq, char* lds, f32x16 (&o)[4], const int wave_id) {
  int tid_ = wave_id * 64 + (int)__builtin_amdgcn_mbcnt_hi(~0u, __builtin_amdgcn_mbcnt_lo(~0u, 0u)); asm volatile("" : "+v"(tid_));
  const int tid = tid_, wid = tid >> 6, lane = tid & 63, r32 = lane & 31, hi = lane >> 5;
  char* V_lds = lds + O_V; char* K_lds = lds + O_K;
  float* ws = (float*)(lds + O_WS) + wid * 64; float* li_l = ws; float* al_l = ws + 32;
  float m_reg = -1e30f, l_reg = 0; bf16x8 qr[4];
#pragma unroll
  for (int d = 0; d < 4; ++d) o[d] = f32x16{};
  const bf16* Ql = Qw + (long)r32 * LDK + hi * 8;
#pragma unroll
  for (int d0 = 0; d0 < 4; ++d0) qr[d0] = *reinterpret_cast<const bf16x8*>(Ql + d0 * 16);
  const int sr = tid >> 4, sc = (tid & 15) * 8, vst0 = v_st(sr, sc), vst1 = v_st(32 + sr, sc);
  const int kr = tid >> 3, kc = tid & 7, kst = KSWZ64(kr, kc);
  const int vb0 = (int)(uintptr_t)V_lds + v_rd_base(lane);
  struct { bf16x8 vs0, vs1, ks0; } sr_[2];
#define AT_SLOAD(i, k0) do { sr_[i].vs0 = *reinterpret_cast<const bf16x8*>(&Vh[(long)((k0) + sr) * LDK + sc]); sr_[i].vs1 = *reinterpret_cast<const bf16x8*>(&Vh[(long)((k0) + 32 + sr) * LDK + sc]); \
    sr_[i].ks0 = *reinterpret_cast<const bf16x8*>(&Kh[(long)((k0) + kr) * LDK + kc * 8]); } while (0)
#define AT_SWRITE(b, i) do { *(bf16x8*)(V_lds + (b) * SHM_V + vst0) = sr_[i].vs0; *(bf16x8*)(V_lds + (b) * SHM_V + vst1) = sr_[i].vs1; \
    *(bf16x8*)(K_lds + (b) * SHM_K + kst) = sr_[i].ks0; } while (0)
#define AT_SWAIT() asm volatile("s_waitcnt vmcnt(3)" ::: "memory")
#define AT_RESC(a) do { if (__any((a) < 1.f)) { if (hi == 0) al_l[r32] = (a); asm volatile("s_waitcnt lgkmcnt(0)" ::: "memory"); \
    _Pragma("unroll") for (int d = 0; d < 4; ++d) _Pragma("unroll") for (int r = 0; r < 16; ++r) o[d][r] *= al_l[crow(r, hi)]; } } while (0)
  f32x16 pA0, pA1, pB0, pB1; float mnA, mnB, alA, alB; bf16x8 pa0, pa1, pa2, pa3; const int NT = seq / 64;
  constexpr int SE = 0, SO = 1;
  AT_SLOAD(SE, 0); asm volatile("s_waitcnt vmcnt(0)" ::: "memory"); AT_SWRITE(0, SE); __syncthreads();
  qkt(pA0, pA1, K_lds, qr, r32, hi); partialSM(pA0, pA1, m_reg, mnA, alA);
  AT_SLOAD(SO, 64); if (2 < NT) AT_SLOAD(SE, 128);
  AT_SWAIT(); AT_SWRITE(1, SO); __syncthreads();
#ifdef AT_PRIO
  if (__builtin_amdgcn_readfirstlane(tid) >= 256) __builtin_amdgcn_s_setprio(1);
#endif
  for (int j = 1; j + 1 < NT; j += 2) {
    AT_SBAR(); qkt(pB0, pB1, K_lds + SHM_K, qr, r32, hi, -m_reg);
    finishSM(pA0, pA1, alA, l_reg, pa0, pa1, pa2, pa3); AT_SBAR();
    AT_SLOAD(SO, (j + 2) * 64); AT_SBAR();
    pv_d0(o, vb0, pa0, pa1, pa2, pa3); partialSM_rel(pB0, pB1, m_reg, alB);
    __syncthreads(); AT_SWAIT(); AT_SWRITE(0, SE);
    AT_RESC(alB); __syncthreads();
    AT_SBAR(); qkt(pA0, pA1, K_lds, qr, r32, hi, -m_reg);
    finishSM(pB0, pB1, alB, l_reg, pa0, pa1, pa2, pa3); AT_SBAR();
    { const int kn_ = __builtin_amdgcn_readfirstlane((j + 3 < NT ? j + 3 : NT - 1) * 64); AT_SLOAD(SE, kn_); } AT_SBAR();
    pv_d0(o, vb0 + SHM_V, pa0, pa1, pa2, pa3); partialSM_rel(pA0, pA1, m_reg, alA);
    __syncthreads(); AT_SWAIT(); AT_SWRITE(1, SO);
    AT_RESC(alA); __syncthreads();
  }
  AT_SBAR(); qkt(pB0, pB1, K_lds + SHM_K, qr, r32, hi, -m_reg);
  finishSM(pA0, pA1, alA, l_reg, pa0, pa1, pa2, pa3); AT_SBAR();
  pv_d0(o, vb0, pa0, pa1, pa2, pa3); partialSM_rel(pB0, pB1, m_reg, alB);
  __syncthreads(); AT_RESC(alB);
  finishSM(pB0, pB1, alB, l_reg, pa0, pa1, pa2, pa3); AT_SBAR();
  pv_d0(o, vb0 + SHM_V, pa0, pa1, pa2, pa3);
#ifdef AT_PRIO
  __builtin_amdgcn_s_setprio(0);
#endif
  if (hi == 0) li_l[r32] = l_reg; asm volatile("s_waitcnt lgkmcnt(0)" ::: "memory");
#pragma unroll
  for (int r = 0; r < 16; ++r) { const float rl = __builtin_amdgcn_rcpf(li_l[crow(r, hi)]);
#pragma unroll
    for (int d = 0; d < 4; ++d) o[d][r] *= rl; }
  __syncthreads();
#undef AT_SLOAD
#undef AT_SWRITE
#undef AT_SWAIT
#undef AT_RESC
}
}

__device__ __forceinline__ void attn_unit(Frame& F, int unit, float lam, const float* subln_g) {
    const int b = unit >> 6, h = (unit >> 3) & 7, qb = unit & 7;
    const int wid = F.wave;
    const size_t rowbase = (size_t)b * SEQ;
    const bf16* Qb = (const bf16*)(F.ws + WS_DAQ) + (rowbase + qb * 256 + wid * 32) * 1024 + h * 128;
    const bf16* Kb = (const bf16*)(F.ws + WS_DAK) + rowbase * 1024 + h * 128;
    const bf16* Vb = (const bf16*)(F.ws + WS_DAV) + rowbase * 1024 + h * 128;
    char* lds = (char*)F.ldsg + RING_OFF;
    f32x16 o[4];
    at::attn_pass(Qb, Kb, Vb, SEQ, lds, o, F.wave);
    { int t1_ = F.wave * 64 + (int)__builtin_amdgcn_mbcnt_hi(~0u, __builtin_amdgcn_mbcnt_lo(~0u, 0u)); asm volatile("" : "+v"(t1_));
      GAS f32x4* st1 = (GAS f32x4*)(F.ws + WS_STASH) + (size_t)blockIdx.x * 16 * 512 + t1_;
#pragma unroll
      for (int d = 0; d < 4; ++d)
#pragma unroll
          for (int g = 0; g < 4; ++g) st1[(d * 4 + g) * 512] = (f32x4){o[d][4 * g], o[d][4 * g + 1], o[d][4 * g + 2], o[d][4 * g + 3]}; }
    at::attn_pass(Qb + 64, Kb + 64, Vb, SEQ, lds, o, F.wave);
    int tid_ = F.wave * 64 + (int)__builtin_amdgcn_mbcnt_hi(~0u, __builtin_amdgcn_mbcnt_lo(~0u, 0u)); asm volatile("" : "+v"(tid_));
    const int tid = tid_, lane = tid & 63, r32 = lane & 31, hi = lane >> 5;
    GAS f32x4* stash = (GAS f32x4*)(F.ws + WS_STASH) + (size_t)blockIdx.x * 16 * 512 + tid;
    float gsc[4];
#pragma unroll
    for (int d = 0; d < 4; ++d) gsc[d] = subln_g[d * 32 + r32] * (1.0f - LAMBDA_INIT);
    bf16* Ob = (bf16*)(F.ws + WS_OA) + (rowbase + qb * 256 + wid * 32) * 1024 + h * 128;
    LAS unsigned char* stg = F.lds + RING_OFF + 51200 + wid * 8704;
#pragma unroll
    for (int g = 0; g < 4; ++g) {
        f32x4 s0[4];
#pragma unroll
        for (int d = 0; d < 4; ++d) s0[d] = stash[(d * 4 + g) * 512];
#pragma unroll
        for (int q = 0; q < 4; ++q) { const int r = 4 * g + q;
            float v[4], ss = 0.f;
#pragma unroll
            for (int d = 0; d < 4; ++d) { v[d] = s0[d][q] - lam * o[d][r]; ss += v[d] * v[d]; }
#pragma unroll
            for (int x = 1; x < 32; x <<= 1) ss += __shfl_xor(ss, x);
            const float rstd = __builtin_amdgcn_rsqf(ss * (1.0f / 128.0f) + EPS);
            const int orow = at::crow(r, hi);
#pragma unroll
            for (int d = 0; d < 4; ++d) *(LAS unsigned short*)(stg + orow * 272 + (d * 32 + r32) * 2) = (unsigned short)(cvtpk(v[d] * rstd * gsc[d], 0.f) & 0xffffu);
        }
    }
    asm volatile("s_waitcnt lgkmcnt(0)" ::: "memory");
#pragma unroll
    for (int i = 0; i < 8; ++i) { const int row = i * 4 + (lane >> 4), ch = lane & 15;
        const v4u w = *(const LAS v4u*)(stg + row * 272 + ch * 16);
        *(v4u*)(Ob + (size_t)row * 1024 + ch * 8) = w; }
}


__device__ __forceinline__ void hgrn_combine(Frame& F, const float* norm_g) {
    const int gw = F.vcu * NWAVES + F.wave, NGW = F.G * NWAVES, lane = F.lane;
    const bf16* OFp = (const bf16*)(F.ws + WS_OF); const bf16* OBp = (const bf16*)(F.ws + WS_OBW);
    const bf16* GG = (const bf16*)(F.ws + WS_HGG); bf16* OB = (bf16*)(F.ws + WS_OB);
    f32x4 ng[4];
#pragma unroll
    for (int j = 0; j < 4; ++j) ng[j] = *(const f32x4*)(norm_g + (16 * lane + 4 * j) % 128);
    v4u fa[2], ba[2], ga[2], fb[2], bb[2], gb[2];
#if I8_AB
    v4u oa_a[2], oa_b[2];
    const bf16* OAp = (const bf16*)(F.ws + WS_OA);
#define HC_LOADA(AV, m_) do { const size_t off_ = (size_t)(m_) * 1024 + 16 * lane; AV[0] = *(const v4u*)(OAp + off_); AV[1] = *(const v4u*)(OAp + off_ + 8); } while (0)
#define HC_Q16(VAL, DST, SC, m_) do { float am_ = 0.f; _Pragma("unroll") for (int j = 0; j < 16; ++j) am_ = fmaxf(am_, __builtin_fabsf(VAL[j])); \
        _Pragma("unroll") for (int o = 1; o < 64; o <<= 1) am_ = fmaxf(am_, __shfl_xor(am_, o)); const float inv_ = am_ > 0.f ? 127.0f / am_ : 0.f; unsigned w_[4]; \
        _Pragma("unroll") for (int q = 0; q < 4; ++q) { const int a0 = __float2int_rn(VAL[4 * q] * inv_), a1 = __float2int_rn(VAL[4 * q + 1] * inv_), a2 = __float2int_rn(VAL[4 * q + 2] * inv_), a3 = __float2int_rn(VAL[4 * q + 3] * inv_); \
            w_[q] = (unsigned)(a0 & 255) | ((unsigned)(a1 & 255) << 8) | ((unsigned)(a2 & 255) << 16) | ((unsigned)a3 << 24); } \
        *(v4u*)((DST) + (size_t)(m_) * 1024 + 16 * lane) = (v4u){w_[0], w_[1], w_[2], w_[3]}; if (lane == 0) (SC)[m_] = am_ * (1.0f / 127.0f); } while (0)
#else
#define HC_LOADA(AV, m_) do { } while (0)
#endif
#define HC_LOAD(FV, BV, GV, m_) do { const size_t off_ = (size_t)(m_) * 1024 + 16 * lane; \
        FV[0] = *(const v4u*)(OFp + off_); FV[1] = *(const v4u*)(OFp + off_ + 8); BV[0] = *(const v4u*)(OBp + off_); BV[1] = *(const v4u*)(OBp + off_ + 8); \
        GV[0] = *(const v4u*)(GG + off_); GV[1] = *(const v4u*)(GG + off_ + 8); } while (0)
#define HC_PROC(FV, BV, GV, AV, m_) do { const size_t off_ = (size_t)(m_) * 1024 + 16 * lane; float v_[16]; float ss_ = 0.f; \
        const unsigned ff_[8] = {FV[0].x, FV[0].y, FV[0].z, FV[0].w, FV[1].x, FV[1].y, FV[1].z, FV[1].w}, bq_[8] = {BV[0].x, BV[0].y, BV[0].z, BV[0].w, BV[1].x, BV[1].y, BV[1].z, BV[1].w}; \
        _Pragma("unroll") for (int j = 0; j < 8; ++j) { v_[2 * j] = bf_lo(ff_[j]) + bf_lo(bq_[j]); v_[2 * j + 1] = bf_hi(ff_[j]) + bf_hi(bq_[j]); ss_ += v_[2 * j] * v_[2 * j] + v_[2 * j + 1] * v_[2 * j + 1]; } \
        ss_ += __shfl_xor(ss_, 1); ss_ += __shfl_xor(ss_, 2); ss_ += __shfl_xor(ss_, 4); \
        const float rstd_ = __builtin_amdgcn_rsqf(ss_ * (1.0f / 128.0f) + EPS); \
        const unsigned gg_[8] = {GV[0].x, GV[0].y, GV[0].z, GV[0].w, GV[1].x, GV[1].y, GV[1].z, GV[1].w}; \
        _Pragma("unroll") for (int j = 0; j < 8; ++j) { v_[2 * j] = v_[2 * j] * rstd_ * ng[j >> 1][(2 * j) & 3] * bf_lo(gg_[j]); v_[2 * j + 1] = v_[2 * j + 1] * rstd_ * ng[j >> 1][(2 * j + 1) & 3] * bf_hi(gg_[j]); } \
        HC_STORE(v_, AV, m_, off_); } while (0)
#if I8_AB
#define HC_STORE(V, AV, m_, off_) do { HC_Q16(V, (unsigned char*)(F.ws + WS_OB), (float*)(F.ws + WS_SAB), m_); \
        const unsigned aa_[8] = {AV[0].x, AV[0].y, AV[0].z, AV[0].w, AV[1].x, AV[1].y, AV[1].z, AV[1].w}; float a_[16]; \
        _Pragma("unroll") for (int j = 0; j < 8; ++j) { a_[2 * j] = bf_lo(aa_[j]); a_[2 * j + 1] = bf_hi(aa_[j]); } \
        HC_Q16(a_, (unsigned char*)(F.ws + WS_OA8), (float*)(F.ws + WS_SAO), m_); } while (0)
#else
#define HC_STORE(V, AV, m_, off_) do { unsigned o_[8]; _Pragma("unroll") for (int j = 0; j < 8; ++j) o_[j] = cvtpk(V[2 * j], V[2 * j + 1]); \
        *(v4u*)(OB + off_) = (v4u){o_[0], o_[1], o_[2], o_[3]}; *(v4u*)(OB + off_ + 8) = (v4u){o_[4], o_[5], o_[6], o_[7]}; } while (0)
    v4u oa_a[2], oa_b[2];
#endif
    int m = gw;
    if (m < T) { HC_LOAD(fa, ba, ga, m); HC_LOADA(oa_a, m); }
    for (; m < T; m += 2 * NGW) {
        if (m + NGW < T) { HC_LOAD(fb, bb, gb, m + NGW); HC_LOADA(oa_b, m + NGW); }
        HC_PROC(fa, ba, ga, oa_a, m);
        if (m + NGW < T) { if (m + 2 * NGW < T) { HC_LOAD(fa, ba, ga, m + 2 * NGW); HC_LOADA(oa_a, m + 2 * NGW); } HC_PROC(fb, bb, gb, oa_b, m + NGW); }
    }
#undef HC_LOAD
#undef HC_LOADA
#undef HC_PROC
#undef HC_STORE
#if I8_AB
#undef HC_Q16
#endif
}
__device__ __forceinline__ void cvt_table(Frame& F, const float* src, bf16* dst, size_t n) {
    const size_t n8 = n / 8, stride = (size_t)F.G * 512;
    for (size_t i = (size_t)F.vcu * 512 + F.tid; i < n8; i += stride) {
        const f32x4 a = *(const f32x4*)(src + i * 8), b = *(const f32x4*)(src + i * 8 + 4);
        *(v4u*)(dst + i * 8) = (v4u){cvtpk(a.x, a.y), cvtpk(a.z, a.w), cvtpk(b.x, b.y), cvtpk(b.z, b.w)};
    }
}

namespace pr {
typedef short bf16x8 __attribute__((ext_vector_type(8)));
constexpr int LK = 272;
#define PR_CE(a, b) do { const unsigned hi_ = (a) > (b) ? (a) : (b); const unsigned lo_ = (a) > (b) ? (b) : (a); (a) = hi_; (b) = lo_; } while (0)
__device__ __forceinline__ void sort16(unsigned (&v)[16]) {
#pragma unroll
    for (int k = 2; k <= 16; k <<= 1)
#pragma unroll
        for (int j = k >> 1; j > 0; j >>= 1)
#pragma unroll
            for (int i = 0; i < 16; ++i) { const int l = i ^ j; if (l > i) { if ((i & k) == 0) PR_CE(v[i], v[l]); else PR_CE(v[l], v[i]); } }
}
__device__ __forceinline__ void merge16(unsigned (&a)[16], const unsigned (&b)[16]) {
#pragma unroll
    for (int i = 0; i < 16; ++i) a[i] = a[i] > b[15 - i] ? a[i] : b[15 - i];
#pragma unroll
    for (int j = 8; j > 0; j >>= 1)
#pragma unroll
        for (int i = 0; i < 16; ++i) { const int l = i ^ j; if (l > i) PR_CE(a[i], a[l]); }
}
__device__ __forceinline__ unsigned ord(float f) { const unsigned u = __float_as_uint(f); return u ^ ((unsigned)((int)u >> 31) | 0x80000000u); }
__device__ __forceinline__ float unord(unsigned u) { return __uint_as_float((u & 0x80000000u) ? (u ^ 0x80000000u) : ~u); }
}
__device__ __forceinline__ void peer_route_unit(Frame& F, int unit, const float* keys1, const float* keys2) {
    using namespace pr;
    const int hp = unit >> 6, tt = unit & 63;
    LAS unsigned char* L = F.lds + RING_OFF;
    const int tid = F.tid, lane = F.lane, w = F.wave, r32 = lane & 31, hi = lane >> 5;
    for (int i = tid; i < 2 * 128 * 16; i += 512) { const int half = i >> 11, rem = i & 2047, kr = rem >> 4, kc = rem & 15;
        const float* src = (half ? keys2 : keys1) + ((size_t)hp * 128 + kr) * 128 + kc * 8;
        const f32x4 a = *(const f32x4*)src, b = *(const f32x4*)(src + 4);
        *(LAS v4u*)(L + half * (128 * LK) + kr * LK + kc * 16) = (v4u){cvtpk(a.x, a.y), cvtpk(a.z, a.w), cvtpk(b.x, b.y), cvtpk(b.z, b.w)}; }
    __syncthreads();
    const int tok = tt * 256 + w * 32 + r32;
    const bf16* qrow = (const bf16*)(F.ws + WS_QP) + (size_t)tok * DM + hp * 256 + hi * 8;
    unsigned top[2][16];
#pragma unroll
    for (int half = 0; half < 2; ++half) {
        bf16x8 qf[8];
#pragma unroll
        for (int ks = 0; ks < 8; ++ks) qf[ks] = *(const bf16x8*)(qrow + half * 128 + ks * 16);
        unsigned res[16];
#pragma unroll
        for (int kb = 0; kb < 4; ++kb) {
            f32x16 acc = f32x16{};
#pragma unroll
            for (int ks = 0; ks < 8; ++ks) acc = __builtin_amdgcn_mfma_f32_32x32x16_bf16(*(const LAS bf16x8*)(L + half * (128 * LK) + (32 * kb + r32) * LK + ks * 32 + hi * 16), qf[ks], acc, 0, 0, 0);
            unsigned kv[16];
#pragma unroll
            for (int r = 0; r < 16; ++r) { const int idx = 32 * kb + (r & 3) + 8 * (r >> 2) + 4 * hi; kv[r] = (ord(acc[r]) & 0xFFFFFF80u) | (unsigned)(127 - idx); }
            sort16(kv);
            if (kb == 0) {
#pragma unroll
                for (int r = 0; r < 16; ++r) res[r] = kv[r];
            } else merge16(res, kv);
        }
        unsigned oth[16];
#pragma unroll
        for (int r = 0; r < 16; ++r) { auto rr = __builtin_amdgcn_permlane32_swap(res[r], res[r], false, false); oth[r] = hi ? rr[0] : rr[1]; }
        merge16(res, oth);
#pragma unroll
        for (int r = 0; r < 16; ++r) top[half][r] = res[r];
    }
    float f1[16], f2[16]; unsigned ip1[4] = {0u, 0u, 0u, 0u}, ip2[4] = {0u, 0u, 0u, 0u};
#pragma unroll
    for (int r = 0; r < 16; ++r) { f1[r] = unord((top[0][r] & 0xFFFFFF80u) | 0x40u); f2[r] = unord((top[1][r] & 0xFFFFFF80u) | 0x40u);
        ip1[r >> 2] |= (127u - (top[0][r] & 127u)) << (8 * (r & 3)); ip2[r >> 2] |= (127u - (top[1][r] & 127u)) << (8 * (r & 3)); }
    unsigned cand[64];
    { int n = 0;
#pragma unroll
      for (int i = 0; i < 16; ++i)
#pragma unroll
          for (int j = 0; j < 16; ++j) if ((i + 1) * (j + 1) <= 16) { cand[n] = (ord(f1[i] + f2[j]) & 0xFFFFFF00u) | (unsigned)(255 - (i * 16 + j)); ++n; }
#pragma unroll
      for (int q = 50; q < 64; ++q) cand[q] = 0u; }
    unsigned res[16];
#pragma unroll
    for (int g = 0; g < 4; ++g) { unsigned kv[16];
#pragma unroll
        for (int r = 0; r < 16; ++r) kv[r] = cand[g * 16 + r];
        sort16(kv);
        if (g == 0) {
#pragma unroll
            for (int r = 0; r < 16; ++r) res[r] = kv[r];
        } else merge16(res, kv); }
    float sc[16]; int ex[16];
#pragma unroll
    for (int r = 0; r < 16; ++r) { sc[r] = unord((res[r] & 0xFFFFFF00u) | 0x80u); const unsigned ci = 255u - (res[r] & 255u), i = ci >> 4, j = ci & 15u;
        unsigned wi = ip1[0]; wi = (i >> 2) == 1 ? ip1[1] : wi; wi = (i >> 2) == 2 ? ip1[2] : wi; wi = (i >> 2) == 3 ? ip1[3] : wi;
        unsigned wj = ip2[0]; wj = (j >> 2) == 1 ? ip2[1] : wj; wj = (j >> 2) == 2 ? ip2[2] : wj; wj = (j >> 2) == 3 ? ip2[3] : wj;
        ex[r] = (int)(((wi >> (8 * (i & 3))) & 255u) * 128u + ((wj >> (8 * (j & 3))) & 255u)); }
    const float mx = sc[0];
    float ev[16], sum = 0.f;
#pragma unroll
    for (int r = 0; r < 16; ++r) { ev[r] = __expf(sc[r] - mx); sum += ev[r]; }
    const float inv = 1.0f / sum;
    int eo[8]; float go[8];
#pragma unroll
    for (int q = 0; q < 8; ++q) { eo[q] = hi ? ex[8 + q] : ex[q]; go[q] = (hi ? ev[8 + q] : ev[q]) * inv; }
    int* EI = (int*)(F.ws + WS_EIDX) + (size_t)tok * 128 + hp * 16 + 8 * hi;
    float* EGp = (float*)(F.ws + WS_EG) + (size_t)tok * 128 + hp * 16 + 8 * hi;
    typedef int i32x4 __attribute__((ext_vector_type(4)));
    *(i32x4*)EI = (i32x4){eo[0], eo[1], eo[2], eo[3]}; *(i32x4*)(EI + 4) = (i32x4){eo[4], eo[5], eo[6], eo[7]};
    *(f32x4*)EGp = (f32x4){go[0], go[1], go[2], go[3]}; *(f32x4*)(EGp + 4) = (f32x4){go[4], go[5], go[6], go[7]};
    __syncthreads();
}

typedef float f32x32 __attribute__((ext_vector_type(32)));
typedef int i32x6 __attribute__((ext_vector_type(6)));
typedef __bf16 bf16x32 __attribute__((ext_vector_type(32)));
typedef unsigned v2u __attribute__((ext_vector_type(2)));
constexpr int ROWB = 1536;
__device__ __forceinline__ void cvt_table_fp6(Frame& F, const float* src, unsigned char* dst, float* scale) {
    const int gw = F.vcu * NWAVES + F.wave, NGW = F.G * NWAVES, lane = F.lane;
    f32x4 va[8], vb[8];
#define CT_LOAD(V, r_) do { const float* rp_ = src + (size_t)(r_) * DM; _Pragma("unroll") for (int q = 0; q < 8; ++q) V[q] = *(const f32x4*)(rp_ + q * 256 + 4 * lane); } while (0)
#define CT_PROC(V, r_) do { float am_ = 0.f; \
        _Pragma("unroll") for (int q = 0; q < 8; ++q) am_ = fmaxf(am_, fmaxf(fmaxf(__builtin_fabsf(V[q].x), __builtin_fabsf(V[q].y)), fmaxf(__builtin_fabsf(V[q].z), __builtin_fabsf(V[q].w)))); \
        _Pragma("unroll") for (int o = 1; o < 64; o <<= 1) am_ = fmaxf(am_, __shfl_xor(am_, o)); \
        const float sc_ = am_ > 0.f ? am_ * (1.0f / 7.5f) : 1.0f, inv_ = 1.0f / sc_; bf16x32 b_; \
        _Pragma("unroll") for (int q = 0; q < 8; ++q) { b_[4 * q] = (__bf16)(V[q].x * inv_); b_[4 * q + 1] = (__bf16)(V[q].y * inv_); b_[4 * q + 2] = (__bf16)(V[q].z * inv_); b_[4 * q + 3] = (__bf16)(V[q].w * inv_); } \
        const i32x6 w_ = __builtin_amdgcn_cvt_scalef32_pk32_fp6_bf16(b_, 1.0f); unsigned char* op_ = dst + (size_t)(r_) * ROWB; \
        *(v4u*)(op_ + lane * 16) = (v4u){(unsigned)w_[0], (unsigned)w_[1], (unsigned)w_[2], (unsigned)w_[3]}; \
        *(v2u*)(op_ + 1024 + lane * 8) = (v2u){(unsigned)w_[4], (unsigned)w_[5]}; \
        if (lane == 0) scale[r_] = sc_; } while (0)
    int row = gw;
    if (row < 16384) CT_LOAD(va, row);
    for (; row < 16384; row += 2 * NGW) {
        if (row + NGW < 16384) CT_LOAD(vb, row + NGW);
        CT_PROC(va, row);
        if (row + NGW < 16384) { if (row + 2 * NGW < 16384) CT_LOAD(va, row + 2 * NGW); CT_PROC(vb, row + NGW); }
    }
#undef CT_LOAD
#undef CT_PROC
}
template <bool F4> __device__ __forceinline__ f32x32 dec_row(const v4u a, const v2u b) {
    if constexpr (F4) { f32x32 d; const unsigned ww[4] = {a.x, a.y, a.z, a.w};
#pragma unroll
        for (int q = 0; q < 4; ++q) { const f32x2v d0 = __builtin_amdgcn_cvt_scalef32_pk_f32_fp4(ww[q], 1.0f, 0), d1 = __builtin_amdgcn_cvt_scalef32_pk_f32_fp4(ww[q], 1.0f, 1), d2 = __builtin_amdgcn_cvt_scalef32_pk_f32_fp4(ww[q], 1.0f, 2), d3 = __builtin_amdgcn_cvt_scalef32_pk_f32_fp4(ww[q], 1.0f, 3);
            d[8 * q] = d0.x; d[8 * q + 1] = d0.y; d[8 * q + 2] = d1.x; d[8 * q + 3] = d1.y; d[8 * q + 4] = d2.x; d[8 * q + 5] = d2.y; d[8 * q + 6] = d3.x; d[8 * q + 7] = d3.y; }
        return d; }
    else { const i32x6 w = {(int)a.x, (int)a.y, (int)a.z, (int)a.w, (int)b.x, (int)b.y}; return __builtin_amdgcn_cvt_scalef32_pk32_f32_fp6(w, 1.0f); }
}
__device__ __forceinline__ f32x32 dec_fp6(const v4u a, const v2u b) { const i32x6 w = {(int)a.x, (int)a.y, (int)a.z, (int)a.w, (int)b.x, (int)b.y}; return __builtin_amdgcn_cvt_scalef32_pk32_f32_fp6(w, 1.0f); }
__device__ __forceinline__ float dot32_fp6(const v4u a, const v2u b, const f32x2v* h2) {
    const f32x32 d = dec_row<PEER_U4 != 0>(a, b); f32x2v p0 = {0.f, 0.f}, p1 = {0.f, 0.f};
#pragma unroll
    for (int q = 0; q < 16; q += 2) { p0 = __builtin_elementwise_fma((f32x2v){d[2 * q], d[2 * q + 1]}, h2[q], p0); p1 = __builtin_elementwise_fma((f32x2v){d[2 * q + 2], d[2 * q + 3]}, h2[q + 1], p1); }
    const f32x2v p = p0 + p1; return p.x + p.y;
}
__device__ __forceinline__ void axpy32_fp6(const v4u a, const v2u b, float c, f32x2v* acc2) {
    const f32x32 d = dec_row<PEER_V4 != 0>(a, b); const f32x2v cc = {c, c};
#pragma unroll
    for (int q = 0; q < 16; ++q) acc2[q] = __builtin_elementwise_fma(cc, (f32x2v){d[2 * q], d[2 * q + 1]}, acc2[q]);
}
#if PEER_UI4
template <int MODE, bool TO_LDS> __device__ __forceinline__ void peer_dots_pass(Frame& F, const int j0, const int ntok, const int gw, const int NGW, LAS unsigned char* dig, LAS unsigned* list, LAS float* apl) {
    int lane_ = F.lane; asm volatile("" : "+v"(lane_)); const int lane = lane_;
    const unsigned char* H2 = F.ws + WS_H2; const unsigned char* U8 = F.ws + WS_U8;
    const int* EI = (const int*)(F.ws + WS_EIDX); float* AP = (float*)(F.ws + WS_AP);
    typedef int i32x4v __attribute__((ext_vector_type(4)));
    {
        int evr[4][2];
#pragma unroll
        for (int tl = 0; tl < 4; ++tl) { evr[tl][0] = -1; evr[tl][1] = -1;
            if (tl < ntok) { const int t = gw + NGW * (j0 + tl);
            evr[tl][0] = EI[(size_t)t * 128 + lane]; evr[tl][1] = EI[(size_t)t * 128 + 64 + lane];
            unsigned hn[8], ln[8];
#pragma unroll
            for (int q = 0; q < 8; ++q) { const unsigned a = *(const unsigned*)(H2 + (size_t)t * DM + q * 256 + 4 * lane);
                ln[q] = a & 0x0F0F0F0Fu; hn[q] = ((((a ^ 0x80808080u) + 0x08080808u) >> 4) & 0x0F0F0F0Fu) ^ 0x08080808u; }
            *(LAS v4u*)(dig + tl * 2048 + lane * 16) = (v4u){hn[0] | (hn[1] << 4), hn[2] | (hn[3] << 4), hn[4] | (hn[5] << 4), hn[6] | (hn[7] << 4)};
            *(LAS v4u*)(dig + tl * 2048 + 1024 + lane * 16) = (v4u){ln[0] | (ln[1] << 4), ln[2] | (ln[3] << 4), ln[4] | (ln[5] << 4), ln[6] | (ln[7] << 4)}; } }
#pragma unroll 1
        for (int s = 0; s < 8; ++s) {
            int n = 0;
#pragma unroll
            for (int tl = 0; tl < 4; ++tl)
#pragma unroll
                for (int h = 0; h < 2; ++h) { const int ev = evr[tl][h]; const bool c = (ev >> 11) == s; const unsigned long long m = __ballot(c);
                    const int pos = n + (int)__builtin_amdgcn_mbcnt_hi((unsigned)(m >> 32), __builtin_amdgcn_mbcnt_lo((unsigned)m, 0u));
                    if (c) list[pos] = (unsigned)ev | ((unsigned)tl << 14) | ((unsigned)(h * 64 + lane) << 16);
                    n += __builtin_popcountll(m); }
            if (lane < 16) list[n + lane] = ((unsigned)s << 11) | 0x80000000u;
            __builtin_amdgcn_fence(__ATOMIC_RELEASE, "wavefront"); __builtin_amdgcn_wave_barrier();
            const int G16 = (n + 15) >> 4;
            v4u bufA[4][4], bufB[4][4]; unsigned entA[4], entB[4];
            const int grp = lane >> 4, li = lane & 15;
#define PS_LOAD(BUF, ENT, g_) do { _Pragma("unroll") for (int j_ = 0; j_ < 4; ++j_) { ENT[j_] = list[16 * (g_) + 4 * j_ + grp]; \
                const unsigned char* rp_ = U8 + (size_t)(ENT[j_] & (MODE == 1 ? 63u : 0x3FFFu)) * 1024 + li * 16; \
                if (!(ENT[j_] >> 31)) { _Pragma("unroll") for (int k_ = 0; k_ < 4; ++k_) BUF[j_][k_] = *(const v4u*)(rp_ + 256 * k_); } } } while (0)
#define PS_DPP(x_, ctrl_) __builtin_bit_cast(float, __builtin_amdgcn_update_dpp(0, __builtin_bit_cast(int, (x_)), (ctrl_), 0xF, 0xF, true))
#define PS_PROC(BUF, ENT, g_) do { float part[4]; \
                _Pragma("unroll") for (int j_ = 0; j_ < 4; ++j_) { const LAS unsigned char* dp_ = dig + ((ENT[j_] >> 14) & 3u) * 2048 + li * 16; int ah = 0, al = 0; \
                    _Pragma("unroll") for (int k_ = 0; k_ < 4; ++k_) { const i32x4v dh = *(const LAS i32x4v*)(dp_ + 256 * k_), dl = *(const LAS i32x4v*)(dp_ + 1024 + 256 * k_); \
                        ah = __builtin_amdgcn_sdot8((int)BUF[j_][k_].x, dh.x, ah, false); al = __builtin_amdgcn_sdot8((int)BUF[j_][k_].x, dl.x, al, false); \
                        ah = __builtin_amdgcn_sdot8((int)BUF[j_][k_].y, dh.y, ah, false); al = __builtin_amdgcn_sdot8((int)BUF[j_][k_].y, dl.y, al, false); \
                        ah = __builtin_amdgcn_sdot8((int)BUF[j_][k_].z, dh.z, ah, false); al = __builtin_amdgcn_sdot8((int)BUF[j_][k_].z, dl.z, al, false); \
                        ah = __builtin_amdgcn_sdot8((int)BUF[j_][k_].w, dh.w, ah, false); al = __builtin_amdgcn_sdot8((int)BUF[j_][k_].w, dl.w, al, false); } \
                    part[j_] = (float)(ah * 16 + al); } \
                { const bool up_ = (lane & 1) != 0; \
                  const float s0 = up_ ? part[0] : part[2], k0 = up_ ? part[2] : part[0], s1 = up_ ? part[1] : part[3], k1 = up_ ? part[3] : part[1]; \
                  part[0] = k0 + PS_DPP(s0, 0xB1); part[1] = k1 + PS_DPP(s1, 0xB1); } \
                { const bool up_ = (lane & 2) != 0; const float s0 = up_ ? part[0] : part[1], k0 = up_ ? part[1] : part[0]; part[0] = k0 + PS_DPP(s0, 0x4E); } \
                float tot = part[0]; tot = (tot + PS_DPP(tot, 0x124)) + (PS_DPP(tot, 0x128) + PS_DPP(tot, 0x12C));              \
                if ((lane & 12) == 0) { const unsigned en_ = list[16 * (g_) + 4 * (2 * (lane & 1) + ((lane >> 1) & 1)) + grp]; \
                    if (!(en_ >> 31)) { if (TO_LDS) apl[((en_ >> 14) & 3u) * 128u + ((en_ >> 16) & 127u)] = tot; \
                        else { const int t_ = gw + NGW * (j0 + (int)((en_ >> 14) & 3u)); AP[(size_t)t_ * 128 + ((en_ >> 16) & 127u)] = tot; } } } } while (0)
            if (G16 > 0) PS_LOAD(bufA, entA, 0);
#pragma unroll 1
            for (int g = 0; g < G16; g += 2) {
                if (g + 1 < G16) PS_LOAD(bufB, entB, g + 1);
                PS_PROC(bufA, entA, g);
                if (g + 1 < G16) { if (g + 2 < G16) PS_LOAD(bufA, entA, g + 2); PS_PROC(bufB, entB, g + 1); }
            }
#undef PS_LOAD
#undef PS_PROC
#undef PS_DPP
            __builtin_amdgcn_fence(__ATOMIC_RELEASE, "wavefront"); __builtin_amdgcn_wave_barrier();
        }
    }
}
template <int MODE> __device__ __forceinline__ void peer_dots_sweep(Frame& F) {
    const int gw = F.vcu * NWAVES + F.wave, NGW = F.G * NWAVES;
    LAS unsigned char* dig = F.lds + RING_OFF + F.wave * 8192;
    LAS unsigned* list = (LAS unsigned*)(F.lds + RING_OFF + 65536 + F.wave * 2176);
#pragma unroll 1
    for (int half = 0; half < 2; ++half) peer_dots_pass<MODE, false>(F, 4 * half, 4, gw, NGW, dig, list, nullptr);
}
#endif
#ifndef PEER_VSWEEP
#define PEER_VSWEEP 0
#endif
#ifndef PEER_ROLES
#define PEER_ROLES 1
#endif
#ifndef PEER_VDEEP
#define PEER_VDEEP 0
#endif
#ifndef PEER_TSPLIT
#define PEER_TSPLIT 13
#endif
#ifndef PEER_VSORT
#define PEER_VSORT 1
#endif
#ifndef PEER_VBAR
#define PEER_VBAR 1
#endif
#if PEER_UI4 && PEER_VSWEEP
#ifndef VS_SHIFT
#define VS_SHIFT 11
#endif
template <int MODE> __device__ __forceinline__ void peer_vsweep_pass(Frame& F, const float* ada, const float* final_g_, const int pass) {
    const float* final_g = final_g_; asm volatile("" : "+s"(final_g));
    const int gw = F.vcu * NWAVES + F.wave, NGW = F.G * NWAVES;
    int lane_ = F.lane; asm volatile("" : "+v"(lane_)); const int lane = lane_;
    const unsigned char* V8 = F.ws + WS_V8;
    const float* SU = (const float*)(F.ws + WS_SCU); const float* SV = (const float*)(F.ws + WS_SCV);
    const int* EI = (const int*)(F.ws + WS_EIDX); const float* EGp = (const float*)(F.ws + WS_EG); const float* AP = (const float*)(F.ws + WS_AP);
    LAS unsigned* le = (LAS unsigned*)(F.lds + RING_OFF + F.wave * 8192);
    LAS float* lc = (LAS float*)(le + 384);
    int evr[2][2]; float cfr[2][2];
#pragma unroll
    for (int tl = 0; tl < 2; ++tl) { const int t = gw + NGW * (2 * pass + tl);
        const float sa2 = ((const float*)(F.ws + WS_SA2))[t];
        const int ev0 = EI[(size_t)t * 128 + lane], ev1 = EI[(size_t)t * 128 + 64 + lane];
        const float gv0 = EGp[(size_t)t * 128 + lane], gv1 = EGp[(size_t)t * 128 + 64 + lane];
        const float at0 = AP[(size_t)t * 128 + lane], at1 = AP[(size_t)t * 128 + 64 + lane];
        const float su0 = SU[ev0], su1 = SU[ev1], sv0 = SV[ev0], sv1 = SV[ev1];
        const pg8::f32x2 gl = pg8::gelu_pk((pg8::f32x2){at0 * su0 * sa2, at1 * su1 * sa2});
        evr[tl][0] = ev0; evr[tl][1] = ev1; cfr[tl][0] = gl.x * gv0 * sv0; cfr[tl][1] = gl.y * gv1 * sv1; }
    int n = 0;
#pragma unroll 1
    for (int s = 0; s < (16384 >> VS_SHIFT); ++s) {
#pragma unroll
        for (int tl = 0; tl < 2; ++tl) { const int n0 = n;
#pragma unroll
            for (int h = 0; h < 2; ++h) { const int ev = evr[tl][h]; const bool c = (ev >> VS_SHIFT) == s; const unsigned long long m = __ballot(c);
                const int pos = n + (int)__builtin_amdgcn_mbcnt_hi((unsigned)(m >> 32), __builtin_amdgcn_mbcnt_lo((unsigned)m, 0u));
                if (c) { le[pos] = (unsigned)ev | ((unsigned)tl << 14); lc[pos] = cfr[tl][h]; }
                n += __builtin_popcountll(m); }
            const int padn = (n0 - n) & 3;
            if (lane < padn) { le[n + lane] = ((unsigned)s << VS_SHIFT) | ((unsigned)tl << 14); lc[n + lane] = 0.f; }
            n += padn; }
    }
    if (lane < 4) { le[n + lane] = (7u << 11); lc[n + lane] = 0.f; }
    __builtin_amdgcn_fence(__ATOMIC_RELEASE, "wavefront"); __builtin_amdgcn_wave_barrier();
    const int G4 = ((n + 7) & ~7) >> 2;
    f32x2v acc0[16], acc1[16];
#pragma unroll
    for (int i = 0; i < 16; ++i) { acc0[i] = (f32x2v){0.f, 0.f}; acc1[i] = (f32x2v){0.f, 0.f}; }
    v4u bufA[4], bufB[4]; unsigned entA = 0u, entB = 0u; float cfA = 0.f, cfB = 0.f;
#pragma unroll
    for (int i = 0; i < 4; ++i) { bufA[i] = (v4u){0u, 0u, 0u, 0u}; bufB[i] = (v4u){0u, 0u, 0u, 0u}; }
    v2u bufA2[4], bufB2[4];
#pragma unroll
    for (int i = 0; i < 4; ++i) { bufA2[i] = (v2u){0u, 0u}; bufB2[i] = (v2u){0u, 0u}; }
#define PV_LOAD(BUF, ENT, CF, g_) do { ENT = le[4 * (g_) + (lane & 3)]; CF = lc[4 * (g_) + (lane & 3)]; \
        _Pragma("unroll") for (int i_ = 0; i_ < 4; ++i_) { const unsigned e_ = (unsigned)__builtin_amdgcn_readlane((int)ENT, i_) & (MODE == 2 ? 63u : 0x3FFFu); const unsigned char* p_ = V8 + (size_t)e_ * pg8::PEER_ROWB_V; BUF[i_] = *(const v4u*)(p_ + lane * 16); if (!(PEER_V4)) BUF##2[i_] = *(const v2u*)(p_ + 1024 + lane * 8); } } while (0)
#define PV_PROC(BUF, ENT, CF) do { const unsigned tg_ = ((unsigned)__builtin_amdgcn_readlane((int)ENT, 0) >> 14) & 1u; \
        if (tg_ != curtl) { curtl = tg_; _Pragma("unroll") for (int i_ = 0; i_ < 16; ++i_) { const f32x2v t_ = acc0[i_]; acc0[i_] = acc1[i_]; acc1[i_] = t_; } }     \
        _Pragma("unroll") for (int i_ = 0; i_ < 4; ++i_) axpy32_fp6(BUF[i_], BUF##2[i_], __builtin_bit_cast(float, __builtin_amdgcn_readlane(__builtin_bit_cast(int, CF), i_)), acc0); } while (0)
    unsigned curtl = 0u;
    PV_LOAD(bufA, entA, cfA, 0);
#pragma unroll 1
    for (int g = 0; g < G4; g += 2) {
        PV_LOAD(bufB, entB, cfB, g + 1);
        PV_PROC(bufA, entA, cfA);
        if (g + 2 < G4) PV_LOAD(bufA, entA, cfA, g + 2);
        PV_PROC(bufB, entB, cfB);
    }
#undef PV_LOAD
#undef PV_PROC
    __builtin_amdgcn_fence(__ATOMIC_RELEASE, "wavefront"); __builtin_amdgcn_wave_barrier();
#pragma unroll 1
    for (int tl = 0; tl < 2; ++tl) { const int t = gw + NGW * (2 * pass + tl);
        const int b = t / SEQ; float* xo = F.out + (size_t)t * DM; float ss = 0.f; f32x4 x2[8];
#pragma unroll
        for (int q = 0; q < 8; ++q) { const int col = q * 256 + 4 * lane;
            const f32x4 x1 = *(const f32x4*)(xo + col), g2 = *(const f32x4*)(ada + (size_t)b * ADA_W + 5 * DM + col);
            const f32x4 pe = ((unsigned)tl != curtl) ? (f32x4){acc1[2 * q].x, acc1[2 * q].y, acc1[2 * q + 1].x, acc1[2 * q + 1].y} : (f32x4){acc0[2 * q].x, acc0[2 * q].y, acc0[2 * q + 1].x, acc0[2 * q + 1].y};
            x2[q] = x1 + g2 * pe;
            ss += (x2[q].x * x2[q].x + x2[q].y * x2[q].y) + (x2[q].z * x2[q].z + x2[q].w * x2[q].w); }
        const float rstd = __builtin_amdgcn_rsqf(wave_sum(ss) * (1.0f / DM) + EPS);
#pragma unroll
        for (int q = 0; q < 8; ++q) { const int col = q * 256 + 4 * lane; const f32x4 fg = *(const f32x4*)(final_g + col);
            if (MODE == 0) *(f32x4*)(xo + col) = x2[q] * rstd * fg; else asm volatile("" :: "v"(x2[q] * rstd * fg)); } }
}
#endif
__device__ __forceinline__ void peer_main(Frame& F, const float* ada, const float* final_g, const XcdBarrier* barp) {
    const int gw = F.vcu * NWAVES + F.wave, NGW = F.G * NWAVES;
    int lane_ = F.lane; asm volatile("" : "+v"(lane_)); const int lane = lane_;
    const bf16* H2 = (const bf16*)(F.ws + WS_H2); const unsigned char* U8 = F.ws + WS_U8; const unsigned char* V8 = F.ws + WS_V8;
    const float* SU = (const float*)(F.ws + WS_SCU); const float* SV = (const float*)(F.ws + WS_SCV);
    const int* EI = (const int*)(F.ws + WS_EIDX); const float* EGp = (const float*)(F.ws + WS_EG);
#if PEER_UI4 && PEER_ROLES
    const int pw = F.wave & 3; const bool is_s = F.wave < 4;
    const int gw2 = F.vcu * 4 + pw, NGW2 = F.G * 4;
    LAS float* apl = (LAS float*)(F.lds + RING_OFF + 86016 + pw * 4096);
    volatile LAS unsigned* flg = (volatile LAS unsigned*)(F.lds + RING_OFF + 102400) + pw * 2;
    if (F.tid < 8) ((volatile LAS unsigned*)(F.lds + RING_OFF + 102400))[F.tid] = 0u;
    __syncthreads();
#ifndef PR_MODE
#define PR_MODE 4
#endif
#if PR_MODE == 0
#define PR_START(p_) ((p_) == 0 ? 0 : ((p_) == 1 ? 1 : 4 * ((p_) - 1)))
#define PR_NP 5
#elif PR_MODE == 1
#define PR_START(p_) (2 * (p_))
#define PR_NP 8
#elif PR_MODE == 2
#define PR_START(p_) ((p_) < 4 ? (p_) : ((p_) < 6 ? 4 + 2 * ((p_) - 4) : 8 + 4 * ((p_) - 6)))
#define PR_NP 8
#elif PR_MODE == 3
#define PR_START(p_) ((p_) < 2 ? (p_) : ((p_) < 5 ? 2 + 2 * ((p_) - 2) : 8 + 4 * ((p_) - 5)))
#define PR_NP 7
#else
#define PR_START(p_) (4 * (p_))
#define PR_NP 4
#define PR_COOP 1
#endif
    if (is_s) {
        LAS unsigned char* dig = F.lds + RING_OFF + pw * 8192; LAS unsigned* list = (LAS unsigned*)(F.lds + RING_OFF + 65536 + pw * 2176);
#ifdef PEER_SPRIO
        __builtin_amdgcn_s_setprio(PEER_SPRIO);
#endif
#pragma unroll 1
        for (int p = 0; p < PR_NP; ++p) {
            while (p >= 2 && flg[1] + 1u < (unsigned)p) __builtin_amdgcn_s_sleep(8);
#ifdef PR_COOP
            peer_dots_pass<0, true>(F, PR_START(p), (p == 0) ? 2 : 4, gw2, NGW2, dig, list, apl + (p & 1) * 512);
#else
            peer_dots_pass<0, true>(F, PR_START(p), PR_START(p + 1) - PR_START(p), gw2, NGW2, dig, list, apl + (p & 1) * 512);
#endif
            asm volatile("s_waitcnt lgkmcnt(0)" ::: "memory");
            if (lane == 0) flg[0] = (unsigned)(p + 1);
        }
#ifdef PEER_SPRIO
        __builtin_amdgcn_s_setprio(0);
#endif
    }
#ifdef PR_COOP
    if (!is_s) {
        LAS unsigned char* digb = F.lds + RING_OFF + F.wave * 8192; LAS unsigned* listb = (LAS unsigned*)(F.lds + RING_OFF + 65536 + F.wave * 2176);
        peer_dots_pass<0, true>(F, 2, 2, gw2, NGW2, digb, listb, apl + 256);
        asm volatile("s_waitcnt lgkmcnt(0)" ::: "memory");
    }
#endif
#pragma unroll 1
    for (int p = is_s ? PR_NP - 1 : 0; p < PR_NP; ++p) {
    while (flg[0] < (unsigned)(p + 1)) __builtin_amdgcn_s_sleep(8);
    asm volatile("" ::: "memory");
    const int tqa = (p == PR_NP - 1 && is_s) ? PEER_TSPLIT : PR_START(p), tqb = (p == PR_NP - 1 && !is_s) ? PEER_TSPLIT : PR_START(p + 1);
    for (int tq = tqa; tq < tqb; ++tq) { const int t = gw2 + NGW2 * tq; const LAS float* apsrc = apl + (p & 1) * 512 + (tq - PR_START(p)) * 128;
        int lane_t = lane_; asm volatile("" : "+v"(lane_t)); const int lane = lane_t;
        const float sa2 = ((const float*)(F.ws + WS_SA2))[t];
#elif PEER_UI4
#ifdef PROBE_SWEEP_DUP
    peer_dots_sweep<PROBE_SWEEP_DUP>(F);
#endif
    peer_dots_sweep<0>(F);
    __threadfence();
#if PEER_VSWEEP
#pragma unroll 1
    for (int pass = 0; pass < 4; ++pass) {
#if PEER_VBAR
        if (barp) xcd_barrier(*barp);
#endif
#ifdef PROBE_VSWEEP_DUP
        peer_vsweep_pass<PROBE_VSWEEP_DUP>(F, ada, final_g, pass);
#endif
        peer_vsweep_pass<0>(F, ada, final_g, pass);
    }
    return;
#endif
#endif
#if !(PEER_UI4 && PEER_ROLES)
    for (int t = gw; t < T; t += NGW) {
#endif
#if PEER_UI4 && PEER_ROLES
#elif PEER_UI4
#ifdef PROBE_TOKBAR
        if (barp && (((t - gw) / NGW) % PROBE_TOKBAR) == 0) xcd_barrier(*barp);
#endif
        const float sa2 = ((const float*)(F.ws + WS_SA2))[t];
#elif I8_Q
        f32x2v hf[16];
#pragma unroll
        for (int q = 0; q < 8; ++q) { const int a = *(const int*)((const unsigned char*)H2 + (size_t)t * DM + q * 256 + 4 * lane);
            hf[2 * q] = (f32x2v){(float)((a << 24) >> 24), (float)((a << 16) >> 24)}; hf[2 * q + 1] = (f32x2v){(float)((a << 8) >> 24), (float)(a >> 24)}; }
        const float sa2 = ((const float*)(F.ws + WS_SA2))[t];
#else
        f32x2v hf[16];
#pragma unroll
        for (int q = 0; q < 8; ++q) { const v2u a = *(const v2u*)(H2 + (size_t)t * DM + q * 256 + 4 * lane);
            hf[2 * q] = (f32x2v){bf_lo(a.x), bf_hi(a.x)}; hf[2 * q + 1] = (f32x2v){bf_lo(a.y), bf_hi(a.y)}; }
        const float sa2 = 1.0f;
#endif
        int ev0 = EI[(size_t)t * 128 + lane], ev1 = EI[(size_t)t * 128 + 64 + lane];
        const float gv0 = EGp[(size_t)t * 128 + lane], gv1 = EGp[(size_t)t * 128 + 64 + lane];
        const float su0 = SU[ev0], su1 = SU[ev1], sv0 = SV[ev0], sv1 = SV[ev1];
        v4u bufA[4], bufB[4]; v2u bufA2[4], bufB2[4];
#define PM_EMASK 0x7FFFFFFF
#define PM_LOAD(BUF, BUF2, TAB, RB, F4, g) do { const int evs_ = ((g) >= 16) ? ev1 : ev0; _Pragma("unroll") for (int i_ = 0; i_ < 4; ++i_) { const int e_ = __builtin_amdgcn_readlane(evs_, (4 * (g) + i_) & 63) & PM_EMASK; \
            const unsigned char* p_ = (TAB) + (size_t)e_ * (RB); BUF[i_] = *(const v4u*)(p_ + lane * 16); if (!(F4)) BUF2[i_] = *(const v2u*)(p_ + 1024 + lane * 8); else BUF2[i_] = (v2u){0u, 0u}; } } while (0)
#if PEER_UI4
#if PEER_ROLES
        float at0 = apsrc[lane], at1 = apsrc[64 + lane];
#else
        float at0 = ((const float*)(F.ws + WS_AP))[(size_t)t * 128 + lane], at1 = ((const float*)(F.ws + WS_AP))[(size_t)t * 128 + 64 + lane];
#endif
#else
        float at0 = 0.f, at1 = 0.f;
#ifdef PROBE_PEER_LOADL2
#undef PM_EMASK
#define PM_EMASK 2047
#define PROBE_PEER_LOADONLY 1
#endif
#ifdef PROBE_PEER_LOADDEEP
        { unsigned dz = 0u; v4u bufC[4], bufD[4]; v2u bufC2[4], bufD2[4];
#define PM_EAT(B) _Pragma("unroll") for (int i = 0; i < 4; ++i) dz ^= (B[i].x ^ B[i].y) ^ (B[i].z ^ B[i].w);
          PM_LOAD(bufA, bufA2, V8, pg8::PEER_ROWB_V, PEER_V4, 0); PM_LOAD(bufB, bufB2, V8, pg8::PEER_ROWB_V, PEER_V4, 1); PM_LOAD(bufC, bufC2, V8, pg8::PEER_ROWB_V, PEER_V4, 2);
#pragma unroll 1
          for (int g4 = 0; g4 < 32; g4 += 4) {
              PM_LOAD(bufD, bufD2, V8, pg8::PEER_ROWB_V, PEER_V4, g4 + 3); PM_EAT(bufA)
              if (g4 + 4 < 32) PM_LOAD(bufA, bufA2, V8, pg8::PEER_ROWB_V, PEER_V4, g4 + 4); PM_EAT(bufB)
              if (g4 + 4 < 32) PM_LOAD(bufB, bufB2, V8, pg8::PEER_ROWB_V, PEER_V4, g4 + 5); PM_EAT(bufC)
              if (g4 + 4 < 32) PM_LOAD(bufC, bufC2, V8, pg8::PEER_ROWB_V, PEER_V4, g4 + 6); PM_EAT(bufD)
          }
#undef PM_EAT
          asm volatile("" :: "v"(dz)); }
#endif
#ifdef PROBE_PEER_LOADONLY
        { unsigned dz = 0u;
          PM_LOAD(bufA, bufA2, V8, pg8::PEER_ROWB_V, PEER_V4, 0);
#pragma unroll 1
          for (int g2 = 0; g2 < 32; g2 += 2) {
              PM_LOAD(bufB, bufB2, V8, pg8::PEER_ROWB_V, PEER_V4, g2 + 1);
#pragma unroll
              for (int i = 0; i < 4; ++i) dz ^= (bufA[i].x ^ bufA[i].y) ^ (bufA[i].z ^ bufA[i].w);
              if (g2 + 2 < 32) PM_LOAD(bufA, bufA2, V8, pg8::PEER_ROWB_V, PEER_V4, g2 + 2);
#pragma unroll
              for (int i = 0; i < 4; ++i) dz ^= (bufB[i].x ^ bufB[i].y) ^ (bufB[i].z ^ bufB[i].w);
          }
          asm volatile("" :: "v"(dz)); }
#endif
#undef PM_EMASK
#define PM_EMASK 0x7FFFFFFF
#ifdef PROBE_PEER_A2
#pragma unroll 1
        for (int rep_ = 0; rep_ < 2; ++rep_) {
#else
        {
#endif
        PM_LOAD(bufA, bufA2, U8, pg8::PEER_ROWB_U, PEER_U4, 0);
#pragma unroll 1
        for (int sg = 0; sg < 8; ++sg) {
            float part[16]; const int g0 = 4 * sg;
            PM_LOAD(bufB, bufB2, U8, pg8::PEER_ROWB_U, PEER_U4, g0 + 1);
#pragma unroll
            for (int i = 0; i < 4; ++i) part[i] = dot32_fp6(bufA[i], bufA2[i], hf);
            PM_LOAD(bufA, bufA2, U8, pg8::PEER_ROWB_U, PEER_U4, g0 + 2);
#pragma unroll
            for (int i = 0; i < 4; ++i) part[4 + i] = dot32_fp6(bufB[i], bufB2[i], hf);
            PM_LOAD(bufB, bufB2, U8, pg8::PEER_ROWB_U, PEER_U4, g0 + 3);
#pragma unroll
            for (int i = 0; i < 4; ++i) part[8 + i] = dot32_fp6(bufA[i], bufA2[i], hf);
            if (sg < 7) PM_LOAD(bufA, bufA2, U8, pg8::PEER_ROWB_U, PEER_U4, g0 + 4);
#pragma unroll
            for (int i = 0; i < 4; ++i) part[12 + i] = dot32_fp6(bufB[i], bufB2[i], hf);
#define PM_STAGE(N, OFF) _Pragma("unroll") for (int i = 0; i < (N); ++i) { const bool up_ = (lane & (OFF)) != 0; const float send = up_ ? part[i] : part[i + (N)]; const float keep = up_ ? part[i + (N)] : part[i]; part[i] = keep + __shfl_xor(send, (OFF)); }
            PM_STAGE(8, 8) PM_STAGE(4, 4) PM_STAGE(2, 2) PM_STAGE(1, 1)
#undef PM_STAGE
            float tot = part[0]; tot += __shfl_xor(tot, 16); tot += __shfl_xor(tot, 32);
            const bool mine = (lane >> 4) == (sg & 3);
            if (sg < 4) at0 = mine ? tot : at0; else at1 = mine ? tot : at1;
        }
        }
#endif
        float cf0, cf1;
        { const pg8::f32x2 gl = pg8::gelu_pk((pg8::f32x2){at0 * su0 * sa2, at1 * su1 * sa2}); cf0 = gl.x * gv0 * sv0; cf1 = gl.y * gv1 * sv1; }
#if PEER_UI4 && PEER_VSORT
        { LAS unsigned* le = (LAS unsigned*)(F.lds + RING_OFF + F.wave * 8192); LAS float* lc = (LAS float*)(le + 128); int n = 0;
#pragma unroll 1
          for (int s = 0; s < 8; ++s) {
#pragma unroll
              for (int h = 0; h < 2; ++h) { const int ev = h ? ev1 : ev0; const bool c = (ev >> 11) == s; const unsigned long long m = __ballot(c);
                  const int pos = n + (int)__builtin_amdgcn_mbcnt_hi((unsigned)(m >> 32), __builtin_amdgcn_mbcnt_lo((unsigned)m, 0u));
                  if (c) { le[pos] = (unsigned)ev; lc[pos] = h ? cf1 : cf0; }
                  n += __builtin_popcountll(m); } }
          __builtin_amdgcn_fence(__ATOMIC_RELEASE, "wavefront"); __builtin_amdgcn_wave_barrier();
          ev0 = (int)le[lane]; ev1 = (int)le[64 + lane]; cf0 = lc[lane]; cf1 = lc[64 + lane];
          __builtin_amdgcn_fence(__ATOMIC_RELEASE, "wavefront"); __builtin_amdgcn_wave_barrier(); }
#endif
        f32x2v acc[16];
#pragma unroll
        for (int i = 0; i < 16; ++i) acc[i] = (f32x2v){0.f, 0.f};
#define PM_ROWACC(A_, A2_, c_) axpy32_fp6(A_, A2_, c_, acc)
#ifdef PROBE_PEER_VALU
        f32x2v accd[16];
#pragma unroll
        for (int i = 0; i < 16; ++i) accd[i] = (f32x2v){0.f, 0.f};
#endif
#if PEER_UI4 && PEER_ROLES && PEER_VDEEP
        {
          v4u bufC[4], bufD[4]; v2u bufC2[4], bufD2[4];
#define PM_AXPY(BUF, BUF2, g_) do { const int cfs_ = __builtin_bit_cast(int, ((g_) >= 16) ? cf1 : cf0); \
            _Pragma("unroll") for (int i = 0; i < 4; ++i) PM_ROWACC(BUF[i], BUF2[i], __builtin_bit_cast(float, __builtin_amdgcn_readlane(cfs_, (4 * (g_) + i) & 63))); } while (0)
#define PM_GC(x_) ((x_) < 31 ? (x_) : 31)
          PM_LOAD(bufA, bufA2, V8, pg8::PEER_ROWB_V, PEER_V4, 0); PM_LOAD(bufB, bufB2, V8, pg8::PEER_ROWB_V, PEER_V4, 1); PM_LOAD(bufC, bufC2, V8, pg8::PEER_ROWB_V, PEER_V4, 2);
#pragma unroll 1
          for (int g4 = 0; g4 < 32; g4 += 4) {
              PM_LOAD(bufD, bufD2, V8, pg8::PEER_ROWB_V, PEER_V4, g4 + 3); PM_AXPY(bufA, bufA2, g4);
              { const int gl_ = PM_GC(g4 + 4); PM_LOAD(bufA, bufA2, V8, pg8::PEER_ROWB_V, PEER_V4, gl_); } PM_AXPY(bufB, bufB2, g4 + 1);
              { const int gl_ = PM_GC(g4 + 5); PM_LOAD(bufB, bufB2, V8, pg8::PEER_ROWB_V, PEER_V4, gl_); } PM_AXPY(bufC, bufC2, g4 + 2);
              { const int gl_ = PM_GC(g4 + 6); PM_LOAD(bufC, bufC2, V8, pg8::PEER_ROWB_V, PEER_V4, gl_); } PM_AXPY(bufD, bufD2, g4 + 3);
          }
#undef PM_AXPY
#undef PM_GC
        }
#else
        PM_LOAD(bufA, bufA2, V8, pg8::PEER_ROWB_V, PEER_V4, 0);
#pragma unroll 1
        for (int g2 = 0; g2 < 32; g2 += 2) {
            PM_LOAD(bufB, bufB2, V8, pg8::PEER_ROWB_V, PEER_V4, g2 + 1);
            { const int cfs = __builtin_bit_cast(int, (g2 >= 16) ? cf1 : cf0);
#pragma unroll
              for (int i = 0; i < 4; ++i) { const float c = __builtin_bit_cast(float, __builtin_amdgcn_readlane(cfs, (4 * g2 + i) & 63)); axpy32_fp6(bufA[i], bufA2[i], c, acc);
#ifdef PROBE_PEER_VALU
                axpy32_fp6(bufA[i], bufA2[i], c * 0.5f, accd);
#endif
              } }
            { const int gn_ = g2 + 2 < 32 ? g2 + 2 : 31; PM_LOAD(bufA, bufA2, V8, pg8::PEER_ROWB_V, PEER_V4, gn_); }
            { const int cfs = __builtin_bit_cast(int, (g2 + 1 >= 16) ? cf1 : cf0);
#pragma unroll
              for (int i = 0; i < 4; ++i) { const float c = __builtin_bit_cast(float, __builtin_amdgcn_readlane(cfs, (4 * (g2 + 1) + i) & 63)); axpy32_fp6(bufB[i], bufB2[i], c, acc);
#ifdef PROBE_PEER_VALU
                axpy32_fp6(bufB[i], bufB2[i], c * 0.5f, accd);
#endif
              } }
        }
#endif
#undef PM_LOAD
#undef PM_ROWACC
#ifdef PROBE_PEER_VALU
#pragma unroll
        for (int i = 0; i < 16; ++i) asm volatile("" :: "v"(accd[i]));
#endif
        const int b = t / SEQ; float* xo = F.out + (size_t)t * DM; float ss = 0.f; f32x4 x2[8];
#pragma unroll
        for (int q = 0; q < 8; ++q) { const int col = q * 256 + 4 * lane;
#if X1_BF16
            const v2u xw_ = *(const v2u*)((const bf16*)(F.ws + WS_X1B) + (size_t)t * DM + col); const f32x4 x1 = {bf_lo(xw_.x), bf_hi(xw_.x), bf_lo(xw_.y), bf_hi(xw_.y)};
            const f32x4 g2 = *(const f32x4*)(ada + (size_t)b * ADA_W + 5 * DM + col);
#else
            const f32x4 x1 = *(const f32x4*)(xo + col), g2 = *(const f32x4*)(ada + (size_t)b * ADA_W + 5 * DM + col);
#endif
            const f32x4 pe = {acc[2 * q].x, acc[2 * q].y, acc[2 * q + 1].x, acc[2 * q + 1].y};
            x2[q] = x1 + g2 * pe;
            ss += (x2[q].x * x2[q].x + x2[q].y * x2[q].y) + (x2[q].z * x2[q].z + x2[q].w * x2[q].w); }
        const float rstd = __builtin_amdgcn_rsqf(wave_sum(ss) * (1.0f / DM) + EPS);
#pragma unroll
        for (int q = 0; q < 8; ++q) { const int col = q * 256 + 4 * lane; const f32x4 fg = *(const f32x4*)(final_g + col);
            *(f32x4*)(xo + col) = x2[q] * rstd * fg; }
    }
#if PEER_UI4 && PEER_ROLES
    asm volatile("s_waitcnt lgkmcnt(0)" ::: "memory");
    if (lane == 0) flg[1] = (unsigned)(p + 1);
    }
#undef PR_START
#undef PR_NP
#undef PR_COOP
#endif
}


struct Args { const void* in[25]; float* out; unsigned char* ws; int ph_lo, ph_hi; };
__global__ void __launch_bounds__(NWAVES * 64, 2) mk_fwd(Args args) {
    extern __shared__ __attribute__((aligned(16))) unsigned char lds[];
    Frame F;
    F.lds = (LAS unsigned char*)lds; F.ldsg = lds;
    F.MISC = (volatile LAS unsigned*)(F.lds + MISC_OFF);
    F.tid = threadIdx.x; F.lane = F.tid & 63; F.wave = __builtin_amdgcn_readfirstlane(F.tid >> 6);
    F.G = gridDim.x; { const int bx = blockIdx.x; F.vcu = (F.G % 8 == 0) ? (bx % 8) * (F.G / 8) + bx / 8 : bx; }
    F.ws = args.ws; F.out = args.out; F.ctl = (gu32*)(args.ws + WS_CTL);
    for (int u = F.tid; u < (LDS_BYTES - LDSCTL_OFF) / 4; u += NWAVES * 64) ((LAS unsigned*)(F.lds + LDSCTL_OFF))[u] = 0u;
    __syncthreads();
    XcdBarrier bar; bar.bar = (unsigned*)(F.ctl + CW_BAR); bar.x = 0; bar.st = nullptr; bar.wv = F.wave;
    if (N_LAUNCHES == 1) bar = xcd_barrier_post((unsigned*)(F.ctl + CW_BAR), F.MISC + 8);
#ifdef DOUBLE_BAR
#define GRID_BAR() do { if (N_LAUNCHES == 1) { xcd_barrier(bar); xcd_barrier(bar); } } while (0)
#else
#define GRID_BAR() do { if (N_LAUNCHES == 1) xcd_barrier(bar); } while (0)
#endif
    const int lo = args.ph_lo, hi = args.ph_hi;
#ifndef G1_SP2
#define G1_SP2 true
#endif
#ifndef G1_ALIGN
#define G1_ALIGN true
#endif
#ifndef PH_MASK
#define PH_MASK 0xFFFF
#endif
#ifndef P89_HANDOFF
#define P89_HANDOFF 1
#endif
#ifndef X1_BF16
#define X1_BF16 1
#endif
#define IN(k) ((((PH_MASK) >> (k)) & 1) && lo <= (k) && (k) < hi)
#define BOTH(k) (IN(k) && IN((k) + 1))
#ifndef DUP_MASK
#define DUP_MASK 0
#endif
#define REPS(k) for (int rep_ = 0; rep_ < ((((DUP_MASK) >> (k)) & 1) ? 2 : 1); ++rep_) if (frame_refresh(F))
    const float* x = IN_F(0); const float* ada = (const float*)(F.ws + WS_ADA);

    if (IN(0)) REPS(0) { p0_prologue<0>(F, IN_F(1), (const int*)args.in[2], IN_F(3), IN_F(4), IN_F(6), IN_F(15), IN_F(16), IN_F(17), IN_F(19)); if (BOTH(0)) GRID_BAR(); }
    if (IN(1)) REPS(1) { p0_prologue<1>(F, IN_F(1), (const int*)args.in[2], IN_F(3), IN_F(4), IN_F(6), IN_F(15), IN_F(16), IN_F(17), IN_F(19)); mod_rows_i8(F, x, IN_F(5), ada + 0 * DM, ada + 1 * DM, F.ws + WS_H, (float*)(F.ws + WS_SA)); if (BOTH(1)) GRID_BAR(); }
    if (IN(2)) REPS(2) {
        pg8::Gemm g{(const bf16*)(F.ws + WS_H), (const bf16*)(F.ws + WS_WIN), T, IN_W, DM / 2}; pg8::StaticOrder S; S.init(T, IN_W, F.G, (int)blockIdx.x);
        pg8::EpiG1 E; E.ws = F.ws; E.positions = (const int*)args.in[2]; E.sa = (const float*)(F.ws + WS_SA); E.sb = (const float*)(F.ws + WS_SB) + CM_IN / 256;
        E.tsrc_u = IN_F(22); E.tsrc_v = IN_F(23); E.tdst_u = F.ws + WS_U8; E.tdst_v = F.ws + WS_V8; E.tsc_u = (float*)(F.ws + WS_SCU); E.tsc_v = (float*)(F.ws + WS_SCV); E.cnt = 0;
#ifndef G1_STAGGER_MASK
#define G1_STAGGER_MASK 3
#endif
#if TR_LATE
        if (blockIdx.x & 1) { p0_prologue<5>(F, IN_F(1), (const int*)args.in[2], IN_F(3), IN_F(4), IN_F(6), IN_F(15), IN_F(16), IN_F(17), IN_F(19)); __syncthreads(); }
#elif defined(G1_STAGGER_TICKS)
        { const unsigned long long t0_ = rt(); const unsigned long long d_ = (unsigned long long)(blockIdx.x & G1_STAGGER_MASK) * G1_STAGGER_TICKS; while (rt() - t0_ < d_) __builtin_amdgcn_s_sleep(8); }
#endif
#ifdef PROBE_G1_VAR
        { pg8::EpiG1T<PROBE_G1_VAR> EV; EV.ws = F.ws; EV.positions = E.positions; EV.sa = E.sa; EV.sb = E.sb; EV.cnt = 8; pg8::gemm_phase<pg8::EpiG1T<PROBE_G1_VAR>, pg8::StaticOrder, true, true, true>(F.lds + RING_OFF, g, S, EV); }
#endif
        pg8::gemm_phase<pg8::EpiG1, pg8::StaticOrder, G1_ALIGN, G1_SP2, true>(F.lds + RING_OFF, g, S, E, F.wave);
#if TJOB_POST
        if (!(blockIdx.x & 1)) E.tjob_post((int)blockIdx.x >> 1, F.wave, F.lane);
#endif
#ifdef PROBE_G1_NULL
        { pg8::EpiNull EN; pg8::gemm_phase<pg8::EpiNull, pg8::StaticOrder, true, true, true>(F.lds + RING_OFF, g, S, EN); }
#endif
        if (BOTH(2)) GRID_BAR();
    }
    if (IN(3)) REPS(3) {
        for (int r2_ = 0; r2_ < ((((DUP_MASK) >> 11) & 1) ? 2 : 1); ++r2_) if ((PH_MASK >> 11) & 1) for (int it = F.vcu; it < 256; it += F.G) hgrn_item(F, it, IN_F(12), IN_F(13));
        float lam;
        { float s1 = 0.f, s2 = 0.f; const float* q1 = IN_F(7); const float* k1 = IN_F(8); const float* q2 = IN_F(9); const float* k2 = IN_F(10);
          for (int i = 0; i < 64; ++i) { s1 += q1[i] * k1[i]; s2 += q2[i] * k2[i]; }
          lam = __expf(s1) - __expf(s2) + LAMBDA_INIT; }
        for (int r2_ = 0; r2_ < ((((DUP_MASK) >> 12) & 1) ? 2 : 1); ++r2_) if ((PH_MASK >> 12) & 1) for (int u = F.vcu; u < 512; u += F.G) attn_unit(F, u, lam, IN_F(11));
        if (BOTH(3)) GRID_BAR();
    }
    if (IN(4)) REPS(4) { hgrn_combine(F, IN_F(14)); if (BOTH(4)) GRID_BAR(); }
    if (IN(5)) REPS(5) {
#if I8_AB
        { pg8::Gemm g{(const bf16*)(F.ws + WS_OA8), (const bf16*)(F.ws + WS_WA), T, DM, 512}; pg8::StaticOrder S; S.init(T, DM, F.G, (int)blockIdx.x);
          pg8::EpiGate<false> E{(bf16*)(F.ws + WS_Y), (const bf16*)(F.ws + WS_GA), DM, (const float*)(F.ws + WS_SAO), (const float*)(F.ws + WS_SB) + CM_A / 256};
          pg8::gemm_phase<pg8::EpiGate<false>, pg8::StaticOrder, true, true, true>(F.lds + RING_OFF, g, S, E, F.wave); }
        { pg8::Gemm g{(const bf16*)(F.ws + WS_OB), (const bf16*)(F.ws + WS_WB), T, DM, 512}; pg8::StaticOrder S; S.init(T, DM, F.G, (int)blockIdx.x);
          pg8::EpiGate<true> E{(bf16*)(F.ws + WS_Y), (const bf16*)(F.ws + WS_GB), DM, (const float*)(F.ws + WS_SAB), (const float*)(F.ws + WS_SB) + CM_B / 256};
          pg8::gemm_phase<pg8::EpiGate<true>, pg8::StaticOrder, true, true, true>(F.lds + RING_OFF, g, S, E, F.wave); }
#else
        { pg8::Gemm g{(const bf16*)(F.ws + WS_OA), (const bf16*)(F.ws + WS_WA), T, DM, 1024}; pg8::StaticOrder S; S.init(T, DM, F.G, (int)blockIdx.x);
          pg8::EpiGate<false> E{(bf16*)(F.ws + WS_Y), (const bf16*)(F.ws + WS_GA), DM, nullptr, nullptr};
          pg8::gemm_phase<pg8::EpiGate<false>, pg8::StaticOrder, true, true>(F.lds + RING_OFF, g, S, E, F.wave); }
        { pg8::Gemm g{(const bf16*)(F.ws + WS_OB), (const bf16*)(F.ws + WS_WB), T, DM, 1024}; pg8::StaticOrder S; S.init(T, DM, F.G, (int)blockIdx.x);
          pg8::EpiGate<true> E{(bf16*)(F.ws + WS_Y), (const bf16*)(F.ws + WS_GB), DM, nullptr, nullptr};
          pg8::gemm_phase<pg8::EpiGate<true>, pg8::StaticOrder, true, true>(F.lds + RING_OFF, g, S, E, F.wave); }
#endif
#if I8_O
        GRID_BAR();
        quant_rows_bf16(F, (const bf16*)(F.ws + WS_Y), F.ws + WS_Y8, (float*)(F.ws + WS_SAY));
#endif
        if (BOTH(5)) GRID_BAR();
    }
    if (IN(6)) REPS(6) {
#if I8_O
        pg8::Gemm g{(const bf16*)(F.ws + WS_Y8), (const bf16*)(F.ws + WS_WOUT), T, DM, DM / 2}; pg8::StaticOrder S; S.init(T, DM, F.G, (int)blockIdx.x);
        pg8::EpiResGate E{x, F.out, ada + 2 * DM, DM, ADA_W, SEQ, (const float*)(F.ws + WS_SAY), (const float*)(F.ws + WS_SB) + CM_O / 256};
#if X1_BF16
        E.outb = (pg8::bf16_t*)(F.ws + WS_X1B);
#endif
        pg8::gemm_phase<pg8::EpiResGate, pg8::StaticOrder, true, true, true>(F.lds + RING_OFF, g, S, E, F.wave);
#else
        pg8::Gemm g{(const bf16*)(F.ws + WS_Y), (const bf16*)(F.ws + WS_WOUT), T, DM, DM}; pg8::StaticOrder S; S.init(T, DM, F.G, (int)blockIdx.x);
        pg8::EpiResGate E{x, F.out, ada + 2 * DM, DM, ADA_W, SEQ, nullptr, nullptr};
        pg8::gemm_phase<pg8::EpiResGate, pg8::StaticOrder, true, true>(F.lds + RING_OFF, g, S, E, F.wave);
#endif
        if (BOTH(6)) GRID_BAR();
    }
    if (IN(7)) REPS(7) {
#if I8_Q
#if X1_BF16
        mod_rows_i8<(PEER_UI4 != 0) ? 119 : 127, true>(F, (const float*)(F.ws + WS_X1B), IN_F(18), ada + 3 * DM, ada + 4 * DM, F.ws + WS_H2, (float*)(F.ws + WS_SA2));
#else
        mod_rows_i8<(PEER_UI4 != 0) ? 119 : 127>(F, F.out, IN_F(18), ada + 3 * DM, ada + 4 * DM, F.ws + WS_H2, (float*)(F.ws + WS_SA2));
#endif
#else
        mod_rows(F, F.out, IN_F(18), ada + 3 * DM, ada + 4 * DM, (bf16*)(F.ws + WS_H2));
#endif
        if (BOTH(7)) GRID_BAR();
    }
    if (IN(8)) REPS(8) {
#if I8_Q
        pg8::Gemm g{(const bf16*)(F.ws + WS_H2), (const bf16*)(F.ws + WS_WQ), T, DM, DM / 2}; pg8::StaticOrder S; S.init(T, DM, F.G, (int)blockIdx.x);
        pg8::EpiPlainS E{(bf16*)(F.ws + WS_QP), DM, (const float*)(F.ws + WS_SA2), (const float*)(F.ws + WS_SBC)};
        pg8::gemm_phase<pg8::EpiPlainS, pg8::StaticOrder, true, true, true>(F.lds + RING_OFF, g, S, E, F.wave);
#else
        pg8::Gemm g{(const bf16*)(F.ws + WS_H2), (const bf16*)(F.ws + WS_WQ), T, DM, DM}; pg8::StaticOrder S; S.init(T, DM, F.G, (int)blockIdx.x);
        pg8::EpiPlain E{(bf16*)(F.ws + WS_QP), DM};
        pg8::gemm_phase<pg8::EpiPlain, pg8::StaticOrder, true, true>(F.lds + RING_OFF, g, S, E, F.wave);
#endif
#if P89_HANDOFF
        if (BOTH(8) && N_LAUNCHES != 1) GRID_BAR();
#else
        if (BOTH(8)) GRID_BAR();
#endif
    }
    if (IN(9)) REPS(9) {
#if P89_HANDOFF
        { pg8::StaticOrder S9; S9.init(T, DM, F.G, (int)blockIdx.x); int pm9 = 0, pn9 = 0;
          for (int i = 0; S9.next_inl(i, pm9, pn9); ++i) peer_route_unit(F, pn9 * 64 + pm9, IN_F(20), IN_F(21)); }
#else
        for (int u = F.vcu; u < 512; u += F.G) peer_route_unit(F, u, IN_F(20), IN_F(21));
#endif
        if (BOTH(9)) GRID_BAR(); }
    if (IN(10)) REPS(10) { peer_main(F, ada, IN_F(24), (N_LAUNCHES == 1) ? &bar : nullptr); }
#undef IN
#undef BOTH
#undef GRID_BAR
}

extern "C" void kernel_launch(void* const* d_in, const int* in_sizes, int n_in, void* d_out, int out_size, void* d_ws, size_t ws_size, hipStream_t stream) {
    static int grid = 0;
    if (grid == 0) {
        if (n_in != 25 || in_sizes[0] != T * DM || out_size != T * DM || ws_size < WS_END) {
            fprintf(stderr, "kernel_launch: shape/workspace mismatch: n_in %d in0 %d out %d ws %zu (need >= %zu)\n", n_in, n_in > 0 ? in_sizes[0] : -1, out_size, ws_size, (size_t)WS_END); grid = -1; return; }
        int dev = 0, cus = 0, per_cu = 0;
        if (hipGetDevice(&dev) != hipSuccess || hipDeviceGetAttribute(&cus, hipDeviceAttributeMultiprocessorCount, dev) != hipSuccess) { fprintf(stderr, "kernel_launch: device query failed\n"); grid = -1; return; }
        if (hipFuncSetAttribute((const void*)mk_fwd, hipFuncAttributeMaxDynamicSharedMemorySize, LDS_BYTES) != hipSuccess) { fprintf(stderr, "kernel_launch: hipFuncSetAttribute failed\n"); grid = -1; return; }
        if (hipOccupancyMaxActiveBlocksPerMultiprocessor(&per_cu, (const void*)mk_fwd, NWAVES * 64, LDS_BYTES) != hipSuccess || per_cu < 1) {
            fprintf(stderr, "kernel_launch: occupancy query reports %d workgroups per CU\n", per_cu); (void)hipGetLastError(); per_cu = 1; }
        grid = cus;
        if (grid != 256) { fprintf(stderr, "kernel_launch: built for a 256-CU device (got %d)\n", cus); grid = -1; return; }
    }
    if (grid < 0) return;
    if (hipMemsetAsync((char*)d_ws + WS_CTL, 0, CTL_ZERO_BYTES, stream) != hipSuccess) { fprintf(stderr, "kernel_launch: memset failed\n"); return; }
    Args a{};
    for (int i = 0; i < 25; ++i) a.in[i] = d_in[i];
    a.out = (float*)d_out; a.ws = (unsigned char*)d_ws;
    for (int li = 0; li < N_LAUNCHES; ++li) {
        a.ph_lo = (N_LAUNCHES == 1) ? 0 : li; a.ph_hi = (N_LAUNCHES == 1) ? N_PHASES : li + 1;
        hipLaunchKernelGGL(mk_fwd, dim3(grid), dim3(NWAVES * 64), LDS_BYTES, stream, a);
        const hipError_t le = hipPeekAtLastError();
        if (le != hipSuccess) { fprintf(stderr, "kernel_launch: launch %d failed: %s\n", li, hipGetErrorName(le)); break; }
    }
}
```
